# Optimizing an MI355X kernel written in HIP

```python
import math
import jax, jax.numpy as jnp
from jax import lax
import numpy as np

D_MODEL = 1024
BATCH = 16
SEQ = 2048
DEPTH = 1

CTX_LEN = 256
GRID_W = 64

N_HEADS = 8
QK_NOPE_DIM = 128
QK_ROPE_DIM = 64
V_HEAD_DIM = 128
Q_RANK = 384
KV_RANK = 256
ROPE_AXIS_DIM = QK_ROPE_DIM // 2
ROPE_BASE = 10000.0
Q_BLOCK = 128

S5_WIDTH = D_MODEL // 2
S5_GROUP = 16
S5_GROUPS = S5_WIDTH // S5_GROUP
S5_STATE = 64
S5_DT_MIN = 1e-3
S5_DT_MAX = 1e-1

PEER_HEADS = 8
PEER_N_KEYS = 128
PEER_EXPERTS = PEER_N_KEYS * PEER_N_KEYS
PEER_TOPK = 16
PEER_QUERY_DIM = 256
PEER_HALF = PEER_QUERY_DIM // 2
TOKEN_BLOCK = 128

IN_SPLIT_POINTS = (Q_RANK, Q_RANK + KV_RANK, Q_RANK + KV_RANK + QK_ROPE_DIM, Q_RANK + KV_RANK + QK_ROPE_DIM + S5_WIDTH, Q_RANK + KV_RANK + QK_ROPE_DIM + S5_WIDTH + D_MODEL)
IN_WIDTH = Q_RANK + KV_RANK + QK_ROPE_DIM + S5_WIDTH + 2 * D_MODEL

DEEPNORM_ALPHA = (2.0 * DEPTH) ** 0.25
DEEPNORM_BETA = (8.0 * DEPTH) ** -0.25
LN_EPS = 1e-6
N_MOD = 6

kernel_name = 'hybrid_mla_s5_peer_dit_block'


def layer_norm_plain(x):
    xf = x.astype(jnp.float32)
    xc = xf - jnp.mean(xf, axis=-1, keepdims=True)
    var = jnp.mean(xc * xc, axis=-1, keepdims=True)
    return (xc * lax.rsqrt(var + LN_EPS)).astype(x.dtype)


def layer_norm(x, g, b):
    return layer_norm_plain(x) * g + b


def rms_norm(x, g):
    xf = x.astype(jnp.float32)
    y = xf * lax.rsqrt(jnp.mean(xf * xf, axis=-1, keepdims=True) + LN_EPS)
    return y.astype(x.dtype) * g


def modulation(cond, w_mod, b_mod):
    m = jax.nn.silu(cond) @ w_mod + b_mod
    return jnp.split(m[..., None, :], N_MOD, axis=-1)


def modulate(h, shift, scale):
    return layer_norm_plain(h) * (1.0 + scale) + shift


def axial_rope_tables(rows, dtype):
    row = jnp.broadcast_to(jnp.arange(rows, dtype=jnp.float32)[:, None], (rows, GRID_W)).reshape(-1)
    col = jnp.broadcast_to(jnp.arange(GRID_W, dtype=jnp.float32)[None, :], (rows, GRID_W)).reshape(-1)
    inv_freq = jnp.power(ROPE_BASE, -jnp.arange(0, ROPE_AXIS_DIM, 2, dtype=jnp.float32) / ROPE_AXIS_DIM)
    ang_r = row[:, None, None] * inv_freq
    ang_c = col[:, None, None] * inv_freq
    return (jnp.cos(ang_r).astype(dtype), jnp.sin(ang_r).astype(dtype),
            jnp.cos(ang_c).astype(dtype), jnp.sin(ang_c).astype(dtype))


def rotate_half_pairs(x, cos, sin):
    x1, x2 = jnp.split(x, 2, axis=-1)
    return jnp.concatenate([x1 * cos - x2 * sin, x2 * cos + x1 * sin], axis=-1)


def axial_rope(x, rope):
    cos_r, sin_r, cos_c, sin_c = rope
    x_row, x_col = jnp.split(x, 2, axis=-1)
    return jnp.concatenate([rotate_half_pairs(x_row, cos_r, sin_r), rotate_half_pairs(x_col, cos_c, sin_c)], axis=-1)


def mla_project(cq, ckv, kpe, q_norm_g, kv_norm_g, w_uq, w_ukv, rope):
    b, l, _ = cq.shape
    q = (rms_norm(cq, q_norm_g) @ w_uq).reshape(b, l, N_HEADS, QK_NOPE_DIM + QK_ROPE_DIM)
    kv = (rms_norm(ckv, kv_norm_g) @ w_ukv).reshape(b, l, N_HEADS, QK_NOPE_DIM + V_HEAD_DIM)
    q_nope, q_pe = jnp.split(q, [QK_NOPE_DIM], axis=-1)
    k_nope, v = jnp.split(kv, [QK_NOPE_DIM], axis=-1)
    k_pe = kpe[:, :, None, :]
    if rope is not None:
        q_pe = axial_rope(q_pe, rope)
        k_pe = axial_rope(k_pe, rope)
    k_pe = jnp.broadcast_to(k_pe, (b, l, N_HEADS, QK_ROPE_DIM))
    q = jnp.concatenate([q_nope, q_pe], axis=-1)
    k = jnp.concatenate([k_nope, k_pe], axis=-1)
    return q.transpose(0, 2, 1, 3), k.transpose(0, 2, 1, 3), v.transpose(0, 2, 1, 3)


def block_attention(q, k, v):
    b, h, lq, dk = q.shape
    nblk = lq // Q_BLOCK
    scale = dk ** -0.5
    qb = jnp.moveaxis(q.reshape(b, h, nblk, Q_BLOCK, dk), 2, 0)

    def attend(qi):
        s = jnp.einsum('bhqd,bhkd->bhqk', qi, k).astype(jnp.float32) * scale
        p = jax.nn.softmax(s, axis=-1).astype(v.dtype)
        return jnp.einsum('bhqk,bhkd->bhqd', p, v)

    o = lax.map(attend, qb)
    return jnp.moveaxis(o, 0, 2).reshape(b, h, lq, v.shape[-1])


def s5_discretize(a_re, a_im, log_dt, b_re, b_im):
    a_re = a_re.astype(jnp.float32)
    a_im = a_im.astype(jnp.float32)
    b_re = b_re.astype(jnp.float32)
    b_im = b_im.astype(jnp.float32)
    dt = jnp.exp(log_dt.astype(jnp.float32))[:, None]
    mag = jnp.exp(a_re * dt)
    ab_re = mag * jnp.cos(a_im * dt)
    ab_im = mag * jnp.sin(a_im * dt)
    den = a_re * a_re + a_im * a_im
    f_re = ((ab_re - 1.0) * a_re + ab_im * a_im) / den
    f_im = (ab_im * a_re - (ab_re - 1.0) * a_im) / den
    bb_re = f_re[..., None] * b_re - f_im[..., None] * b_im
    bb_im = f_re[..., None] * b_im + f_im[..., None] * b_re
    return ab_re, ab_im, bb_re, bb_im


def s5_scan(u, ab_re, ab_im, bb_re, bb_im, h0_re, h0_im):
    bu_re = jnp.einsum('blgc,gpc->blgp', u, bb_re)
    bu_im = jnp.einsum('blgc,gpc->blgp', u, bb_im)
    bu_re = bu_re.at[:, 0].add(ab_re * h0_re - ab_im * h0_im)
    bu_im = bu_im.at[:, 0].add(ab_re * h0_im + ab_im * h0_re)
    shape = (1, u.shape[1]) + ab_re.shape
    a_re = jnp.broadcast_to(ab_re, shape)
    a_im = jnp.broadcast_to(ab_im, shape)

    def combine(e1, e2):
        a1r, a1i, b1r, b1i = e1
        a2r, a2i, b2r, b2i = e2
        return (a2r * a1r - a2i * a1i, a2r * a1i + a2i * a1r,
                a2r * b1r - a2i * b1i + b2r, a2r * b1i + a2i * b1r + b2i)

    _, _, h_re, h_im = lax.associative_scan(combine, (a_re, a_im, bu_re, bu_im), axis=1)
    return h_re, h_im


def s5_readout(h_re, h_im, c_re, c_im):
    return jnp.einsum('blgp,gcp->blgc', h_re, c_re) - jnp.einsum('blgp,gcp->blgc', h_im, c_im)


def s5_mixer(u_lat, u_ctx, a_re, a_im, log_dt, b_re, b_im, c_re, c_im, d_skip, need_ctx):
    bsz, l_lat, _ = u_lat.shape
    l_ctx = u_ctx.shape[1]
    ul = u_lat.astype(jnp.float32).reshape(bsz, l_lat, S5_GROUPS, S5_GROUP)
    uc = u_ctx.astype(jnp.float32).reshape(bsz, l_ctx, S5_GROUPS, S5_GROUP)
    dk = d_skip.astype(jnp.float32).reshape(S5_GROUPS, S5_GROUP)
    zeros = jnp.zeros((bsz, S5_GROUPS, S5_STATE), jnp.float32)
    y_lat = dk * ul
    y_ctx = dk * uc if need_ctx else None
    for direction in range(2):
        ab_re, ab_im, bb_re, bb_im = s5_discretize(a_re[direction], a_im[direction], log_dt[direction],
                                                   b_re[direction], b_im[direction])
        cr = c_re[direction].astype(jnp.float32)
        ci = c_im[direction].astype(jnp.float32)
        flip = direction == 1
        uc_d = jnp.flip(uc, axis=1) if flip else uc
        ul_d = jnp.flip(ul, axis=1) if flip else ul
        hc_re, hc_im = s5_scan(uc_d, ab_re, ab_im, bb_re, bb_im, zeros, zeros)
        hl_re, hl_im = s5_scan(ul_d, ab_re, ab_im, bb_re, bb_im, hc_re[:, -1], hc_im[:, -1])
        yl = s5_readout(hl_re, hl_im, cr, ci)
        y_lat = y_lat + (jnp.flip(yl, axis=1) if flip else yl)
        if need_ctx:
            yc = s5_readout(hc_re, hc_im, cr, ci)
            y_ctx = y_ctx + (jnp.flip(yc, axis=1) if flip else yc)
    y_lat = y_lat.reshape(bsz, l_lat, S5_WIDTH).astype(u_lat.dtype)
    if need_ctx:
        y_ctx = y_ctx.reshape(bsz, l_ctx, S5_WIDTH).astype(u_ctx.dtype)
    return y_lat, y_ctx


def branch_merge(att, s5_y, gate_mla, gate_s5, w_glu, w_out):
    b, h, l, dv = att.shape
    att = att.transpose(0, 2, 1, 3).reshape(b, l, h * dv)
    glu_a, glu_b = jnp.split(jax.nn.gelu(s5_y) @ w_glu, 2, axis=-1)
    s5_out = glu_a * jax.nn.sigmoid(glu_b)
    merged = jax.nn.sigmoid(gate_mla) * att + jax.nn.sigmoid(gate_s5) * s5_out
    return merged @ w_out


def peer(h, wq, keys, u_tab, v_tab):
    b, l, d = h.shape
    blocks = h.reshape(-1, TOKEN_BLOCK, d)

    def retrieve(xb):
        q = (xb @ wq).reshape(TOKEN_BLOCK, PEER_HEADS, 2, PEER_HALF)
        s = jnp.einsum('thzd,hznd->thzn', q, keys).astype(jnp.float32)
        sv, si = lax.top_k(s, PEER_TOPK)
        cand_s = (sv[:, :, 0, :, None] + sv[:, :, 1, None, :]).reshape(TOKEN_BLOCK, PEER_HEADS, PEER_TOPK * PEER_TOPK)
        cand_e = (si[:, :, 0, :, None] * PEER_N_KEYS + si[:, :, 1, None, :]).reshape(TOKEN_BLOCK, PEER_HEADS, PEER_TOPK * PEER_TOPK)
        top_s, top_pos = lax.top_k(cand_s, PEER_TOPK)
        experts = jnp.take_along_axis(cand_e, top_pos, axis=-1)
        g = jax.nn.softmax(top_s, axis=-1).astype(xb.dtype)
        act = jax.nn.gelu(jnp.einsum('thkd,td->thk', u_tab[experts], xb))
        return jnp.einsum('thk,thkd->td', g * act, v_tab[experts])

    return lax.map(retrieve, blocks).reshape(b, l, d)


def setup_inputs(seed: int = 0) -> dict:
    key = jax.random.key(seed)
    ks = jax.random.split(key, 29)
    f32 = jnp.float32

    def nrm(i, shape, scale):
        return jax.random.normal(ks[i], shape, f32) * scale

    G, P, C = S5_GROUPS, S5_STATE, S5_GROUP
    n_idx = jnp.arange(P, dtype=f32)
    return {
        'x': nrm(0, (BATCH, SEQ, D_MODEL), 1.0),
        'c': nrm(1, (BATCH, D_MODEL), 1.0),
        'ctx': nrm(2, (BATCH, CTX_LEN, D_MODEL), 1.0),
        'c_ctx': nrm(3, (D_MODEL,), 1.0),
        'w_mod': nrm(4, (DEPTH, D_MODEL, N_MOD * D_MODEL), 0.5 * D_MODEL ** -0.5),
        'b_mod': nrm(5, (DEPTH, N_MOD * D_MODEL), 0.01),
        'w_in': nrm(6, (DEPTH, D_MODEL, IN_WIDTH), D_MODEL ** -0.5),
        'q_norm_g': 1.0 + nrm(7, (DEPTH, Q_RANK), 0.02),
        'kv_norm_g': 1.0 + nrm(8, (DEPTH, KV_RANK), 0.02),
        'w_uq': nrm(9, (DEPTH, Q_RANK, N_HEADS * (QK_NOPE_DIM + QK_ROPE_DIM)), Q_RANK ** -0.5),
        'w_ukv': nrm(10, (DEPTH, KV_RANK, N_HEADS * (QK_NOPE_DIM + V_HEAD_DIM)), KV_RANK ** -0.5),
        's5_a_re': -0.5 + nrm(11, (DEPTH, 2, G, P), 0.01),
        's5_a_im': math.pi * n_idx + nrm(12, (DEPTH, 2, G, P), 0.01),
        's5_log_dt': jax.random.uniform(ks[13], (DEPTH, 2, G), f32, math.log(S5_DT_MIN), math.log(S5_DT_MAX)),
        's5_b_re': nrm(14, (DEPTH, 2, G, P, C), (2.0 * C) ** -0.5),
        's5_b_im': nrm(15, (DEPTH, 2, G, P, C), (2.0 * C) ** -0.5),
        's5_c_re': nrm(16, (DEPTH, 2, G, C, P), 2.0 ** -0.5),
        's5_c_im': nrm(17, (DEPTH, 2, G, C, P), 2.0 ** -0.5),
        's5_d': nrm(18, (DEPTH, S5_WIDTH), 1.0),
        'w_glu': nrm(19, (DEPTH, S5_WIDTH, 2 * D_MODEL), S5_WIDTH ** -0.5),
        'w_out': nrm(20, (DEPTH, D_MODEL, D_MODEL), DEEPNORM_BETA * D_MODEL ** -0.5),
        'ln1_g': 1.0 + nrm(21, (DEPTH, D_MODEL), 0.02),
        'ln1_b': nrm(22, (DEPTH, D_MODEL), 0.02),
        'peer_wq': nrm(23, (DEPTH, D_MODEL, PEER_HEADS * PEER_QUERY_DIM), D_MODEL ** -0.5),
        'peer_keys': nrm(24, (DEPTH, PEER_HEADS, 2, PEER_N_KEYS, PEER_HALF), PEER_HALF ** -0.5),
        'peer_u': nrm(25, (DEPTH, PEER_EXPERTS, D_MODEL), D_MODEL ** -0.5),
        'peer_v': nrm(26, (DEPTH, PEER_EXPERTS, D_MODEL), DEEPNORM_BETA),
        'ln2_g': 1.0 + nrm(27, (DEPTH, D_MODEL), 0.02),
        'ln2_b': nrm(28, (DEPTH, D_MODEL), 0.02),
    }


def reference(x, c, ctx, c_ctx, w_mod, b_mod, w_in, q_norm_g, kv_norm_g, w_uq, w_ukv,
              s5_a_re, s5_a_im, s5_log_dt, s5_b_re, s5_b_im, s5_c_re, s5_c_im, s5_d, w_glu,
              w_out, ln1_g, ln1_b, peer_wq, peer_keys, peer_u, peer_v, ln2_g, ln2_b):
    rows = x.shape[1] // GRID_W
    rope = axial_rope_tables(rows, x.dtype)
    h_lat, h_ctx = x, ctx
    for layer in range(DEPTH):
        need_ctx = layer < DEPTH - 1
        sh_a, sc_a, g_a, sh_f, sc_f, g_f = modulation(c, w_mod[layer], b_mod[layer])
        csh_a, csc_a, cg_a, csh_f, csc_f, cg_f = modulation(c_ctx, w_mod[layer], b_mod[layer])

        z_lat = modulate(h_lat, sh_a, sc_a) @ w_in[layer]
        z_ctx = modulate(h_ctx, csh_a, csc_a) @ w_in[layer]
        cq_l, ckv_l, kpe_l, su_l, gm_l, gs_l = jnp.split(z_lat, IN_SPLIT_POINTS, axis=-1)
        cq_c, ckv_c, kpe_c, su_c, gm_c, gs_c = jnp.split(z_ctx, IN_SPLIT_POINTS, axis=-1)

        q_l, k_l, v_l = mla_project(cq_l, ckv_l, kpe_l, q_norm_g[layer], kv_norm_g[layer], w_uq[layer], w_ukv[layer], rope)
        q_c, k_c, v_c = mla_project(cq_c, ckv_c, kpe_c, q_norm_g[layer], kv_norm_g[layer], w_uq[layer], w_ukv[layer], None)
        att_lat = block_attention(q_l, jnp.concatenate([k_c, k_l], axis=2), jnp.concatenate([v_c, v_l], axis=2))

        s5_lat, s5_ctx = s5_mixer(su_l, su_c, s5_a_re[layer], s5_a_im[layer], s5_log_dt[layer],
                                  s5_b_re[layer], s5_b_im[layer], s5_c_re[layer], s5_c_im[layer],
                                  s5_d[layer], need_ctx)

        out_lat = branch_merge(att_lat, s5_lat, gm_l, gs_l, w_glu[layer], w_out[layer])
        h_lat = layer_norm(DEEPNORM_ALPHA * h_lat + g_a * out_lat, ln1_g[layer], ln1_b[layer])

        if need_ctx:
            att_ctx = block_attention(q_c, k_c, v_c)
            out_ctx = branch_merge(att_ctx, s5_ctx, gm_c, gs_c, w_glu[layer], w_out[layer])
            h_ctx = layer_norm(DEEPNORM_ALPHA * h_ctx + cg_a * out_ctx, ln1_g[layer], ln1_b[layer])
            f_ctx = peer(modulate(h_ctx, csh_f, csc_f), peer_wq[layer], peer_keys[layer], peer_u[layer], peer_v[layer])
            h_ctx = layer_norm(DEEPNORM_ALPHA * h_ctx + cg_f * f_ctx, ln2_g[layer], ln2_b[layer])

        f_lat = peer(modulate(h_lat, sh_f, sc_f), peer_wq[layer], peer_keys[layer], peer_u[layer], peer_v[layer])
        h_lat = layer_norm(DEEPNORM_ALPHA * h_lat + g_f * f_lat, ln2_g[layer], ln2_b[layer])
    return h_lat
```

```cpp
#include <hip/hip_runtime.h>
#include <cstdio>
#include <cstdint>

#define GAS __attribute__((address_space(1)))
#define LAS __attribute__((address_space(3)))
typedef unsigned short bf16_t;
typedef short bf16x8 __attribute__((ext_vector_type(8)));
typedef short s16x4 __attribute__((ext_vector_type(4)));
typedef short v4i16_t __attribute__((ext_vector_type(4)));
typedef float f32x2 __attribute__((ext_vector_type(2)));
typedef float f32x4 __attribute__((ext_vector_type(4)));
typedef float f32x16 __attribute__((ext_vector_type(16)));
typedef unsigned u32x2 __attribute__((ext_vector_type(2)));
typedef unsigned u32x4 __attribute__((ext_vector_type(4)));


#ifndef MK_FSCALE
#define MK_FSCALE (1.f)
#endif
#ifndef MK_STAGE
#define MK_STAGE 99
#endif
#ifndef MK_N_LAUNCHES
#define MK_N_LAUNCHES 1
#endif

constexpr int DM = 1024, NB = 16, SEQ = 2048, CTXL = 256, MLAT = NB * SEQ, MCTX = NB * CTXL, MTOT = MLAT + MCTX;
constexpr int NH = 8, DK = 192, DV = 128, QRANK = 384, KVRANK = 256, NKEY = CTXL + SEQ;
constexpr int INW = 3264;
constexpr int S5W = 512, S5G = 32, S5C = 16, S5P = 64;
constexpr int PEH = 8, PEK = 128, PEXP = 16384, PETOP = 16;
constexpr float LN_EPS = 1e-6f;
constexpr float ALPHA = 1.189207115002721f;
constexpr float QSCALE = 0.07216878364870322f * 1.4426950408889634f;

constexpr size_t MiB = 1u << 20;
constexpr size_t WS_CTL = 0, CTL_ZERO_BYTES = 64 * 1024;
constexpr size_t WS_MOD = 1 * MiB;
constexpr size_t WS_S5ABAR = 1 * MiB + 512 * 1024;
constexpr size_t WS_S5POW = WS_S5ABAR + 32768;
constexpr size_t WS_S5BB = WS_S5POW + 65536;
constexpr size_t WS_S5CM = WS_S5BB + 262144;
constexpr size_t WS_ROPE = WS_S5CM + 262144;
constexpr size_t WS_PART = 3 * MiB;
constexpr size_t WS_S5E = 6 * MiB;
constexpr size_t WS_WIN = 10 * MiB;
constexpr size_t WS_WUQ = WS_WIN + 3328 * 1024 * 2;
constexpr size_t WS_WUKV = WS_WUQ + 1536 * 384 * 2;
constexpr size_t WS_WGLU = WS_WUKV + 2048 * 256 * 2;
constexpr size_t WS_WOUT = WS_WGLU + 2048 * 512 * 2;
constexpr size_t WS_WQ = WS_WOUT + 1024 * 1024 * 2;
constexpr size_t WS_KEYS = WS_WQ + 2048 * 1024 * 2;
static_assert(WS_KEYS + 16 * 128 * 128 * 2 <= 28 * MiB, "weights region");
constexpr size_t WS_ZQ = 28 * MiB;
constexpr size_t WS_Y = 28 * MiB;
constexpr size_t WS_PU = 28 * MiB, WS_PV = 60 * MiB;
constexpr size_t WS_SU = 82 * MiB;
constexpr size_t WS_GATES = 118 * MiB;
constexpr size_t WS_XM2 = 118 * MiB;
constexpr size_t WS_PQ = 182 * MiB;
constexpr size_t WS_XM = 246 * MiB;
constexpr size_t WS_V = 246 * MiB;
constexpr size_t WS_MERGED = 246 * MiB;
constexpr size_t WS_Q = 318 * MiB;
constexpr size_t WS_T = 318 * MiB;
constexpr size_t WS_KN = 414 * MiB;
constexpr size_t WS_KPE = 486 * MiB;
constexpr size_t WS_ROUTE = 448 * MiB;
constexpr size_t WS_END = 492 * MiB;

#define RLX_AGENT __ATOMIC_RELAXED, __HIP_MEMORY_SCOPE_AGENT
#define LDS_WAIT() asm volatile("s_waitcnt lgkmcnt(0)" ::: "memory")
#define VM_WAIT() asm volatile("s_waitcnt vmcnt(0)" ::: "memory")
typedef __bf16 bf16x2_t __attribute__((ext_vector_type(2)));
__device__ __forceinline__ unsigned cvt_pk_bf16(float lo, float hi) { const f32x2 v = {lo, hi}; const bf16x2_t b = __builtin_convertvector(v, bf16x2_t); return __builtin_bit_cast(unsigned, b); }
__device__ __forceinline__ float bf_lo(unsigned u) { return __builtin_bit_cast(float, u << 16); }
__device__ __forceinline__ float bf_hi(unsigned u) { return __builtin_bit_cast(float, u & 0xffff0000u); }
__device__ __forceinline__ float wave_sum(float v) {
#pragma unroll
    for (int o = 1; o < 64; o <<= 1) v += __shfl_xor(v, o);
    return v;
}
__device__ __forceinline__ int lane_id_fresh() { unsigned z; asm volatile("s_mov_b32 %0, 0" : "=s"(z)); return (int)__builtin_amdgcn_mbcnt_hi(~0u, __builtin_amdgcn_mbcnt_lo(~0u, z)); }
__device__ __forceinline__ float sigmoidf_(float x) { return __builtin_amdgcn_rcpf(1.f + __expf(-x)); }
__device__ __forceinline__ float gelu_tanh(float x) {
    const float u = 0.7978845608028654f * (x + 0.044715f * x * x * x);
    return x * __builtin_amdgcn_rcpf(1.f + __expf(-2.f * u));
}

#define MFMA32(a, b, c) __builtin_amdgcn_mfma_f32_32x32x16_bf16(a, b, c, 0, 0, 0)
#define MFMA_PAD() do { __builtin_amdgcn_sched_barrier(0); asm volatile("s_nop 15\n\ts_nop 15\n\ts_nop 15\n\ts_nop 15\n\ts_nop 15\n\ts_nop 15" ::: "memory"); __builtin_amdgcn_sched_barrier(0); } while (0)

namespace pg8 {
constexpr int BM = 256, BK = 64, HALF = 128, HTB = HALF * BK * 2, STAGE_BYTES = 8 * HTB, NXCD = 8, WGM = 8;
__host__ __device__ __forceinline__ int lds_byte(int r, int c) { const int st = (r >> 4) * 2 + (c >> 5), rr = r & 15, cc = c & 31, ob = rr * 64 + cc * 2; return st * 1024 + (ob ^ (((ob >> 9) & 1) << 5)); }
__host__ __device__ __forceinline__ void stage_rc(int b, int& R, int& C) { const int st = b / 1024, sb = b % 1024, swz = sb ^ (((sb >> 9) & 1) << 5); R = (st >> 1) * 16 + swz / 64; C = (st & 1) * 32 + (swz % 64) / 2; }
__host__ __device__ __forceinline__ int perm32(int rho) { const int n = rho >> 4, i = rho & 15; return 8 * (i >> 2) + 4 * n + (i & 3); }
struct Unit { int pm, pn; };
struct Gemm { const bf16_t* A; const bf16_t* Bt; int lda, ldb, K; };
struct StaticOrder {
    int nM, nN, nwg, G, c, nM2, nN2, pm0;
    __device__ void init(int nM_, int nN_, int G_, int c_, int nM2_ = 0, int nN2_ = 0) { nM = nM_; nN = nN_; nwg = nM * nN; G = G_; c = c_; nM2 = nM2_; nN2 = nN2_; pm0 = nM_; }
    __device__ bool next(int i, Unit& u) const {
        const long L = (long)i * G + c;
        if (L >= nwg) { const int e = (int)(L - nwg); if (e >= nM2 * nN2) return false; u.pm = pm0 + e % nM2; u.pn = e / nM2; return true; }
        int wgid = (int)L; { const int q = nwg / NXCD, r = nwg % NXCD, xcd = wgid % NXCD, off = wgid / NXCD; wgid = (xcd < r ? xcd * (q + 1) : r * (q + 1) + (xcd - r) * q) + off; }
        const int nig = WGM * nN, gid = wgid / nig, fm = gid * WGM, gsz = (nM - fm) < WGM ? (nM - fm) : WGM;
        u.pm = fm + ((wgid % nig) % gsz); u.pn = (wgid % nig) / gsz; return true;
    }
};

template <class Epi, class Sched>
__device__ __forceinline__ void gemm_phase(LAS unsigned char* lds, const Gemm g, const Sched& S, const Epi& E, int tid_) {
    asm volatile("" : "+v"(tid_));
    const int tid = tid_, wid = __builtin_amdgcn_readfirstlane(tid >> 6), lane = tid & 63, wr = wid >> 2, wc = wid & 3, fr = lane & 15, fq = lane >> 4;
    const int K = g.K, nt = K / BK;
    unsigned voffA[2], voffB[2];
#pragma unroll
    for (int i = 0; i < 2; ++i) { int R, C; stage_rc(tid * 16 + i * 8192, R, C); const int Rb = Epi::PERM ? ((R & ~31) + perm32(R & 31)) : R;
        voffA[i] = (unsigned)(R * g.lda + C) * 2u; voffB[i] = (unsigned)(Rb * g.ldb + C) * 2u; }
    const size_t kstep = (size_t)(BK * 2);
    const size_t hstepA = (size_t)HALF * g.lda * 2, hstepB = (size_t)HALF * g.ldb * 2;
    const size_t tstepA = 2 * hstepA, tstepB = 2 * hstepB;
    const unsigned ldsw = (unsigned)wid * 1024u;
    const int aoff = lds_byte(wr * 64 + fr, fq * 8), boff = lds_byte(wc * 32 + fr, fq * 8);
#define PG8_SA(b, h) (((b) * 2 + (h)) * HTB)
#define PG8_SB(b, h) ((4 + (b) * 2 + (h)) * HTB)
#define PG8_STAGE(bufoff, gbase, voff) do { _Pragma("unroll") for (int _i = 0; _i < 2; ++_i) \
        __builtin_amdgcn_global_load_lds((const unsigned*)((const char*)(gbase) + (voff)[_i]), (LAS unsigned*)(lds + (bufoff) + ldsw + _i * 8192), 16, 0, 0); } while (0)
#define PG8_LDA(dst, b, h) do { _Pragma("unroll") for (int m = 0; m < 4; ++m) _Pragma("unroll") for (int k = 0; k < 2; ++k) dst[m][k] = *(const LAS bf16x8*)(lds + PG8_SA(b, h) + aoff + m * 2048 + k * 1024); } while (0)
#define PG8_LDB(dst, b, h) do { _Pragma("unroll") for (int n = 0; n < 2; ++n) _Pragma("unroll") for (int k = 0; k < 2; ++k) dst[n][k] = *(const LAS bf16x8*)(lds + PG8_SB(b, h) + boff + n * 2048 + k * 1024); } while (0)
#define PG8_MMA(ai, bj, At, Bt) do { __builtin_amdgcn_s_setprio(1); _Pragma("unroll") for (int m = 0; m < 4; ++m) _Pragma("unroll") for (int n = 0; n < 2; ++n) _Pragma("unroll") for (int k = 0; k < 2; ++k) \
        acc[ai][bj][m][n] = __builtin_amdgcn_mfma_f32_16x16x32_bf16(Bt[n][k], At[m][k], acc[ai][bj][m][n], 0, 0, 0); __builtin_amdgcn_s_setprio(0); } while (0)
#define PG8_WAIT_V(n) asm volatile("s_waitcnt vmcnt(" #n ")" ::: "memory")
#define PG8_WAIT_L(n) asm volatile("s_waitcnt lgkmcnt(" #n ")" ::: "memory")
#define PG8_BAR __builtin_amdgcn_s_barrier()
#define PG8_SCHED __builtin_amdgcn_sched_barrier(0)
    Unit cur, nxt; int ui = 0;
    if (!S.next(0, cur)) return;
    f32x4 acc[2][2][4][2];
#pragma unroll
    for (int a = 0; a < 2; ++a)
#pragma unroll
        for (int b = 0; b < 2; ++b)
#pragma unroll
            for (int m = 0; m < 4; ++m)
#pragma unroll
                for (int n = 0; n < 2; ++n) acc[a][b][m][n] = (f32x4){0.f, 0.f, 0.f, 0.f};
    bf16x8 At[4][2], B0[2][2], B1[2][2];
    const char* cA = (const char*)g.A + (size_t)cur.pm * tstepA; const char* cB = (const char*)g.Bt + (size_t)cur.pn * tstepB;
    PG8_STAGE(PG8_SB(0, 0), cB, voffB); PG8_STAGE(PG8_SB(0, 1), cB + hstepB, voffB); PG8_STAGE(PG8_SA(0, 0), cA, voffA); PG8_STAGE(PG8_SA(0, 1), cA + hstepA, voffA);
    if (wr == 1) PG8_BAR;
    PG8_WAIT_V(2); PG8_BAR;
    PG8_STAGE(PG8_SB(1, 0), cB + kstep, voffB); PG8_STAGE(PG8_SA(1, 0), cA + kstep, voffA); PG8_STAGE(PG8_SB(1, 1), cB + hstepB + kstep, voffB);
    PG8_WAIT_V(6); PG8_BAR;
    for (;;) {
        const bool has_next = S.next(ui + 1, nxt);
        const char* nA = has_next ? (const char*)g.A + (size_t)nxt.pm * tstepA : cA; const char* nB = has_next ? (const char*)g.Bt + (size_t)nxt.pn * tstepB : cB;
        for (int t = 0; t < nt; t += 2) {
            const bool last = (t == nt - 2);
            const char* a1 = cA + (size_t)(t + 1) * kstep;
            const char* a2 = last ? nA : cA + (size_t)(t + 2) * kstep; const char* b2 = last ? nB : cB + (size_t)(t + 2) * kstep;
            const char* a3 = a2 + kstep; const char* b3 = b2 + kstep;
            PG8_LDB(B0, 0, 0); PG8_LDB(B1, 0, 1); PG8_SCHED; PG8_LDA(At, 0, 0); PG8_STAGE(PG8_SA(1, 1), a1 + hstepA, voffA);
            PG8_WAIT_V(8); PG8_WAIT_L(0); PG8_BAR; PG8_MMA(0, 0, At, B0); PG8_MMA(0, 1, At, B1); PG8_BAR; PG8_SCHED;
            PG8_LDA(At, 0, 1); PG8_STAGE(PG8_SB(0, 0), b2, voffB); PG8_STAGE(PG8_SB(0, 1), b2 + hstepB, voffB); PG8_STAGE(PG8_SA(0, 0), a2, voffA);
            PG8_WAIT_V(8); PG8_WAIT_L(0); PG8_BAR; PG8_MMA(1, 0, At, B0); PG8_MMA(1, 1, At, B1); PG8_BAR; PG8_SCHED;
            PG8_LDB(B0, 1, 0); PG8_LDB(B1, 1, 1); PG8_SCHED; PG8_LDA(At, 1, 0); PG8_STAGE(PG8_SA(0, 1), a2 + hstepA, voffA);
            PG8_WAIT_V(8); PG8_WAIT_L(0); PG8_BAR; PG8_MMA(0, 0, At, B0); PG8_MMA(0, 1, At, B1); PG8_BAR; PG8_SCHED;
            PG8_LDA(At, 1, 1); PG8_STAGE(PG8_SB(1, 0), b3, voffB); PG8_STAGE(PG8_SB(1, 1), b3 + hstepB, voffB); PG8_STAGE(PG8_SA(1, 0), a3, voffA);
            PG8_WAIT_V(8); PG8_WAIT_L(0); PG8_BAR; PG8_MMA(1, 0, At, B0); PG8_MMA(1, 1, At, B1); PG8_BAR; PG8_SCHED;
        }
        if (wr == 0) PG8_BAR;
        MFMA_PAD();
        { const int l2 = lane_id_fresh(); E(acc, cur, wr, wc, l2 & 15, l2 >> 4); }
        if (!has_next) break;
#pragma unroll
        for (int a = 0; a < 2; ++a)
#pragma unroll
            for (int b = 0; b < 2; ++b)
#pragma unroll
                for (int m = 0; m < 4; ++m)
#pragma unroll
                    for (int n = 0; n < 2; ++n) acc[a][b][m][n] = (f32x4){0.f, 0.f, 0.f, 0.f};
        cur = nxt; cA = nA; cB = nB; ++ui;
        if (wr == 1) PG8_BAR;
    }
    PG8_WAIT_V(0);
    PG8_BAR;
#undef PG8_SA
#undef PG8_SB
#undef PG8_STAGE
#undef PG8_LDA
#undef PG8_LDB
#undef PG8_MMA
#undef PG8_WAIT_V
#undef PG8_WAIT_L
#undef PG8_BAR
#undef PG8_SCHED
}
}

typedef f32x4 acc_t[2][2][4][2];
__device__ __forceinline__ u32x4 pack8(const f32x4 a, const f32x4 b) { u32x4 w; w.x = cvt_pk_bf16(a[0], a[1]); w.y = cvt_pk_bf16(a[2], a[3]); w.z = cvt_pk_bf16(b[0], b[1]); w.w = cvt_pk_bf16(b[2], b[3]); return w; }

struct EpiInProj { static constexpr bool PERM = true;
    bf16_t* ZQ; bf16_t* SU; bf16_t* GATES; float* PART;
    __device__ __forceinline__ void operator()(const acc_t& acc, const pg8::Unit& u, int wr, int wc, int fr, int fq) const {
        const int row0 = u.pm * 256 + wr * 64 + fr, pn = u.pn;
#pragma unroll
        for (int ai = 0; ai < 2; ++ai)
#pragma unroll
            for (int m = 0; m < 4; ++m) { const int row = row0 + ai * 128 + m * 16;
#pragma unroll
                for (int bj = 0; bj < 2; ++bj) { f32x4 v0 = acc[ai][bj][m][0], v1 = acc[ai][bj][m][1]; const int c0 = bj * 128 + wc * 32 + 8 * fq;
                    if (pn < 3) {
                        *(u32x4*)(ZQ + (size_t)row * 768 + pn * 256 + c0) = pack8(v0, v1);
                        float ss = (v0[0] * v0[0] + v0[1] * v0[1]) + (v0[2] * v0[2] + v0[3] * v0[3]) + (v1[0] * v1[0] + v1[1] * v1[1]) + (v1[2] * v1[2] + v1[3] * v1[3]);
                        ss += __shfl_xor(ss, 16); ss += __shfl_xor(ss, 32);
                        const int slot = pn * 2 + bj;
                        if (fq == 0 && slot < 5) PART[(size_t)row * 20 + slot * 4 + wc] = ss;
                    } else if (pn < 5) {
                        *(u32x4*)(SU + (size_t)row * 512 + (pn - 3) * 256 + c0) = pack8(v0, v1);
                    } else {
#pragma unroll
                        for (int e = 0; e < 4; ++e) { v0[e] = sigmoidf_(v0[e]); v1[e] = sigmoidf_(v1[e]); }
                        *(u32x4*)(GATES + (size_t)row * 2048 + (pn - 5) * 256 + c0) = pack8(v0, v1);
                    } } }
    }
};
struct EpiUQ { static constexpr bool PERM = true;
    bf16_t* Q; const float* PART;
    __device__ __forceinline__ void operator()(const acc_t& acc, const pg8::Unit& u, int wr, int wc, int fr, int fq) const {
        asm volatile("" : "+v"(fr), "+v"(fq));
        const int row0 = u.pm * 256 + wr * 64 + fr;
#pragma unroll
        for (int ai = 0; ai < 2; ++ai)
#pragma unroll
            for (int m = 0; m < 4; ++m) { asm volatile("" ::: "memory"); const int row = row0 + ai * 128 + m * 16; const int b = row >> 11, l = row & 2047;
                const f32x4* pp = (const f32x4*)(PART + (size_t)row * 20); const f32x4 p0 = pp[0], p1 = pp[1], p2 = pp[2];
                const float ssq = ((p0[0] + p0[1]) + (p0[2] + p0[3])) + ((p1[0] + p1[1]) + (p1[2] + p1[3])) + ((p2[0] + p2[1]) + (p2[2] + p2[3]));
                const float sc = rsqrtf(ssq * (1.f / 384.f) + LN_EPS) * QSCALE;
#pragma unroll
                for (int bj = 0; bj < 2; ++bj) { const f32x4 v0 = acc[ai][bj][m][0] * sc, v1 = acc[ai][bj][m][1] * sc;
                    const int g0 = u.pn * 256 + bj * 128 + wc * 32;
                    const int head = g0 / 192, w0 = g0 - head * 192;
                    *(u32x4*)(Q + ((size_t)(b * NH + head) * SEQ + l) * DK + w0 + 8 * fq) = pack8(v0, v1);
                } }
    }
};
struct EpiUKV { static constexpr bool PERM = true;
    bf16_t* KN; bf16_t* V; const float* PART;
    __device__ __forceinline__ void operator()(const acc_t& acc, const pg8::Unit& u, int wr, int wc, int fr, int fq) const {
        asm volatile("" : "+v"(fr), "+v"(fq));
        const int row0 = u.pm * 256 + wr * 64 + fr;
#pragma unroll
        for (int ai = 0; ai < 2; ++ai)
#pragma unroll
            for (int m = 0; m < 4; ++m) { asm volatile("" ::: "memory"); const int row = row0 + ai * 128 + m * 16;
                int b, key; if (row < MLAT) { b = row >> 11; key = CTXL + (row & 2047); } else { const int r2 = row - MLAT; b = r2 >> 8; key = r2 & 255; }
                const f32x4* pp = (const f32x4*)(PART + (size_t)row * 20 + 12); const f32x4 p0 = pp[0], p1 = pp[1];
                const float ssq = ((p0[0] + p0[1]) + (p0[2] + p0[3])) + ((p1[0] + p1[1]) + (p1[2] + p1[3]));
                const float sc = rsqrtf(ssq * (1.f / 256.f) + LN_EPS);
#pragma unroll
                for (int bj = 0; bj < 2; ++bj) { const f32x4 v0 = acc[ai][bj][m][0] * sc, v1 = acc[ai][bj][m][1] * sc;
                    const int head = u.pn; bf16_t* dst = (bj == 0) ? KN : V;
                    *(u32x4*)(dst + ((size_t)(b * NH + head) * NKEY + key) * 128 + wc * 32 + 8 * fq) = pack8(v0, v1);
                } }
    }
};
struct EpiGLU { static constexpr bool PERM = true;
    const bf16_t* ATT; const bf16_t* GATES; bf16_t* MERGED;
    __device__ __forceinline__ void operator()(const acc_t& acc, const pg8::Unit& u, int wr, int wc, int fr, int fq) const {
        asm volatile("" : "+v"(fr), "+v"(fq));
        const int row0 = u.pm * 256 + wr * 64 + fr; const int head = u.pn, d0 = wc * 32 + 8 * fq, j0 = head * 128 + d0;
#pragma unroll
        for (int ai = 0; ai < 2; ++ai)
#pragma unroll
            for (int m = 0; m < 4; ++m) { asm volatile("" ::: "memory"); const int row = row0 + ai * 128 + m * 16; const int b = row >> 11, l = row & 2047;
                const u32x4 at = *(const u32x4*)(ATT + ((size_t)(b * NH + head) * SEQ + (l & ~255)) * DK + (l & 255) * 128 + d0);
                const u32x4 gs = *(const u32x4*)(GATES + (size_t)row * 2048 + 1024 + j0);
                const f32x4 a0 = acc[ai][0][m][0], a1 = acc[ai][0][m][1], b0 = acc[ai][1][m][0], b1 = acc[ai][1][m][1];
                f32x4 o0, o1;
#if MK_STAGE >= 3
#define GLU1(o, a, bb, atw, gsw, e0) o[e0] = bf_lo(atw) + bf_lo(gsw) * a[e0] * sigmoidf_(bb[e0]); o[e0 + 1] = bf_hi(atw) + bf_hi(gsw) * a[e0 + 1] * sigmoidf_(bb[e0 + 1]);
#else
#define GLU1(o, a, bb, atw, gsw, e0) o[e0] = bf_lo(atw) + 0.f * bf_lo(gsw) * a[e0] * bb[e0]; o[e0 + 1] = bf_hi(atw) + 0.f * bf_hi(gsw) * a[e0 + 1] * bb[e0 + 1];
#endif
                GLU1(o0, a0, b0, at.x, gs.x, 0) GLU1(o0, a0, b0, at.y, gs.y, 2) GLU1(o1, a1, b1, at.z, gs.z, 0) GLU1(o1, a1, b1, at.w, gs.w, 2)
#undef GLU1
                *(u32x4*)(MERGED + (size_t)row * 1024 + j0) = pack8(o0, o1);
            }
    }
};
struct EpiOut { static constexpr bool PERM = true;
    const float* X; const float* MOD; float* T;
    __device__ __forceinline__ void operator()(const acc_t& acc, const pg8::Unit& u, int wr, int wc, int fr, int fq) const {
        asm volatile("" : "+v"(fr), "+v"(fq));
        const int row0 = u.pm * 256 + wr * 64 + fr;
#pragma unroll
        for (int ai = 0; ai < 2; ++ai)
#pragma unroll
            for (int m = 0; m < 4; ++m) { asm volatile("" ::: "memory"); const int row = row0 + ai * 128 + m * 16; const int b = row >> 11;
#pragma unroll
                for (int bj = 0; bj < 2; ++bj) { const int c0 = u.pn * 256 + bj * 128 + wc * 32 + 8 * fq;
                    const f32x4* xp = (const f32x4*)(X + (size_t)row * DM + c0); const f32x4* gp = (const f32x4*)(MOD + (size_t)b * 6144 + 2048 + c0);
                    f32x4* tp = (f32x4*)(T + (size_t)row * DM + c0);
#if MK_STAGE >= 1
                    tp[0] = xp[0] * ALPHA + gp[0] * acc[ai][bj][m][0]; tp[1] = xp[1] * ALPHA + gp[1] * acc[ai][bj][m][1];
#else
                    tp[0] = xp[0] * ALPHA + gp[0] * acc[ai][bj][m][0] * 0.f; tp[1] = xp[1] * ALPHA + gp[1] * acc[ai][bj][m][1] * 0.f;
#endif
                } }
    }
};
struct EpiPQ { static constexpr bool PERM = true;
    bf16_t* PQ;
    __device__ __forceinline__ void operator()(const acc_t& acc, const pg8::Unit& u, int wr, int wc, int fr, int fq) const {
        asm volatile("" : "+v"(fr), "+v"(fq));
        const int row0 = u.pm * 256 + wr * 64 + fr;
#pragma unroll
        for (int ai = 0; ai < 2; ++ai)
#pragma unroll
            for (int m = 0; m < 4; ++m) { const int row = row0 + ai * 128 + m * 16;
#pragma unroll
                for (int bj = 0; bj < 2; ++bj) *(u32x4*)(PQ + (size_t)row * 2048 + u.pn * 256 + bj * 128 + wc * 32 + 8 * fq) = pack8(acc[ai][bj][m][0], acc[ai][bj][m][1]); }
    }
};

#define XB_TMO      128
#define XB_XCNT(j)  (256  + 64 * (j))
#define XB_XSUB(j)  (1280 + 64 * (j))
#define XB_XGEN(j)  (2304 + 64 * (j))
#define XB_TOP      3328
#define XB_TOPGEN   3392
#define XCD_BAR_WORDS 3456
#define XB_SPIN_CAP (1u << 22)
__device__ __forceinline__ unsigned xb_ld(unsigned* p)              { return __hip_atomic_load(p, __ATOMIC_RELAXED, __HIP_MEMORY_SCOPE_AGENT); }
__device__ __forceinline__ unsigned xb_add(unsigned* p, unsigned v) { return __hip_atomic_fetch_add(p, v, __ATOMIC_RELAXED, __HIP_MEMORY_SCOPE_AGENT); }
__device__ __forceinline__ unsigned xb_xcc_id() { return (unsigned)__builtin_amdgcn_s_getreg((3 << 11) | 20) & 0xFu; }
#define XB_SPIN(cond, bar) do { unsigned _sp = 0; while (cond) { __builtin_amdgcn_s_sleep(1); \
    if ((++_sp & 255u) == 0u) { if (xb_ld(&(bar)[XB_TMO])) break; if (_sp > XB_SPIN_CAP) { atomicAdd(&(bar)[XB_TMO], 1u); break; } } } } while (0)
struct XcdBarrier { unsigned* bar; unsigned x; volatile LAS unsigned* st; };
__device__ __forceinline__ XcdBarrier xcd_barrier_post(unsigned* bar, volatile LAS unsigned* st, int tid) {
    XcdBarrier b; b.bar = bar; b.x = xb_xcc_id(); b.st = st;
    if (tid == 0) (void)xb_add(&bar[XB_XCNT(b.x)], 1u);
    return b;
}
__device__ __forceinline__ void xcd_barrier_complete(unsigned* bar, unsigned x, unsigned& nloc, unsigned& nx) {
    const unsigned G = gridDim.x * gridDim.y * gridDim.z;
    unsigned sum, cnt, mine, sp = 0u;
    for (;;) {
        sum = 0u; cnt = 0u; mine = 0u;
#pragma unroll
        for (unsigned j = 0; j < 16; ++j) { const unsigned c = xb_ld(&bar[XB_XCNT(j)]); sum += c; cnt += (c > 0u) ? 1u : 0u; mine = (j == x) ? c : mine; }
        if (sum == G) break;
        __builtin_amdgcn_s_sleep(1);
        if ((++sp & 255u) == 0u) { if (xb_ld(&bar[XB_TMO])) break; if (sp > XB_SPIN_CAP) { atomicAdd(&bar[XB_TMO], 1u); break; } }
    }
    nloc = mine > 0u ? mine : 1u; nx = cnt > 0u ? cnt : 1u;
}
__device__ __forceinline__ void xcd_barrier(const XcdBarrier& b, int tid) {
    asm volatile("s_waitcnt vmcnt(0)" ::: "memory");
    __syncthreads();
    if (tid == 0) {
        unsigned* bar = b.bar;
        __builtin_amdgcn_s_waitcnt(0);
        unsigned nloc = b.st[0], nx = b.st[1];
        if (nloc == 0u) { xcd_barrier_complete(bar, b.x, nloc, nx); b.st[0] = nloc; b.st[1] = nx; }
        const unsigned old = xb_add(&bar[XB_XSUB(b.x)], 1u);
        const unsigned gen = old / nloc;
        if (old + 1u == (gen + 1u) * nloc) {
            __builtin_amdgcn_fence(__ATOMIC_RELEASE, "agent");
            asm volatile("s_waitcnt vmcnt(0)" ::: "memory");
            const unsigned og = xb_add(&bar[XB_TOP], 1u);
            const unsigned tg = og / nx;
            if (og + 1u == (tg + 1u) * nx) xb_add(&bar[XB_TOPGEN], 1u);
            else XB_SPIN(xb_ld(&bar[XB_TOPGEN]) == tg, bar);
            __builtin_amdgcn_fence(__ATOMIC_ACQUIRE, "agent");
            xb_add(&bar[XB_XGEN(b.x)], 1u);
            asm volatile("s_waitcnt vmcnt(0)" ::: "memory");
        } else {
            XB_SPIN(xb_ld(&bar[XB_XGEN(b.x)]) == gen, bar);
            __builtin_amdgcn_fence(__ATOMIC_ACQUIRE, "agent");
            asm volatile("s_waitcnt vmcnt(0)" ::: "memory");
        }
    }
    __syncthreads();
}

__device__ __forceinline__ void transpose_item(const float* W, int ldw, int k0, int nsrc0, bf16_t* WT, int ldt, int ndst0, const float* gk, LAS float* scr, int lane) {
    if (nsrc0 >= 0) {
#pragma unroll 8
        for (int i = 0; i < 32; ++i) { const int kk = 2 * i + (lane >> 5); float v = W[(size_t)(k0 + kk) * ldw + nsrc0 + (lane & 31)]; if (gk) v *= gk[k0 + kk]; scr[kk * 33 + (lane & 31)] = v; }
    } else {
#pragma unroll 8
        for (int i = 0; i < 32; ++i) { const int kk = 2 * i + (lane >> 5); scr[kk * 33 + (lane & 31)] = 0.f; }
    }
    LDS_WAIT(); asm volatile("" ::: "memory");
    const int c = lane & 7;
#pragma unroll
    for (int j = 0; j < 4; ++j) { const int n = (lane >> 3) + 8 * j; const LAS float* s = scr + (8 * c) * 33 + n;
        u32x4 o; o.x = cvt_pk_bf16(s[0 * 33], s[1 * 33]); o.y = cvt_pk_bf16(s[2 * 33], s[3 * 33]); o.z = cvt_pk_bf16(s[4 * 33], s[5 * 33]); o.w = cvt_pk_bf16(s[6 * 33], s[7 * 33]);
        *(u32x4*)(WT + (size_t)(ndst0 + n) * ldt + k0 + 8 * c) = o; }
    LDS_WAIT(); asm volatile("" ::: "memory");
}
__device__ __forceinline__ void modulate_row(const float* xrow, const float* sh, const float* sc, bf16_t* orow, int lane) {
    const f32x4* xr = (const f32x4*)xrow + lane; f32x4 v[4]; float s = 0.f;
#pragma unroll
    for (int j = 0; j < 4; ++j) { v[j] = xr[64 * j]; s += (v[j][0] + v[j][1]) + (v[j][2] + v[j][3]); }
    const float mean = wave_sum(s) * (1.f / DM); float s2 = 0.f;
#pragma unroll
    for (int j = 0; j < 4; ++j) { v[j] = v[j] - mean; s2 += (v[j][0] * v[j][0] + v[j][1] * v[j][1]) + (v[j][2] * v[j][2] + v[j][3] * v[j][3]); }
    const float rstd = rsqrtf(wave_sum(s2) * (1.f / DM) + LN_EPS);
    u32x2* o8 = (u32x2*)orow + lane;
#pragma unroll
    for (int j = 0; j < 4; ++j) { const f32x4 a = ((const f32x4*)sc)[64 * j + lane], b = ((const f32x4*)sh)[64 * j + lane]; const f32x4 y = v[j] * rstd * (a + 1.f) + b;
        u32x2 w; w.x = cvt_pk_bf16(y[0], y[1]); w.y = cvt_pk_bf16(y[2], y[3]); o8[64 * j] = w; }
}
__device__ __forceinline__ void ln1_row(float* trow, const float* g1, const float* b1, const float* sh, const float* sc, bf16_t* orow, int lane) {
    f32x4* xr = (f32x4*)trow + lane; f32x4 v[4]; float s = 0.f;
#pragma unroll
    for (int j = 0; j < 4; ++j) { v[j] = xr[64 * j]; s += (v[j][0] + v[j][1]) + (v[j][2] + v[j][3]); }
    float mean = wave_sum(s) * (1.f / DM); float s2 = 0.f;
#pragma unroll
    for (int j = 0; j < 4; ++j) { v[j] = v[j] - mean; s2 += (v[j][0] * v[j][0] + v[j][1] * v[j][1]) + (v[j][2] * v[j][2] + v[j][3] * v[j][3]); }
    float rstd = rsqrtf(wave_sum(s2) * (1.f / DM) + LN_EPS);
    s = 0.f;
#pragma unroll
    for (int j = 0; j < 4; ++j) { v[j] = v[j] * rstd * ((const f32x4*)g1)[64 * j + lane] + ((const f32x4*)b1)[64 * j + lane]; xr[64 * j] = v[j]; s += (v[j][0] + v[j][1]) + (v[j][2] + v[j][3]); }
    mean = wave_sum(s) * (1.f / DM); s2 = 0.f;
#pragma unroll
    for (int j = 0; j < 4; ++j) { v[j] = v[j] - mean; s2 += (v[j][0] * v[j][0] + v[j][1] * v[j][1]) + (v[j][2] * v[j][2] + v[j][3] * v[j][3]); }
    rstd = rsqrtf(wave_sum(s2) * (1.f / DM) + LN_EPS);
    u32x2* o8 = (u32x2*)orow + lane;
#pragma unroll
    for (int j = 0; j < 4; ++j) { const f32x4 a = ((const f32x4*)sc)[64 * j + lane], b = ((const f32x4*)sh)[64 * j + lane]; const f32x4 y = v[j] * rstd * (a + 1.f) + b;
        u32x2 w; w.x = cvt_pk_bf16(y[0], y[1]); w.y = cvt_pk_bf16(y[2], y[3]); o8[64 * j] = w; }
}

__device__ __forceinline__ int s5_row(int d, int b, int s) {
    if (d == 0) return (s < CTXL) ? (MLAT + b * CTXL + s) : (b * SEQ + (s - CTXL));
    return (s < CTXL) ? (MLAT + b * CTXL + (CTXL - 1 - s)) : (b * SEQ + (SEQ - 1 - (s - CTXL)));
}
typedef const LAS unsigned char* lds_cptr;
__device__ __forceinline__ s16x4 vtr(lds_cptr p) { return __builtin_bit_cast(s16x4, __builtin_amdgcn_ds_read_tr16_b64_v4i16((LAS v4i16_t*)p)); }
__device__ __forceinline__ void s5_passA(const bf16_t* __restrict__ SU, const float* __restrict__ ABAR, const bf16_t* __restrict__ BB, float* __restrict__ E, int unit, int lane) {
    asm volatile("" : "+v"(lane));
    const int j = unit % 7, bp = (unit / 7) & 7, g = (unit / 56) & 31, d = unit / 1792;
    const int r = lane & 31, hA = lane >> 5;
    const int bA = 2 * bp + ((r >> 2) & 1), ti = (r & 3) + 4 * (r >> 3);
    const int s_begin = (j == 0) ? 0 : CTXL + 256 * j, s_end = CTXL + 256 * (j + 1);
    const bf16_t* bbp = BB + (size_t)((d * 32 + g) * 2) * 64 * 16;
    const bf16x8 bre0 = *(const bf16x8*)(bbp + (r * 16 + 8 * hA)), bre1 = *(const bf16x8*)(bbp + ((32 + r) * 16 + 8 * hA));
    const bf16x8 bim0 = *(const bf16x8*)(bbp + ((64 + r) * 16 + 8 * hA)), bim1 = *(const bf16x8*)(bbp + ((96 + r) * 16 + 8 * hA));
    const float* ab = ABAR + (size_t)(d * 32 + g) * 128;
    const float ar0 = ab[2 * r], ai0 = ab[2 * r + 1], ar1 = ab[2 * (32 + r)], ai1 = ab[2 * (32 + r) + 1];
    float hr0 = 0.f, hi0 = 0.f, hr1 = 0.f, hi1 = 0.f;
    bf16x8 ua = *(const bf16x8*)(SU + (size_t)s5_row(d, bA, s_begin + ti) * 512 + g * 16 + 8 * hA);
    for (int s0 = s_begin; s0 < s_end; s0 += 16) {
        const int sn = (s0 + 16 < s_end) ? s0 + 16 : s0;
        const bf16x8 un = *(const bf16x8*)(SU + (size_t)s5_row(d, bA, sn + ti) * 512 + g * 16 + 8 * hA);
        const f32x16 z = {};
        __builtin_amdgcn_sched_barrier(0);
        const f32x16 ur0 = MFMA32(ua, bre0, z), ur1 = MFMA32(ua, bre1, z), ui0 = MFMA32(ua, bim0, z), ui1 = MFMA32(ua, bim1, z);
        MFMA_PAD();
#pragma unroll
        for (int i = 0; i < 16; ++i) {
            const float nr0 = fmaf(ar0, hr0, fmaf(-ai0, hi0, ur0[i])), ni0 = fmaf(ar0, hi0, fmaf(ai0, hr0, ui0[i])); hr0 = nr0; hi0 = ni0;
            const float nr1 = fmaf(ar1, hr1, fmaf(-ai1, hi1, ur1[i])), ni1 = fmaf(ar1, hi1, fmaf(ai1, hr1, ui1[i])); hr1 = nr1; hi1 = ni1;
        }
        ua = un;
    }
    const int b = 2 * bp + (lane >> 5);
    float* e = E + (size_t)(((d * 32 + g) * 16 + b) * 7 + j) * 128;
    e[r] = hr0; e[32 + r] = hr1; e[64 + r] = hi0; e[96 + r] = hi1;
}
constexpr int S5_HT_PITCH = 80;
constexpr int S5_LDS_WAVE = 128 * S5_HT_PITCH;
__device__ __forceinline__ void s5_passB(const bf16_t* __restrict__ SU, const float* __restrict__ ABAR, const float* __restrict__ POW, const bf16_t* __restrict__ BB, const bf16_t* __restrict__ CM,
                                         const float* __restrict__ E, const float* __restrict__ DSK, bf16_t* Y, int unit, int lane, LAS unsigned char* ht) {
    asm volatile("" : "+v"(lane));
    const int k = unit & 7, bp = (unit >> 3) & 7, g = unit >> 6;
    const int r = lane & 31, hA = lane >> 5;
    const int bA = 2 * bp + ((r >> 2) & 1), ti = (r & 3) + 4 * (r >> 3);
    const int bS = 2 * bp + hA;
    const int G4 = lane >> 4, q4 = (lane & 15) >> 2, p4 = lane & 3;
    const lds_cptr trb = (lds_cptr)ht + (8 * hA + q4) * S5_HT_PITCH + (16 * (G4 & 1) + 4 * p4) * 2;
    const int bO = 2 * bp + (r >> 4), tO = r & 15;
#pragma unroll 1
    for (int d = 0; d < 2; ++d) {
        const int j = d == 0 ? k : 7 - k;
        const int s_begin = (j == 0) ? 0 : CTXL + 256 * j, s_end = CTXL + 256 * (j + 1);
        const bf16_t* bbp = BB + (size_t)((d * 32 + g) * 2) * 64 * 16;
        const bf16x8 bre0 = *(const bf16x8*)(bbp + (r * 16 + 8 * hA)), bre1 = *(const bf16x8*)(bbp + ((32 + r) * 16 + 8 * hA));
        const bf16x8 bim0 = *(const bf16x8*)(bbp + ((64 + r) * 16 + 8 * hA)), bim1 = *(const bf16x8*)(bbp + ((96 + r) * 16 + 8 * hA));
        const float* ab = ABAR + (size_t)(d * 32 + g) * 128;
        const float ar0 = ab[2 * r], ai0 = ab[2 * r + 1], ar1 = ab[2 * (32 + r)], ai1 = ab[2 * (32 + r) + 1];
        bf16x8 cm[8];
#pragma unroll
        for (int ks = 0; ks < 8; ++ks) { cm[ks] = (bf16x8){0, 0, 0, 0, 0, 0, 0, 0}; if (r < 16) cm[ks] = *(const bf16x8*)(CM + ((size_t)((d * 32 + g) * 16 + r) * 128 + 16 * ks + 8 * hA)); }
        float hr0 = 0.f, hi0 = 0.f, hr1 = 0.f, hi1 = 0.f;
        { const float* e = E + (size_t)(((d * 32 + g) * 16 + bS) * 7) * 128;
          for (int jj = 0; jj < j; ++jj) { const float* pw = POW + ((size_t)((jj == 0 ? 1 : 0) * 64 + d * 32 + g) * 64) * 2;
              const float pr0 = pw[2 * r], pi0 = pw[2 * r + 1], pr1 = pw[2 * (32 + r)], pi1 = pw[2 * (32 + r) + 1];
              const float er0 = e[jj * 128 + r], er1 = e[jj * 128 + 32 + r], ei0 = e[jj * 128 + 64 + r], ei1 = e[jj * 128 + 96 + r];
              const float nr0 = pr0 * hr0 - pi0 * hi0 + er0, ni0 = pr0 * hi0 + pi0 * hr0 + ei0; hr0 = nr0; hi0 = ni0;
              const float nr1 = pr1 * hr1 - pi1 * hi1 + er1, ni1 = pr1 * hi1 + pi1 * hr1 + ei1; hr1 = nr1; hi1 = ni1; } }
        bf16x8 ua = *(const bf16x8*)(SU + (size_t)s5_row(d, bA, s_begin + ti) * 512 + g * 16 + 8 * hA);
        for (int s0 = s_begin; s0 < s_end; s0 += 16) {
            const int sn = (s0 + 16 < s_end) ? s0 + 16 : s0;
            const bf16x8 un = *(const bf16x8*)(SU + (size_t)s5_row(d, bA, sn + ti) * 512 + g * 16 + 8 * hA);
            const f32x16 z = {};
            __builtin_amdgcn_sched_barrier(0);
            f32x16 ur0 = MFMA32(ua, bre0, z), ur1 = MFMA32(ua, bre1, z), ui0 = MFMA32(ua, bim0, z), ui1 = MFMA32(ua, bim1, z);
            MFMA_PAD();
#pragma unroll
            for (int i = 0; i < 16; ++i) {
                const float nr0 = fmaf(ar0, hr0, fmaf(-ai0, hi0, ur0[i])), ni0 = fmaf(ar0, hi0, fmaf(ai0, hr0, ui0[i])); hr0 = nr0; hi0 = ni0; ur0[i] = nr0; ui0[i] = ni0;
                const float nr1 = fmaf(ar1, hr1, fmaf(-ai1, hi1, ur1[i])), ni1 = fmaf(ar1, hi1, fmaf(ai1, hr1, ui1[i])); hr1 = nr1; hi1 = ni1; ur1[i] = nr1; ui1[i] = ni1;
            }
            if (s0 >= CTXL) {
#define S5_WR(V, R) do { LAS unsigned char* wp = ht + (R) * S5_HT_PITCH + hA * 32; \
                    u32x4 w0, w1; w0.x = cvt_pk_bf16(V[0], V[1]); w0.y = cvt_pk_bf16(V[2], V[3]); w0.z = cvt_pk_bf16(V[4], V[5]); w0.w = cvt_pk_bf16(V[6], V[7]); \
                    w1.x = cvt_pk_bf16(V[8], V[9]); w1.y = cvt_pk_bf16(V[10], V[11]); w1.z = cvt_pk_bf16(V[12], V[13]); w1.w = cvt_pk_bf16(V[14], V[15]); \
                    *(LAS u32x4*)wp = w0; *(LAS u32x4*)(wp + 16) = w1; } while (0)
                S5_WR(ur0, r); S5_WR(ur1, 32 + r); S5_WR(ui0, 64 + r); S5_WR(ui1, 96 + r);
#undef S5_WR
                LDS_WAIT();
                f32x16 ya = {};
#pragma unroll
                for (int ks = 0; ks < 8; ++ks) {
                    const s16x4 lo = vtr(trb + (16 * ks) * S5_HT_PITCH), hi = vtr(trb + (16 * ks + 4) * S5_HT_PITCH);
                    const bf16x8 bfrag = (bf16x8){lo[0], lo[1], lo[2], lo[3], hi[0], hi[1], hi[2], hi[3]};
                    ya = MFMA32(cm[ks], bfrag, ya);
                }
                MFMA_PAD();
                const int row = s5_row(d, bO, s0 + tO);
                bf16_t* yp = Y + (size_t)row * 512 + g * 16 + 4 * hA;
                if (d == 0) {
                    const bf16_t* up = SU + (size_t)row * 512 + g * 16 + 4 * hA;
                    const u32x2 u0 = *(const u32x2*)up, u1 = *(const u32x2*)(up + 8);
                    const f32x4 d0 = *(const f32x4*)(DSK + g * 16 + 4 * hA), d1 = *(const f32x4*)(DSK + g * 16 + 8 + 4 * hA);
                    u32x2 o0, o1;
                    o0.x = cvt_pk_bf16(ya[0] + d0[0] * bf_lo(u0.x), ya[1] + d0[1] * bf_hi(u0.x)); o0.y = cvt_pk_bf16(ya[2] + d0[2] * bf_lo(u0.y), ya[3] + d0[3] * bf_hi(u0.y));
                    o1.x = cvt_pk_bf16(ya[4] + d1[0] * bf_lo(u1.x), ya[5] + d1[1] * bf_hi(u1.x)); o1.y = cvt_pk_bf16(ya[6] + d1[2] * bf_lo(u1.y), ya[7] + d1[3] * bf_hi(u1.y));
                    *(u32x2*)yp = o0; *(u32x2*)(yp + 8) = o1;
                } else {
                    const u32x2 f0 = *(const u32x2*)yp, f1 = *(const u32x2*)(yp + 8);
                    u32x2 o0, o1;
                    o0.x = cvt_pk_bf16(gelu_tanh(ya[0] + bf_lo(f0.x)), gelu_tanh(ya[1] + bf_hi(f0.x))); o0.y = cvt_pk_bf16(gelu_tanh(ya[2] + bf_lo(f0.y)), gelu_tanh(ya[3] + bf_hi(f0.y)));
                    o1.x = cvt_pk_bf16(gelu_tanh(ya[4] + bf_lo(f1.x)), gelu_tanh(ya[5] + bf_hi(f1.x))); o1.y = cvt_pk_bf16(gelu_tanh(ya[6] + bf_lo(f1.y)), gelu_tanh(ya[7] + bf_hi(f1.y)));
                    *(u32x2*)yp = o0; *(u32x2*)(yp + 8) = o1;
                }
                LDS_WAIT();
            }
            ua = un;
        }
        VM_WAIT();
    }
}

namespace att {
constexpr int NW = 8, QBLK = 32, KVBLK = 64;
constexpr int SHM_V = KVBLK * 128 * 2, SHM_K = KVBLK * DK * 2;
constexpr int OFF_V = 0, OFF_K = 2 * SHM_V, OFF_WS = OFF_K + 2 * SHM_K, OFF_QPE = OFF_WS + NW * 64 * 4, LDS_BYTES = OFF_QPE + NW * 4096;
constexpr float THRL = 8.f * 1.4426950408889634f;
#define KSWZ(row, colB) ((row) * 384 + ((colB) ^ (((row) & 7) << 4)))
#define SBAR() __builtin_amdgcn_sched_barrier(0)
__device__ __forceinline__ int crow(int r, int hi) { return (r & 3) + 8 * (r >> 2) + 4 * hi; }
__device__ __forceinline__ void partialSM(f32x16& p0, f32x16& p1, float& m_reg, float& mn, float& alpha) {
    float pmax = p0[0];
#pragma unroll
    for (int r = 1; r < 16; ++r) pmax = fmaxf(pmax, p0[r]);
#pragma unroll
    for (int r = 0; r < 16; ++r) pmax = fmaxf(pmax, p1[r]);
    { auto rr = __builtin_amdgcn_permlane32_swap(__float_as_uint(pmax), __float_as_uint(pmax), false, false);
      pmax = fmaxf(__uint_as_float(rr[0]), __uint_as_float(rr[1])); }
    if (__builtin_expect(__all(pmax - m_reg <= THRL), 1)) { mn = m_reg; alpha = 1.f; }
    else { mn = fmaxf(m_reg, pmax); alpha = __builtin_amdgcn_exp2f(m_reg - mn); m_reg = mn; }
#pragma unroll
    for (int r = 0; r < 16; ++r) p0[r] = p0[r] - mn;
#pragma unroll
    for (int r = 0; r < 16; ++r) p1[r] = p1[r] - mn;
#pragma unroll
    for (int r = 0; r < 16; ++r) p0[r] = __builtin_amdgcn_exp2f(p0[r]);
}
__device__ __forceinline__ void finishSM(f32x16& p0, f32x16& p1, float alpha, float& l_reg, bf16x8& pa0, bf16x8& pa1, bf16x8& pa2, bf16x8& pa3) {
#pragma unroll
    for (int r = 0; r < 16; ++r) p1[r] = __builtin_amdgcn_exp2f(p1[r]);
    float ps = 0;
#pragma unroll
    for (int r = 0; r < 16; ++r) ps += p0[r];
#pragma unroll
    for (int r = 0; r < 16; ++r) ps += p1[r];
    { auto rr = __builtin_amdgcn_permlane32_swap(__float_as_uint(ps), __float_as_uint(ps), false, false);
      ps = __uint_as_float(rr[0]) + __uint_as_float(rr[1]); }
    l_reg = l_reg * alpha + ps;
#define PK4(P, BASE, OUT) do { unsigned a0 = cvt_pk_bf16(P[BASE + 0], P[BASE + 1]), a1 = cvt_pk_bf16(P[BASE + 2], P[BASE + 3]);   \
    unsigned b0 = cvt_pk_bf16(P[BASE + 4], P[BASE + 5]), b1 = cvt_pk_bf16(P[BASE + 6], P[BASE + 7]);                              \
    auto r0 = __builtin_amdgcn_permlane32_swap(a0, b0, false, false); auto r1 = __builtin_amdgcn_permlane32_swap(a1, b1, false, false); \
    u32x4 w = {r0[0], r1[0], r0[1], r1[1]}; OUT = *reinterpret_cast<bf16x8*>(&w); } while (0)
    PK4(p0, 0, pa0); PK4(p0, 8, pa1); PK4(p1, 0, pa2); PK4(p1, 8, pa3);
#undef PK4
}
__device__ __forceinline__ void qkt(f32x16& p0, f32x16& p1, const char* Ks, const bf16x8* qr, const char* qpe, int r32, int hi) {
    p0 = f32x16{}; p1 = f32x16{};
#pragma unroll
    for (int d0 = 0; d0 < 12; ++d0) { const int cb = (d0 * 16 + hi * 8) * 2;
        const bf16x8 b0 = *reinterpret_cast<const bf16x8*>(Ks + KSWZ(r32, cb));
        const bf16x8 b1 = *reinterpret_cast<const bf16x8*>(Ks + KSWZ(32 + r32, cb));
        const bf16x8 q = d0 < 8 ? qr[d0 < 8 ? d0 : 0] : *reinterpret_cast<const bf16x8*>(qpe + (d0 - 8) * 1024);
        p0 = MFMA32(b0, q, p0);
        p1 = MFMA32(b1, q, p1); }
}
__device__ __forceinline__ int v_st(int k, int c) { const int kk = (k & ~0xC) | ((k & 4) << 1) | ((k & 8) >> 1); return ((kk >> 3) * 4 + (c >> 5)) * 512 + ((kk & 7) * 32 + (c & 31)) * 2; }
__device__ __forceinline__ int v_rd_base(int lane) { return ((lane & 3) << 3) | (((lane >> 2) & 3) << 6) | (((lane >> 4) & 1) << 5) | (((lane >> 5) & 1) << 8); }
constexpr int v_rd_off(int d0, int ks, int half) { return d0 * 512 + ks * 4096 + half * 2048; }
template <int OFF> __device__ __forceinline__ s16x4 tr_read(int vb) {
    s16x4 r; asm volatile("ds_read_b64_tr_b16 %0, %1 offset:%2" : "=&v"(r) : "v"(vb), "i"(OFF) : "memory"); return r;
}
template <int D0> __device__ __forceinline__ void pv_one(f32x16& od, int vb, bf16x8 pa0, bf16x8 pa1, bf16x8 pa2, bf16x8 pa3) {
    const s16x4 l0 = tr_read<v_rd_off(D0, 0, 0)>(vb), h0 = tr_read<v_rd_off(D0, 0, 1)>(vb), l1 = tr_read<v_rd_off(D0, 1, 0)>(vb), h1 = tr_read<v_rd_off(D0, 1, 1)>(vb);
    const s16x4 l2 = tr_read<v_rd_off(D0, 2, 0)>(vb), h2 = tr_read<v_rd_off(D0, 2, 1)>(vb), l3 = tr_read<v_rd_off(D0, 3, 0)>(vb), h3 = tr_read<v_rd_off(D0, 3, 1)>(vb);
    asm volatile("s_waitcnt lgkmcnt(0)" ::: "memory"); SBAR();
#define PK(L, H) (bf16x8){L[0], L[1], L[2], L[3], H[0], H[1], H[2], H[3]}
    od = MFMA32(pa0, PK(l0, h0), od);
    od = MFMA32(pa1, PK(l1, h1), od);
    od = MFMA32(pa2, PK(l2, h2), od);
    od = MFMA32(pa3, PK(l3, h3), od);
#undef PK
}
__device__ __forceinline__ void pv_d0(f32x16* o, int vb, bf16x8 pa0, bf16x8 pa1, bf16x8 pa2, bf16x8 pa3) {
    pv_one<0>(o[0], vb, pa0, pa1, pa2, pa3); pv_one<1>(o[1], vb, pa0, pa1, pa2, pa3); pv_one<2>(o[2], vb, pa0, pa1, pa2, pa3); pv_one<3>(o[3], vb, pa0, pa1, pa2, pa3);
}
__device__ __forceinline__ void attn_unit(bf16_t* Qu, const bf16_t* __restrict__ Kh, const bf16_t* __restrict__ Pb, const bf16_t* __restrict__ Vh, const bf16_t* __restrict__ Gm, const float* __restrict__ ROPEt, int l0, char* lds, int tid_) {
    asm volatile("" : "+v"(tid_));
    const int tid = tid_, wid = __builtin_amdgcn_readfirstlane(tid >> 6), lane = tid & 63, r32 = lane & 31, hi = lane >> 5;
    char* V_lds = lds + OFF_V; char* K_lds = lds + OFF_K;
    float* ws = (float*)(lds + OFF_WS) + wid * 64; float* li_l = ws; float* al_l = ws + 32;
    float m_reg = -1e30f, l_reg = 0; f32x16 o[4] = {}; bf16x8 qr[8]; char* qpe = lds + OFF_QPE + wid * 4096 + lane * 16;
    const bf16_t* Qw = Qu + (size_t)(wid * QBLK + r32) * DK + hi * 8;
#pragma unroll
    for (int d0 = 0; d0 < 8; ++d0) qr[d0] = *reinterpret_cast<const bf16x8*>(Qw + d0 * 16);
    { const int l = l0 + wid * QBLK + r32;
#pragma unroll
      for (int part = 0; part < 2; ++part) { const int pos = part == 0 ? (l >> 6) : (l & 63);
          const u32x4 x1 = *reinterpret_cast<const u32x4*>(Qw + (8 + 2 * part) * 16), x2 = *reinterpret_cast<const u32x4*>(Qw + (9 + 2 * part) * 16);
          const f32x4* tp = (const f32x4*)(ROPEt + (size_t)pos * 32 + hi * 16); const f32x4 t0 = tp[0], t1 = tp[1], t2 = tp[2], t3 = tp[3];
          u32x4 o1, o2;
#define ROT2(X1, X2, T, O1, O2) { const float a0 = bf_lo(X1), a1 = bf_hi(X1), b0 = bf_lo(X2), b1 = bf_hi(X2); \
          O1 = cvt_pk_bf16(a0 * T[0] - b0 * T[1], a1 * T[2] - b1 * T[3]); O2 = cvt_pk_bf16(b0 * T[0] + a0 * T[1], b1 * T[2] + a1 * T[3]); }
          ROT2(x1.x, x2.x, t0, o1.x, o2.x) ROT2(x1.y, x2.y, t1, o1.y, o2.y) ROT2(x1.z, x2.z, t2, o1.z, o2.z) ROT2(x1.w, x2.w, t3, o1.w, o2.w)
#undef ROT2
          *reinterpret_cast<u32x4*>(qpe + (2 * part) * 1024) = o1; *reinterpret_cast<u32x4*>(qpe + (2 * part + 1) * 1024) = o2; } }
    const int sr = tid >> 4, sc = (tid & 15) * 8, vst0 = v_st(sr, sc), vst1 = v_st(32 + sr, sc);
    const int pr = tid >> 3, pc = (tid & 7) * 8;
    const int vb0 = (int)(uintptr_t)V_lds + v_rd_base(lane);
    bf16x8 vs0, vs1, ks0, ks1, ps0;
    const unsigned go0 = (unsigned)(sr * 128 + sc) * 2u, go1 = go0 + 8192u, go2 = (unsigned)(pr * 64 + pc) * 2u;
#define SLOAD(k0) do { const char* vt_ = (const char*)Vh + (size_t)(k0) * 256; const char* kt_ = (const char*)Kh + (size_t)(k0) * 256; const char* pt_ = (const char*)Pb + (size_t)(k0) * 128; \
    vs0 = *(const bf16x8*)(vt_ + go0); vs1 = *(const bf16x8*)(vt_ + go1); ks0 = *(const bf16x8*)(kt_ + go0); ks1 = *(const bf16x8*)(kt_ + go1); \
    ps0 = *(const bf16x8*)(pt_ + go2); } while (0)
#define SWRITE(b) do { *(bf16x8*)(V_lds + (b) * SHM_V + vst0) = vs0; *(bf16x8*)(V_lds + (b) * SHM_V + vst1) = vs1; const int kc = sc * 2;  \
    *(bf16x8*)(K_lds + (b) * SHM_K + KSWZ(sr, kc)) = ks0; *(bf16x8*)(K_lds + (b) * SHM_K + KSWZ(32 + sr, kc)) = ks1;                       \
    *(bf16x8*)(K_lds + (b) * SHM_K + KSWZ(pr, 256 + pc * 2)) = ps0; } while (0)
#define SWAIT() asm volatile("s_waitcnt vmcnt(0)" ::: "memory")
#define RESC(a) do { if (__any((a) < 1.f)) { if (hi == 0) al_l[r32] = (a); asm volatile("s_waitcnt lgkmcnt(0)" ::: "memory"); \
    _Pragma("unroll") for (int d = 0; d < 4; ++d) _Pragma("unroll") for (int r = 0; r < 16; ++r) o[d][r] *= al_l[crow(r, hi)]; } } while (0)
    f32x16 pA0, pA1, pB0, pB1; float mnA, mnB, alA, alB; bf16x8 pa0, pa1, pa2, pa3; constexpr int NT = NKEY / KVBLK;
    SLOAD(0); SWAIT(); SWRITE(0); __syncthreads();
    qkt(pA0, pA1, K_lds, qr, qpe, r32, hi); partialSM(pA0, pA1, m_reg, mnA, alA);
    SLOAD(KVBLK);
    SWAIT(); SWRITE(1); __syncthreads();
    for (int j = 1; j + 1 < NT; j += 2) {
        SBAR(); qkt(pB0, pB1, K_lds + SHM_K, qr, qpe, r32, hi);
        finishSM(pA0, pA1, alA, l_reg, pa0, pa1, pa2, pa3); SBAR();
        SLOAD((j + 1) * KVBLK); SBAR();
        pv_d0(o, vb0, pa0, pa1, pa2, pa3); partialSM(pB0, pB1, m_reg, mnB, alB);
        __syncthreads(); SWAIT(); SWRITE(0);
        RESC(alB); __syncthreads();
        SBAR(); qkt(pA0, pA1, K_lds, qr, qpe, r32, hi);
        finishSM(pB0, pB1, alB, l_reg, pa0, pa1, pa2, pa3); SBAR();
        SLOAD((j + 2) * KVBLK); SBAR();
        pv_d0(o, vb0 + SHM_V, pa0, pa1, pa2, pa3); partialSM(pA0, pA1, m_reg, mnA, alA);
        __syncthreads(); SWAIT(); SWRITE(1);
        RESC(alA); __syncthreads();
    }
    SBAR(); qkt(pB0, pB1, K_lds + SHM_K, qr, qpe, r32, hi);
    finishSM(pA0, pA1, alA, l_reg, pa0, pa1, pa2, pa3); SBAR();
    pv_d0(o, vb0, pa0, pa1, pa2, pa3); partialSM(pB0, pB1, m_reg, mnB, alB);
    __syncthreads(); RESC(alB);
    finishSM(pB0, pB1, alB, l_reg, pa0, pa1, pa2, pa3); SBAR();
    pv_d0(o, vb0 + SHM_V, pa0, pa1, pa2, pa3);
    if (hi == 0) li_l[r32] = l_reg; asm volatile("s_waitcnt lgkmcnt(0)" ::: "memory");
    __syncthreads();
    { char* ot = lds + wid * (32 * 272);
#pragma unroll
      for (int r = 0; r < 16; ++r) { const int orow = crow(r, hi); const float rl = __builtin_amdgcn_rcpf(li_l[orow]);
#pragma unroll
          for (int d0 = 0; d0 < 4; ++d0) *(bf16_t*)(ot + orow * 272 + (d0 * 32 + r32) * 2) = (bf16_t)(cvt_pk_bf16(o[d0][r] * rl, 0.f) & 0xffffu); }
      asm volatile("s_waitcnt lgkmcnt(0)" ::: "memory");
      bf16_t* Ow = Qu + (size_t)(wid * QBLK) * 128; const bf16_t* Gw = Gm + (size_t)(wid * QBLK) * 2048;
#pragma unroll
      for (int it = 0; it < 8; ++it) { const int idx = it * 64 + lane, row = idx >> 4, ch = idx & 15;
          const u32x4 ov = *(const u32x4*)(ot + row * 272 + ch * 16); const u32x4 gv = *(const u32x4*)(Gw + (size_t)row * 2048 + ch * 8);
          u32x4 w; w.x = cvt_pk_bf16(bf_lo(ov.x) * bf_lo(gv.x), bf_hi(ov.x) * bf_hi(gv.x)); w.y = cvt_pk_bf16(bf_lo(ov.y) * bf_lo(gv.y), bf_hi(ov.y) * bf_hi(gv.y));
          w.z = cvt_pk_bf16(bf_lo(ov.z) * bf_lo(gv.z), bf_hi(ov.z) * bf_hi(gv.z)); w.w = cvt_pk_bf16(bf_lo(ov.w) * bf_lo(gv.w), bf_hi(ov.w) * bf_hi(gv.w));
          *(u32x4*)(Ow + (size_t)row * 128 + ch * 8) = w; } }
    __syncthreads();
#undef SLOAD
#undef SWRITE
#undef SWAIT
#undef RESC
}
#undef KSWZ
#undef SBAR
}


namespace peer {
__device__ __forceinline__ int f2key(float f) { const int b = __builtin_bit_cast(int, f); return b ^ ((b >> 31) & 0x7fffffff); }
__device__ __forceinline__ float key2f(int k) { return __builtin_bit_cast(float, k ^ ((k >> 31) & 0x7fffffff)); }
__device__ __forceinline__ void ce_desc(int& a, int& b) { const int hi = a > b ? a : b, lo = a > b ? b : a; a = hi; b = lo; }
__device__ __forceinline__ void sort16_desc(int (&v)[16]) {
#pragma unroll
    for (int k = 2; k <= 16; k <<= 1)
#pragma unroll
        for (int j = k >> 1; j > 0; j >>= 1)
#pragma unroll
            for (int i = 0; i < 16; ++i) { const int l = i ^ j; if (l > i) { if ((i & k) == 0) ce_desc(v[i], v[l]); else ce_desc(v[l], v[i]); } }
}
__device__ __forceinline__ void merge_top16(int (&a)[16], const int (&b)[16]) {
#pragma unroll
    for (int i = 0; i < 16; ++i) a[i] = a[i] > b[15 - i] ? a[i] : b[15 - i];
#pragma unroll
    for (int j = 8; j > 0; j >>= 1)
#pragma unroll
        for (int i = 0; i < 16; ++i) { const int l = i ^ j; if (l > i) ce_desc(a[i], a[l]); }
}
__device__ __forceinline__ int lut16(const int (&P)[4], int a) { const int s = a >> 2; const int v = (P[0] & -(int)(s == 0)) | (P[1] & -(int)(s == 1)) | (P[2] & -(int)(s == 2)) | (P[3] & -(int)(s == 3)); return (v >> (8 * (a & 3))) & 127; }
constexpr int KSW_BYTES = 2 * 128 * 256;
__device__ __forceinline__ int ksw(int z, int key, int colB) { return (z * 128 + key) * 256 + (colB ^ ((key & 7) << 4)); }

__device__ constexpr int G2A[16] = {1, 1, 1, 1, 1, 1, 1, 2, 2, 2, 2, 3, 3, 3, 4, 4}, G2B[16] = {1, 2, 3, 4, 5, 6, 7, 1, 2, 3, 4, 1, 2, 3, 1, 2};
__device__ constexpr int G3A[3] = {5, 6, 7}, G3B[3] = {1, 1, 1};

__device__ __forceinline__ void route_unit(const bf16_t* __restrict__ PQ, const char* KL, unsigned* __restrict__ RIDX, float* __restrict__ RW, int tok0, int h, int lane) {
    const int r32 = lane & 31, hi = lane >> 5;
    int X[2][16];
#pragma unroll
    for (int z = 0; z < 2; ++z) {
        bf16x8 qf[8];
#ifdef MK_X_ROUTEIN
        const bf16_t* qp = PQ + (size_t)(tok0 + r32) * 1024 + (h & 3) * 256 + z * 128 + hi * 8;
#else
        const bf16_t* qp = PQ + (size_t)(tok0 + r32) * 2048 + h * 256 + z * 128 + hi * 8;
#endif
#pragma unroll
        for (int ks = 0; ks < 8; ++ks) qf[ks] = *(const bf16x8*)(qp + ks * 16);
        f32x16 acc[4];
#pragma unroll
        for (int kt = 0; kt < 4; ++kt) { acc[kt] = f32x16{};
#pragma unroll
            for (int ks = 0; ks < 8; ++ks) { const bf16x8 kf = *(const bf16x8*)(KL + ksw(z, kt * 32 + r32, (ks * 16 + hi * 8) * 2)); acc[kt] = MFMA32(kf, qf[ks], acc[kt]); } }
        MFMA_PAD();
        int g0[16], g1[16];
#pragma unroll
        for (int half = 0; half < 2; ++half) {
#pragma unroll
            for (int i = 0; i < 16; ++i) { g0[i] = (f2key(acc[2 * half][i]) & ~127) | (64 * half + (i & 3) + 8 * (i >> 2) + 4 * hi);
                                           g1[i] = (f2key(acc[2 * half + 1][i]) & ~127) | (64 * half + 32 + (i & 3) + 8 * (i >> 2) + 4 * hi); }
            sort16_desc(g0); sort16_desc(g1); merge_top16(g0, g1);
            if (half == 0) {
#pragma unroll
                for (int i = 0; i < 16; ++i) X[z][i] = g0[i];
            } else merge_top16(X[z], g0);
        }
    }
    int T0[16], T1[16];
    { int P[16];
#pragma unroll
      for (int i = 0; i < 16; ++i) { auto rr = __builtin_amdgcn_permlane32_swap((unsigned)X[0][i], (unsigned)X[1][i], false, false); T0[i] = (int)rr[0]; P[i] = (int)rr[1]; }
      merge_top16(T0, P);
#pragma unroll
      for (int i = 0; i < 16; ++i) { auto rr = __builtin_amdgcn_permlane32_swap((unsigned)T0[i], (unsigned)T0[i], false, false); T0[i] = (int)rr[0]; T1[i] = (int)rr[1]; } }
    float f0[16], f1[16]; int I0[4] = {0, 0, 0, 0}, I1[4] = {0, 0, 0, 0};
#pragma unroll
    for (int a = 0; a < 16; ++a) { f0[a] = key2f(T0[a] & ~127); f1[a] = key2f(T1[a] & ~127); I0[a >> 2] |= (T0[a] & 127) << (8 * (a & 3)); I1[a >> 2] |= (T1[a] & 127) << (8 * (a & 3)); }
    int C0[16], C1[16], C2[16], C3[16];
#pragma unroll
    for (int b = 0; b < 16; ++b) C0[b] = (f2key(f0[0] + f1[b]) & ~255) | b;
#pragma unroll
    for (int a = 1; a < 16; ++a) C1[a - 1] = (f2key(f0[a] + f1[0]) & ~255) | (a << 4);
    C1[15] = (int)0x80000000;
#pragma unroll
    for (int c = 0; c < 16; ++c) C2[c] = (f2key(f0[G2A[c]] + f1[G2B[c]]) & ~255) | (G2A[c] << 4) | G2B[c];
#pragma unroll
    for (int c = 0; c < 16; ++c) C3[c] = (int)0x80000000;
#pragma unroll
    for (int c = 0; c < 3; ++c) C3[c] = (f2key(f0[G3A[c]] + f1[G3B[c]]) & ~255) | (G3A[c] << 4) | G3B[c];
    ce_desc(C3[0], C3[1]); ce_desc(C3[1], C3[2]); ce_desc(C3[0], C3[1]);
    sort16_desc(C2);
    merge_top16(C0, C1); merge_top16(C2, C3); merge_top16(C0, C2);
    float sc[16]; float ssum = 0.f; const float smax = key2f(C0[0] & ~255);
#pragma unroll
    for (int k = 0; k < 16; ++k) { sc[k] = __expf(key2f(C0[k] & ~255) - smax); ssum += sc[k]; }
    const float rs = __builtin_amdgcn_rcpf(ssum);
    {
        unsigned* ip = RIDX + (size_t)(tok0 + r32) * 128 + h * 16; float* wp = RW + (size_t)(tok0 + r32) * 128 + h * 16;
#pragma unroll
        for (int k4 = 0; k4 < 4; ++k4) { u32x4 iv; f32x4 wv;
#pragma unroll
            for (int e = 0; e < 4; ++e) { const int k = 4 * k4 + e, ab = C0[k] & 255; iv[e] = (unsigned)(lut16(I0, ab >> 4) * 128 + lut16(I1, ab & 15)); wv[e] = sc[k] * rs; }
            *(u32x4*)(ip + 4 * k4) = iv; *(f32x4*)(wp + 4 * k4) = wv; }
    }
}

typedef __bf16 bf16x2v __attribute__((ext_vector_type(2)));
__device__ __forceinline__ float dot8(const u32x4 a, const u32x4 b, float c) {
    c = fmaf(bf_lo(a.x), bf_lo(b.x), c); c = fmaf(bf_hi(a.x), bf_hi(b.x), c); c = fmaf(bf_lo(a.y), bf_lo(b.y), c); c = fmaf(bf_hi(a.y), bf_hi(b.y), c);
    c = fmaf(bf_lo(a.z), bf_lo(b.z), c); c = fmaf(bf_hi(a.z), bf_hi(b.z), c); c = fmaf(bf_lo(a.w), bf_lo(b.w), c); c = fmaf(bf_hi(a.w), bf_hi(b.w), c);
    return c;
}
#define DPP_ADD(s, ctrl) s += __builtin_bit_cast(float, __builtin_amdgcn_update_dpp(0, __builtin_bit_cast(int, s), ctrl, 0xF, 0xF, true))
__device__ __forceinline__ void gather_token(const bf16_t* __restrict__ xrow, const unsigned* __restrict__ ridx, const float* __restrict__ rw, const bf16_t* __restrict__ PU, const bf16_t* __restrict__ PV,
                                             float (&f)[16], int lane) {
    const u32x4 x0 = *(const u32x4*)(xrow + 8 * lane), x1 = *(const u32x4*)(xrow + 512 + 8 * lane);
#ifdef MK_X_FIXROUTE
    const unsigned tk_ = (unsigned)(size_t)(xrow - (const bf16_t*)0) >> 11;
    const unsigned id_lo = (tk_ * 131u + lane * 1237u) & 16383u, id_hi = (tk_ * 977u + lane * 4099u + 77u) & 16383u; const float w_lo = 1.f / 128.f, w_hi = 1.f / 128.f;
#else
    const unsigned id_lo = ridx[lane], id_hi = ridx[64 + lane]; const float w_lo = rw[lane], w_hi = rw[64 + lane];
#endif
#pragma unroll
    for (int i = 0; i < 16; ++i) f[i] = 0.f;
    const int grp = lane >> 4;
#pragma unroll 1
    for (int bt = 0; bt < 32; ++bt) {
        unsigned e[4]; float g[4];
#pragma unroll
        for (int q = 0; q < 4; ++q) { const int src = (4 * bt + q) & 63;
            e[q] = bt < 16 ? __builtin_amdgcn_readlane(id_lo, src) : __builtin_amdgcn_readlane(id_hi, src);
            g[q] = __builtin_bit_cast(float, bt < 16 ? __builtin_amdgcn_readlane(__builtin_bit_cast(unsigned, w_lo), src) : __builtin_amdgcn_readlane(__builtin_bit_cast(unsigned, w_hi), src)); }
        u32x4 ua[4][2], va[4][2];
#pragma unroll
        for (int q = 0; q < 4; ++q) { const bf16_t* up = PU + (size_t)e[q] * 1024 + 8 * lane; const bf16_t* vp = PV + (size_t)e[q] * 1024 + 8 * lane;
            ua[q][0] = *(const u32x4*)up; ua[q][1] = *(const u32x4*)(up + 512); va[q][0] = *(const u32x4*)vp; va[q][1] = *(const u32x4*)(vp + 512); }
        float p[4];
#pragma unroll
        for (int q = 0; q < 4; ++q) p[q] = dot8(ua[q][1], x1, dot8(ua[q][0], x0, 0.f));
        { const bool up32 = lane >= 32;
          float k0 = up32 ? p[2] : p[0], k1 = up32 ? p[3] : p[1], s0 = up32 ? p[0] : p[2], s1 = up32 ? p[1] : p[3];
          { auto r0 = __builtin_amdgcn_permlane32_swap(__builtin_bit_cast(unsigned, s0), __builtin_bit_cast(unsigned, s0), false, false);
            auto r1 = __builtin_amdgcn_permlane32_swap(__builtin_bit_cast(unsigned, s1), __builtin_bit_cast(unsigned, s1), false, false);
            k0 += __builtin_bit_cast(float, up32 ? r0[0] : r0[1]); k1 += __builtin_bit_cast(float, up32 ? r1[0] : r1[1]); }
          const bool odd16 = (lane & 16) != 0;
          float kk = odd16 ? k1 : k0, ss = odd16 ? k0 : k1;
          ss = __shfl_xor(ss, 16); kk += ss;
          DPP_ADD(kk, 0xB1); DPP_ADD(kk, 0x4E); DPP_ADD(kk, 0x141); DPP_ADD(kk, 0x140);
          const float gg = grp == 0 ? g[0] : (grp == 1 ? g[1] : (grp == 2 ? g[2] : g[3]));
          const float act = gelu_tanh(kk) * gg;
#pragma unroll
          for (int q = 0; q < 4; ++q) { float a = __builtin_bit_cast(float, __builtin_amdgcn_readlane(__builtin_bit_cast(unsigned, act), 16 * q)); asm volatile("" : "+v"(a));
#pragma unroll
              for (int j = 0; j < 2; ++j) { const u32x4 vv = va[q][j];
                  f[8 * j + 0] += a * bf_lo(vv.x); f[8 * j + 1] += a * bf_hi(vv.x); f[8 * j + 2] += a * bf_lo(vv.y); f[8 * j + 3] += a * bf_hi(vv.y);
                  f[8 * j + 4] += a * bf_lo(vv.z); f[8 * j + 5] += a * bf_hi(vv.z); f[8 * j + 6] += a * bf_lo(vv.w); f[8 * j + 7] += a * bf_hi(vv.w); } } }
    }
}
#undef DPP_ADD
}


#ifdef MK_X_HASH
__device__ __forceinline__ void hash_range(unsigned char* ws, size_t off, size_t bytes, int word, int gt, int NGT) {
    const unsigned* p = (const unsigned*)(ws + off); const size_t n = bytes / 4; unsigned h = 0u;
    for (size_t i = gt; i < n; i += NGT) h += p[i] * ((unsigned)i * 2654435761u + 12345u);
    atomicAdd((unsigned*)(ws + WS_CTL) + 8192 + word, h);
}
#endif
constexpr int NWAVES = 8, RING_BYTES = 131072, LDSCTL_OFF = RING_BYTES, MISC_OFF = LDSCTL_OFF + 320, LDS_BYTES = 147456;
constexpr int NPH = 11;
struct Args { const float* in[29]; float* out; unsigned char* ws; int ph_lo, ph_hi; };
static_assert(sizeof(Args) == 29 * 8 + 8 + 8 + 8, "Args has no padding");
enum { I_X = 0, I_C, I_CTX, I_CCTX, I_WMOD, I_BMOD, I_WIN, I_QNG, I_KVNG, I_WUQ, I_WUKV, I_S5ARE, I_S5AIM, I_S5LDT, I_S5BRE, I_S5BIM, I_S5CRE, I_S5CIM, I_S5D, I_WGLU, I_WOUT,
       I_LN1G, I_LN1B, I_PWQ, I_PKEYS, I_PU, I_PV, I_LN2G, I_LN2B };

__global__ void __launch_bounds__(NWAVES * 64, 2) mk_fwd(Args args) {
    extern __shared__ __attribute__((aligned(16))) unsigned char lds[];
    LAS unsigned char* ldsl = (LAS unsigned char*)lds;
    volatile LAS unsigned* MISC = (volatile LAS unsigned*)(ldsl + MISC_OFF);
    const int wave = __builtin_amdgcn_readfirstlane(threadIdx.x >> 6);
    const int G = gridDim.x; const int bx = blockIdx.x; const int vcu = (G % 8 == 0) ? (bx % 8) * (G / 8) + bx / 8 : bx;
    const int gw = vcu * NWAVES + wave, NGW = G * NWAVES;
    unsigned char* ws = args.ws;
    { const int tid = wave * 64 + lane_id_fresh(); for (int u = tid; u < (LDS_BYTES - LDSCTL_OFF) / 4; u += NWAVES * 64) ((LAS unsigned*)(ldsl + LDSCTL_OFF))[u] = 0u; }
    __syncthreads();
    XcdBarrier bar; bar.bar = (unsigned*)(ws + WS_CTL); bar.x = 0; bar.st = nullptr;
    if (MK_N_LAUNCHES == 1) bar = xcd_barrier_post((unsigned*)(ws + WS_CTL), MISC + 8, wave * 64 + lane_id_fresh());
    const int lo = args.ph_lo, hi = args.ph_hi;
#ifndef MK_ONLY
#define MK_ONLY -1
#endif
#define IN(k) ((MK_ONLY < 0 || MK_ONLY == (k)) && lo <= (k) && (k) < hi)
#ifdef MK_X_HASH
#define HR(off, bytes, w) hash_range(ws, off, bytes, w, gt_, NGT_)
#define SEAM(k) do { if (IN(k) && IN((k) + 1)) { xcd_barrier(bar, wave * 64 + lane_id_fresh()); { const int gt_ = bx * 512 + wave * 64 + lane_id_fresh(), NGT_ = G * 512; \
    if ((k) == 2) { HR(WS_S5ABAR, (size_t)(0.6 * MiB), 0); HR(WS_SU, 36 * MiB, 1); } \
    if ((k) == 3) { HR(WS_S5E, (size_t)(3.5 * MiB), 2); HR(WS_Q, 96 * MiB, 20); HR(WS_KN, 72 * MiB, 21); HR(WS_V, 72 * MiB, 22); HR(WS_KPE, (size_t)(4.5 * MiB), 23); } \
    if ((k) == 4) { HR(WS_Q, 96 * MiB, 12); HR(WS_Y, 32 * MiB, 13); } \
    if ((k) == 5) HR(WS_MERGED, 64 * MiB, 14); \
    if ((k) == 6) HR(WS_T, 128 * MiB, 15); \
    if ((k) == 7) { HR(WS_T, 128 * MiB, 16); HR(WS_XM2, 64 * MiB, 16); HR(WS_PU, 64 * MiB, 16); } \
    if ((k) == 8) HR(WS_PQ, 128 * MiB, 17); \
    if ((k) == 9) HR(WS_ROUTE, 32 * MiB, 18); } \
    xcd_barrier(bar, wave * 64 + lane_id_fresh()); } } while (0)
#else
#define SEAM(k) do { if (IN(k) && IN((k) + 1)) { xcd_barrier(bar, wave * 64 + lane_id_fresh()); } } while (0)
#endif
#define MOD ((float*)(ws + WS_MOD))
#define ABAR ((float*)(ws + WS_S5ABAR))
#define POW ((float*)(ws + WS_S5POW))
#define BB ((bf16_t*)(ws + WS_S5BB))
#define CM ((bf16_t*)(ws + WS_S5CM))
#define ROPE ((float*)(ws + WS_ROPE))
#define PART ((float*)(ws + WS_PART))
#define S5E ((float*)(ws + WS_S5E))
#define WIN ((bf16_t*)(ws + WS_WIN))
#define WUQ ((bf16_t*)(ws + WS_WUQ))
#define WUKV ((bf16_t*)(ws + WS_WUKV))
#define WGLU ((bf16_t*)(ws + WS_WGLU))
#define WOUT ((bf16_t*)(ws + WS_WOUT))
#define WQ ((bf16_t*)(ws + WS_WQ))
#define KEYS ((bf16_t*)(ws + WS_KEYS))
#define ZQ ((bf16_t*)(ws + WS_ZQ))
#define YB ((bf16_t*)(ws + WS_Y))
#define SU ((bf16_t*)(ws + WS_SU))
#define GATES ((bf16_t*)(ws + WS_GATES))
#define XM ((bf16_t*)(ws + WS_XM))
#define VB ((bf16_t*)(ws + WS_V))
#define MERGED ((bf16_t*)(ws + WS_MERGED))
#define QB ((bf16_t*)(ws + WS_Q))
#define KN ((bf16_t*)(ws + WS_KN))
#define KPE ((bf16_t*)(ws + WS_KPE))
#define TB ((float*)(ws + WS_T))
#define XM2 ((bf16_t*)(ws + WS_XM2))
#define PQ ((bf16_t*)(ws + WS_PQ))
#define PUB ((bf16_t*)(ws + WS_PU))
#define PVB ((bf16_t*)(ws + WS_PV))
    if (IN(0)) { const int lane = lane_id_fresh(), tid = wave * 64 + lane; (void)tid;
        if (bx < 96) {
            LAS float* sl = (LAS float*)ldsl;
            for (int idx = tid; idx < 17 * 1024; idx += 512) { const int b = idx >> 10, k = idx & 1023; const float cv = (b < 16) ? args.in[I_C][b * 1024 + k] : args.in[I_CCTX][k];
                sl[k * 20 + b] = cv * __builtin_amdgcn_rcpf(1.f + __expf(-cv)); }
            __syncthreads();
            LAS float* red = (LAS float*)(ldsl + 81920);
            for (int item = bx; item < 96; item += G) { const int n0 = item * 64;
                float acc[17];
#pragma unroll
                for (int b = 0; b < 17; ++b) acc[b] = 0.f;
                const float* wp = args.in[I_WMOD] + (size_t)(wave * 128) * 6144 + n0 + lane;
#pragma unroll 4
                for (int kk = 0; kk < 128; ++kk) { const float w = wp[(size_t)kk * 6144]; const LAS float* s = sl + (wave * 128 + kk) * 20;
                    const f32x4 s0 = *(const LAS f32x4*)s, s1 = *(const LAS f32x4*)(s + 4), s2 = *(const LAS f32x4*)(s + 8), s3 = *(const LAS f32x4*)(s + 12); const float s4 = s[16];
                    acc[0] += w * s0[0]; acc[1] += w * s0[1]; acc[2] += w * s0[2]; acc[3] += w * s0[3]; acc[4] += w * s1[0]; acc[5] += w * s1[1]; acc[6] += w * s1[2]; acc[7] += w * s1[3];
                    acc[8] += w * s2[0]; acc[9] += w * s2[1]; acc[10] += w * s2[2]; acc[11] += w * s2[3]; acc[12] += w * s3[0]; acc[13] += w * s3[1]; acc[14] += w * s3[2]; acc[15] += w * s3[3]; acc[16] += w * s4; }
#pragma unroll
                for (int b = 0; b < 17; ++b) red[(wave * 17 + b) * 64 + lane] = acc[b];
                __syncthreads();
                for (int idx = tid; idx < 17 * 64; idx += 512) { const int b = idx >> 6, ln = idx & 63; float s = args.in[I_BMOD][n0 + ln];
#pragma unroll
                    for (int w = 0; w < 8; ++w) s += red[(w * 17 + b) * 64 + ln];
                    MOD[(size_t)b * 6144 + n0 + ln] = s; }
                __syncthreads();
            }
        }
        {
            LAS float* scr = (LAS float*)(ldsl + wave * 16384);
            constexpr int I_1 = 16 * 104, I_2 = 6 * 48, I_3 = 4 * 64, I_4 = 8 * 64, I_5 = 16 * 32, I_6 = 16 * 64, NITEMS = I_1 + I_2 + I_3 + I_4 + I_5 + I_6;
            for (int it = gw; it < NITEMS; it += NGW) { int r = it;
                if (r < I_1) { const int kb = r / 104, nb = r % 104, nd = nb * 32;
                    const int ns = nd < 704 ? nd : (nd < 768 ? -1 : nd - 64);
                    transpose_item(args.in[I_WIN], INW, kb * 64, ns, WIN, 1024, nd, nullptr, scr, lane); continue; } r -= I_1;
                if (r < I_2) { const int kb = r / 48, nb = r % 48; transpose_item(args.in[I_WUQ], 1536, kb * 64, nb * 32, WUQ, 384, nb * 32, args.in[I_QNG], scr, lane); continue; } r -= I_2;
                if (r < I_3) { const int kb = r / 64, nb = r % 64; transpose_item(args.in[I_WUKV], 2048, kb * 64, nb * 32, WUKV, 256, nb * 32, args.in[I_KVNG], scr, lane); continue; } r -= I_3;
                if (r < I_4) { const int kb = r / 64, nb = r % 64, nd = nb * 32, tile = nd >> 8, wi = nd & 255;
                    const int ns = wi < 128 ? tile * 128 + wi : 1024 + tile * 128 + (wi - 128);
                    transpose_item(args.in[I_WGLU], 2048, kb * 64, ns, WGLU, 512, nd, nullptr, scr, lane); continue; } r -= I_4;
                if (r < I_5) { const int kb = r / 32, nb = r % 32; transpose_item(args.in[I_WOUT], 1024, kb * 64, nb * 32, WOUT, 1024, nb * 32, nullptr, scr, lane); continue; } r -= I_5;
                { const int kb = r / 64, nb = r % 64; transpose_item(args.in[I_PWQ], 2048, kb * 64, nb * 32, WQ, 1024, nb * 32, nullptr, scr, lane); }
            }
        }
        const int gt = bx * 512 + tid, NGT = G * 512;
#ifdef MK_X_SWEEP
        { f32x4 accv = {0.f, 0.f, 0.f, 0.f};
          for (int i = gt; i < MLAT * DM / 4; i += NGT) { const f32x4 t = ((const f32x4*)args.in[I_X])[i]; accv += t; }
          asm volatile("" :: "v"(accv[0]), "v"(accv[1]), "v"(accv[2]), "v"(accv[3])); }
#endif
#ifdef MK_X_P0POISON
        for (size_t i = gt; i < (508 * MiB - WS_ZQ) / 16; i += NGT) ((u32x4*)(ws + WS_ZQ))[i] = (u32x4){0xAAAAAAAAu, 0xAAAAAAAAu, 0xAAAAAAAAu, 0xAAAAAAAAu};
        for (size_t i = gt; i < (7 * MiB) / 16; i += NGT) ((u32x4*)(ws + 3 * MiB))[i] = (u32x4){0xAAAAAAAAu, 0xAAAAAAAAu, 0xAAAAAAAAu, 0xAAAAAAAAu};
#endif
        for (int i = gt; i < 16 * 128 * 128 / 8; i += NGT) {
            const f32x4 a = ((const f32x4*)args.in[I_PKEYS])[2 * i], b = ((const f32x4*)args.in[I_PKEYS])[2 * i + 1]; ((u32x4*)KEYS)[i] = pack8(a, b); }
        for (int i = gt; i < 4096; i += NGT) {
            const int p = i & 63, dg = i >> 6;
            const double dt = exp((double)args.in[I_S5LDT][dg]), ar = args.in[I_S5ARE][i], ai = args.in[I_S5AIM][i];
            const double mag = exp(ar * dt), abr = mag * cos(ai * dt), abi = mag * sin(ai * dt), den = ar * ar + ai * ai;
            const double fr = ((abr - 1.0) * ar + abi * ai) / den, fi = (abi * ar - (abr - 1.0) * ai) / den;
            ABAR[2 * i] = (float)abr; ABAR[2 * i + 1] = (float)abi;
            { const double m1 = exp(ar * dt * 256.0), m2 = exp(ar * dt * 512.0);
              POW[2 * i] = (float)(m1 * cos(ai * dt * 256.0)); POW[2 * i + 1] = (float)(m1 * sin(ai * dt * 256.0));
              POW[8192 + 2 * i] = (float)(m2 * cos(ai * dt * 512.0)); POW[8192 + 2 * i + 1] = (float)(m2 * sin(ai * dt * 512.0)); }
            for (int c = 0; c < 16; ++c) { const double br = args.in[I_S5BRE][(size_t)i * 16 + c], bi = args.in[I_S5BIM][(size_t)i * 16 + c];
                BB[((size_t)(dg * 2 + 0) * 64 + p) * 16 + c] = (bf16_t)(cvt_pk_bf16((float)(fr * br - fi * bi), 0.f) & 0xffffu);
                BB[((size_t)(dg * 2 + 1) * 64 + p) * 16 + c] = (bf16_t)(cvt_pk_bf16((float)(fr * bi + fi * br), 0.f) & 0xffffu);
                CM[((size_t)dg * 16 + c) * 128 + p] = (bf16_t)(cvt_pk_bf16(args.in[I_S5CRE][((size_t)dg * 16 + c) * 64 + p], 0.f) & 0xffffu);
                CM[((size_t)dg * 16 + c) * 128 + 64 + p] = (bf16_t)(cvt_pk_bf16(-args.in[I_S5CIM][((size_t)dg * 16 + c) * 64 + p], 0.f) & 0xffffu); }
        }
        for (int i = gt; i < 1024; i += NGT) { const int pos = i >> 4, idx = i & 15;
            const double ang = (double)pos * exp(-9.210340371976184 * (double)idx / 16.0); ROPE[2 * i] = (float)cos(ang); ROPE[2 * i + 1] = (float)sin(ang); }
    }
    SEAM(0);
    if (IN(1)) { const int lane = lane_id_fresh(), tid = wave * 64 + lane; (void)tid;
        for (int m = gw; m < MTOT; m += NGW) {
            const int b = (m < MLAT) ? (m >> 11) : 16; const float* xr = (m < MLAT) ? args.in[I_X] + (size_t)m * DM : args.in[I_CTX] + (size_t)(m - MLAT) * DM;
            modulate_row(xr, MOD + (size_t)b * 6144, MOD + (size_t)b * 6144 + 1024, XM + (size_t)m * DM, lane); }
    }
    SEAM(1);
    if (IN(2)) {
        pg8::Gemm g{XM, WIN, 1024, 1024, 1024}; pg8::StaticOrder S; S.init(MLAT / 256, 13, G, bx, MCTX / 256, 5);
        EpiInProj E{ZQ, SU, GATES, PART};
        pg8::gemm_phase(ldsl, g, S, E, wave * 64 + lane_id_fresh());
    }
    SEAM(2);
    if (IN(3)) { const int lane = lane_id_fresh(), tid = wave * 64 + lane; (void)tid;
        { pg8::Gemm g{ZQ, WUQ, 768, 384, 384}; pg8::StaticOrder S; S.init(MLAT / 256, 6, G, bx); EpiUQ E{QB, PART}; pg8::gemm_phase(ldsl, g, S, E, wave * 64 + lane_id_fresh()); }
        { pg8::Gemm g{ZQ + 384, WUKV, 768, 256, 256}; pg8::StaticOrder S; S.init(MTOT / 256, 8, G, bx); EpiUKV E{KN, VB, PART}; pg8::gemm_phase(ldsl, g, S, E, wave * 64 + lane_id_fresh()); }
        const int gt = bx * 512 + tid, NGT = G * 512;
        for (int i = gt; i < MTOT * 32; i += NGT) {
            const int row = i >> 5, pp = i & 31, part = pp >> 4, idx = pp & 15;
            const bf16_t* z = ZQ + (size_t)row * 768 + 640 + part * 32 + idx; const float x1 = bf_lo((unsigned)z[0]), x2 = bf_lo((unsigned)z[16]);
            float o1 = x1, o2 = x2; int b, key;
            if (row < MLAT) { b = row >> 11; const int l = row & 2047; key = CTXL + l; const int pos = part == 0 ? (l >> 6) : (l & 63); const float cs = ROPE[(pos * 16 + idx) * 2], sn = ROPE[(pos * 16 + idx) * 2 + 1];
                o1 = x1 * cs - x2 * sn; o2 = x2 * cs + x1 * sn; }
            else { const int r2 = row - MLAT; b = r2 >> 8; key = r2 & 255; }
            bf16_t* kp = KPE + ((size_t)b * NKEY + key) * 64 + part * 32 + idx;
            kp[0] = (bf16_t)(cvt_pk_bf16(o1, 0.f) & 0xffffu); kp[16] = (bf16_t)(cvt_pk_bf16(o2, 0.f) & 0xffffu); }
#if MK_STAGE >= 3
        for (int u = gw; u < 2 * 32 * 8 * 7; u += NGW) s5_passA(SU, ABAR, BB, S5E, u, lane);
#ifdef MK_X_DUPA
        for (int u = gw; u < 2 * 32 * 8 * 7; u += NGW) s5_passA(SU, ABAR, BB, (float*)(ws + 492 * MiB), u, lane);
#endif
#endif
    }
    SEAM(3);
    if (IN(4)) { const int lane = lane_id_fresh(), tid = wave * 64 + lane; (void)tid;
#if MK_STAGE >= 2
#pragma unroll 1
        for (int U = vcu; U < 1024; U += G) { const int bh = U >> 3, qb = U & 7, b = bh >> 3, h = bh & 7;
            att::attn_unit(QB + ((size_t)bh * SEQ + qb * 256) * DK, KN + (size_t)bh * NKEY * 128, KPE + (size_t)b * NKEY * 64, VB + (size_t)bh * NKEY * 128,
                           GATES + ((size_t)(b * SEQ + qb * 256)) * 2048 + h * 128, ROPE, qb * 256, (char*)lds, wave * 64 + lane_id_fresh()); }
#endif
#if MK_STAGE >= 3
        for (int u = gw; u < 2048; u += NGW) s5_passB(SU, ABAR, POW, BB, CM, S5E, args.in[I_S5D], YB, u, lane, ldsl + wave * S5_LDS_WAVE);
#endif
    }
    SEAM(4);
    if (IN(5)) {
        pg8::Gemm g{YB, WGLU, 512, 512, 512}; pg8::StaticOrder S; S.init(MLAT / 256, 8, G, bx); EpiGLU E{QB, GATES, MERGED}; pg8::gemm_phase(ldsl, g, S, E, wave * 64 + lane_id_fresh());
    }
    SEAM(5);
    if (IN(6)) {
        pg8::Gemm g{MERGED, WOUT, 1024, 1024, 1024}; pg8::StaticOrder S; S.init(MLAT / 256, 4, G, bx); EpiOut E{args.in[I_X], MOD, TB}; pg8::gemm_phase(ldsl, g, S, E, wave * 64 + lane_id_fresh());
    }
    SEAM(6);
    if (IN(7)) { const int lane = lane_id_fresh(), tid = wave * 64 + lane; (void)tid;
        for (int m = gw; m < MLAT; m += NGW) { const int b = m >> 11;
            ln1_row(TB + (size_t)m * DM, args.in[I_LN1G], args.in[I_LN1B], MOD + (size_t)b * 6144 + 3072, MOD + (size_t)b * 6144 + 4096, XM2 + (size_t)m * DM, lane); }
#if MK_STAGE >= 5
        const int gt = bx * 512 + tid, NGT = G * 512;
        for (int i = gt; i < 2 * PEXP * DM / 8; i += NGT) { const bool isU = i < PEXP * DM / 8; const int j = isU ? i : i - PEXP * DM / 8;
            const f32x4* src = (const f32x4*)(isU ? args.in[I_PU] : args.in[I_PV]); const f32x4 a = src[2 * j], b = src[2 * j + 1]; ((u32x4*)(isU ? PUB : PVB))[j] = pack8(a, b); }
#endif
    }
    SEAM(7);
#if MK_STAGE >= 5
    if (IN(8)) {
        pg8::Gemm g{XM2, WQ, 1024, 1024, 1024}; pg8::StaticOrder S; S.init(MLAT / 256, 8, G, bx); EpiPQ E{PQ}; pg8::gemm_phase(ldsl, g, S, E, wave * 64 + lane_id_fresh());
    }
#endif
    SEAM(8);
#if MK_STAGE >= 5
    if (IN(9)) { const int lane = lane_id_fresh(), tid = wave * 64 + lane; const int h = bx & 7;
        for (int c = tid; c < 4096; c += 512) { const int z = c >> 11, key = (c >> 4) & 127, c16 = c & 15;
            *(LAS u32x4*)(ldsl + peer::ksw(z, key, c16 * 16)) = *(const u32x4*)(KEYS + ((size_t)(h * 2 + z) * 128 + key) * 128 + c16 * 8); }
        __syncthreads();
#ifdef MK_X_LINROUTE
        { const int gt = bx * 512 + tid, NGT = G * 512; unsigned* RI = (unsigned*)(ws + WS_ROUTE); float* RWp = (float*)(ws + WS_ROUTE + 16 * MiB);
          for (int i = gt; i < MLAT * 128; i += NGT) { const int tok = i >> 7, k = i & 127; const u32x4 a = *(const u32x4*)(PQ + (size_t)tok * 2048 + k * 16), b = *(const u32x4*)(PQ + (size_t)tok * 2048 + k * 16 + 8);
              const float sm = (bf_lo(a.x) + bf_hi(a.x) + bf_lo(a.y) + bf_hi(a.y) + bf_lo(a.z) + bf_hi(a.z) + bf_lo(a.w) + bf_hi(a.w)) + (bf_lo(b.x) + bf_hi(b.x) + bf_lo(b.y) + bf_hi(b.y) + bf_lo(b.z) + bf_hi(b.z) + bf_lo(b.w) + bf_hi(b.w));
              RI[i] = ((unsigned)tok * 131u + (unsigned)k * 1237u) & 16383u; RWp[i] = sm * (1.f / 128.f); } }
#else
#pragma unroll 1
        for (int j = wave; j < 32; j += 8) { int l2 = lane; asm volatile("" : "+v"(l2));
#ifdef MK_X_ROUTEIN
            peer::route_unit(XM2, (const char*)lds,
#else
            peer::route_unit(PQ, (const char*)lds,
#endif
                (unsigned*)(ws + WS_ROUTE), (float*)(ws + WS_ROUTE + 16 * MiB), ((bx >> 3) * 32 + j) * 32, h, l2); }
#ifdef MK_X_DUP
#pragma unroll 1
        for (int j = wave; j < 32; j += 8) { int l2 = lane; asm volatile("" : "+v"(l2));
            peer::route_unit(PQ, (const char*)lds, (unsigned*)(ws + 480 * MiB), (float*)(ws + 496 * MiB), ((bx >> 3) * 32 + j) * 32, h, l2); }
#endif
#endif
    }
#endif
    SEAM(9);
    if (IN(10)) { const int lane = lane_id_fresh();
#pragma unroll 1
        for (int m = gw; m < MLAT; m += NGW) { const int b = m >> 11;
            float v[16];
#if MK_STAGE >= 5
            { float f[16];
              peer::gather_token(XM2 + (size_t)m * DM, (const unsigned*)(ws + WS_ROUTE) + (size_t)m * 128, (const float*)(ws + WS_ROUTE + 16 * MiB) + (size_t)m * 128, PUB, PVB, f, lane);
#ifdef MK_X_DUPG
              { float f2[16]; int l2 = lane; asm volatile("" : "+v"(l2));
                peer::gather_token(XM2 + (size_t)m * DM, (const unsigned*)(ws + WS_ROUTE) + (size_t)m * 128, (const float*)(ws + WS_ROUTE + 16 * MiB) + (size_t)m * 128, PUB, PVB, f2, l2);
                bool bad = false;
#pragma unroll
                for (int i = 0; i < 16; ++i) bad |= (__builtin_bit_cast(unsigned, f[i]) != __builtin_bit_cast(unsigned, f2[i]));
                if (__any(bad)) {
#pragma unroll
                    for (int i = 0; i < 16; ++i) f[i] += 1000.f; } }
#endif
#pragma unroll
              for (int j = 0; j < 2; ++j) { const f32x4* gp = (const f32x4*)(MOD + (size_t)b * 6144 + 5120 + 512 * j + 8 * lane); const f32x4 g0 = gp[0], g1 = gp[1];
#pragma unroll
                  for (int e = 0; e < 4; ++e) { v[8 * j + e] = MK_FSCALE * g0[e] * f[8 * j + e]; v[8 * j + 4 + e] = MK_FSCALE * g1[e] * f[8 * j + 4 + e]; } } }
#else
#pragma unroll
            for (int i = 0; i < 16; ++i) v[i] = 0.f;
#endif
#ifdef MK_X_DUP
            { const unsigned* ia = (const unsigned*)(ws + WS_ROUTE) + (size_t)m * 128; const unsigned* ib = (const unsigned*)(ws + 480 * MiB) + (size_t)m * 128;
              const unsigned* wa = (const unsigned*)(ws + WS_ROUTE + 16 * MiB) + (size_t)m * 128; const unsigned* wb = (const unsigned*)(ws + 496 * MiB) + (size_t)m * 128;
              const bool bad = (ia[lane] != ib[lane]) | (ia[64 + lane] != ib[64 + lane]) | (wa[lane] != wb[lane]) | (wa[64 + lane] != wb[64 + lane]);
              if (__any(bad)) {
#pragma unroll
                  for (int i = 0; i < 16; ++i) v[i] += 1000.f; } }
#endif
#ifdef MK_X_RCMP
            { const unsigned* ia = (const unsigned*)(ws + WS_ROUTE) + (size_t)m * 128; unsigned* ib = (unsigned*)(ws + 496 * MiB) + (size_t)m * 128;
              const unsigned magic = *(const unsigned*)(ws + 495 * MiB);
              const unsigned* wa_ = (const unsigned*)(ws + WS_ROUTE + 16 * MiB) + (size_t)m * 128; unsigned* wb_ = (unsigned*)(ws + 479 * MiB) + (size_t)m * 128;
              const unsigned d0 = wa_[lane], d1 = wa_[64 + lane], q0 = wb_[lane], q1 = wb_[64 + lane]; wb_[lane] = d0; wb_[64 + lane] = d1;
              const unsigned c0 = ia[lane], c1 = ia[64 + lane], p0 = ib[lane], p1 = ib[64 + lane];
              if (magic == 0x600DF00Du && __any((c0 != p0) | (c1 != p1) | (d0 != q0) | (d1 != q1))) {
#pragma unroll
                  for (int i = 0; i < 16; ++i) v[i] += 1000.f; }
              ib[lane] = c0; ib[64 + lane] = c1;
              if (m == MLAT - 1 && lane == 0) *(unsigned*)(ws + 495 * MiB) = 0x600DF00Du; }
#endif
#ifdef MK_X_ECMP
            { const unsigned* ea = (const unsigned*)(ws + WS_S5E) + (size_t)m * 28; unsigned* eb = (unsigned*)(ws + 500 * MiB) + (size_t)m * 28;
              const unsigned magic = *(const unsigned*)(ws + 499 * MiB);
              const unsigned cur = lane < 28 ? ea[lane] : 0u, prev = lane < 28 ? eb[lane] : 0u;
              if (magic == 0x600DF00Du && __any(cur != prev)) {
#pragma unroll
                  for (int i = 0; i < 16; ++i) v[i] += 1000.f; }
              if (lane < 28) eb[lane] = cur;
              if (m == MLAT - 1 && lane == 0) *(unsigned*)(ws + 499 * MiB) = 0x600DF00Du; }
#endif
#ifdef MK_X_DUPA
            { const unsigned* ea = (const unsigned*)(ws + WS_S5E) + (size_t)m * 28; const unsigned* eb = (const unsigned*)(ws + 492 * MiB) + (size_t)m * 28;
              const bool bad = lane < 28 && ea[lane] != eb[lane];
              if (__any(bad)) {
#pragma unroll
                  for (int i = 0; i < 16; ++i) v[i] += 1000.f; } }
#endif
            float s = 0.f;
#pragma unroll
            for (int j = 0; j < 2; ++j) { const f32x4* hp = (const f32x4*)(TB + (size_t)m * DM + 512 * j + 8 * lane); const f32x4 h0 = hp[0], h1 = hp[1];
#pragma unroll
                for (int e = 0; e < 4; ++e) { v[8 * j + e] += ALPHA * h0[e]; v[8 * j + 4 + e] += ALPHA * h1[e]; } }
#pragma unroll
            for (int i = 0; i < 16; ++i) s += v[i];
            const float mean = wave_sum(s) * (1.f / DM); float s2 = 0.f;
#pragma unroll
            for (int i = 0; i < 16; ++i) { v[i] -= mean; s2 += v[i] * v[i]; }
            const float rstd = rsqrtf(wave_sum(s2) * (1.f / DM) + LN_EPS);
#pragma unroll
            for (int j = 0; j < 2; ++j) { const f32x4* gp = (const f32x4*)(args.in[I_LN2G] + 512 * j + 8 * lane); const f32x4* bp = (const f32x4*)(args.in[I_LN2B] + 512 * j + 8 * lane);
                f32x4* op = (f32x4*)(args.out + (size_t)m * DM + 512 * j + 8 * lane);
                f32x4 o0, o1; const f32x4 g0 = gp[0], g1 = gp[1], b0 = bp[0], b1 = bp[1];
#pragma unroll
                for (int e = 0; e < 4; ++e) { o0[e] = v[8 * j + e] * rstd * g0[e] + b0[e]; o1[e] = v[8 * j + 4 + e] * rstd * g1[e] + b1[e]; }
#ifdef MK_X_HASH
                if (j == 0 && lane == 0 && m < 3) {
                    const unsigned hv = __hip_atomic_load((unsigned*)(ws + WS_CTL) + 8192 + m, __ATOMIC_RELAXED, __HIP_MEMORY_SCOPE_AGENT);
                    float sc_ = 100.f; for (int q = m; q < 2; ++q) sc_ *= 3.f;
#pragma unroll
                    for (int e = 0; e < 4; ++e) { o0[e] += ((hv >> e) & 1u) ? sc_ : -sc_; o1[e] += ((hv >> (4 + e)) & 1u) ? sc_ : -sc_; } }
#endif
                op[0] = o0; op[1] = o1; }
        }
    }
#undef IN
#undef SEAM
}

extern "C" void kernel_launch(void* const* d_in, const int* in_sizes, int n_in, void* d_out, int out_size, void* d_ws, size_t ws_size, hipStream_t stream) {
    static int grid = 0;
    if (grid == 0) {
        if (n_in != 29 || in_sizes[0] != MLAT * DM || out_size != MLAT * DM || ws_size < WS_END) {
            fprintf(stderr, "kernel_launch: unexpected problem: n_in %d in0 %d out %d ws %zu (need %zu)\n", n_in, n_in > 0 ? in_sizes[0] : -1, out_size, ws_size, (size_t)WS_END); grid = -1; return; }
        int dev = 0, cus = 0;
        if (hipGetDevice(&dev) != hipSuccess || hipDeviceGetAttribute(&cus, hipDeviceAttributeMultiprocessorCount, dev) != hipSuccess) { grid = -1; return; }
        if (hipFuncSetAttribute((const void*)mk_fwd, hipFuncAttributeMaxDynamicSharedMemorySize, LDS_BYTES) != hipSuccess) { fprintf(stderr, "kernel_launch: hipFuncSetAttribute failed\n"); grid = -1; return; }
        int per_cu = 0;
        if (hipOccupancyMaxActiveBlocksPerMultiprocessor(&per_cu, (const void*)mk_fwd, NWAVES * 64, LDS_BYTES) != hipSuccess || per_cu < 1)
            fprintf(stderr, "kernel_launch: occupancy query reports %d blocks per CU\n", per_cu);
        (void)hipGetLastError();
        grid = cus;
    }
    if (grid < 0) return;
    if (hipMemsetAsync((char*)d_ws + WS_CTL, 0, CTL_ZERO_BYTES, stream) != hipSuccess) return;
    Args a{};
    for (int i = 0; i < 29; ++i) a.in[i] = (const float*)d_in[i];
    a.out = (float*)d_out; a.ws = (unsigned char*)d_ws;
#if MK_N_LAUNCHES == 1
    a.ph_lo = 0; a.ph_hi = NPH;
    hipLaunchKernelGGL(mk_fwd, dim3(grid), dim3(NWAVES * 64), LDS_BYTES, stream, a);
#else
    for (int p = 0; p < NPH; ++p) { a.ph_lo = p; a.ph_hi = p + 1; hipLaunchKernelGGL(mk_fwd, dim3(grid), dim3(NWAVES * 64), LDS_BYTES, stream, a); }
#endif
    const hipError_t le = hipPeekAtLastError();
    if (le != hipSuccess) fprintf(stderr, "kernel_launch: launch failed: %s\n", hipGetErrorName(le));
}
```

```cpp
#include <hip/hip_runtime.h>
#include <cstdio>
#include <cstdint>

#define GAS __attribute__((address_space(1)))
#define LAS __attribute__((address_space(3)))
typedef unsigned short bf16_t;
typedef short bf16x8 __attribute__((ext_vector_type(8)));
typedef short s16x4 __attribute__((ext_vector_type(4)));
typedef short v4i16_t __attribute__((ext_vector_type(4)));
typedef float f32x2 __attribute__((ext_vector_type(2)));
typedef float f32x4 __attribute__((ext_vector_type(4)));
typedef float f32x16 __attribute__((ext_vector_type(16)));
typedef unsigned u32x2 __attribute__((ext_vector_type(2)));
typedef unsigned u32x4 __attribute__((ext_vector_type(4)));


#ifndef MK_FSCALE
#define MK_FSCALE (1.f)
#endif
#ifndef MK_STAGE
#define MK_STAGE 99
#endif
#ifndef MK_N_LAUNCHES
#define MK_N_LAUNCHES 1
#endif

constexpr int DM = 1024, NB = 16, SEQ = 2048, CTXL = 256, MLAT = NB * SEQ, MCTX = NB * CTXL, MTOT = MLAT + MCTX;
constexpr int NH = 8, DK = 192, DV = 128, QRANK = 384, KVRANK = 256, NKEY = CTXL + SEQ;
constexpr int INW = 3264;
constexpr int S5W = 512, S5G = 32, S5C = 16, S5P = 64;
constexpr int PEH = 8, PEK = 128, PEXP = 16384, PETOP = 16;
constexpr float LN_EPS = 1e-6f;
constexpr float ALPHA = 1.189207115002721f;
constexpr float QSCALE = 0.07216878364870322f * 1.4426950408889634f;

constexpr size_t MiB = 1u << 20;
constexpr size_t WS_CTL = 0, CTL_ZERO_BYTES = 64 * 1024;
constexpr size_t WS_MOD = 1 * MiB;
constexpr size_t WS_S5ABAR = 1 * MiB + 512 * 1024;
constexpr size_t WS_S5POW = WS_S5ABAR + 32768;
constexpr size_t WS_S5BB = WS_S5POW + 65536;
constexpr size_t WS_S5CM = WS_S5BB + 262144;
constexpr size_t WS_ROPE = WS_S5CM + 262144;
constexpr size_t WS_PART = 3 * MiB;
constexpr size_t WS_S5E = 6 * MiB;
constexpr size_t WS_WIN = 10 * MiB;
constexpr size_t WS_WUQ = WS_WIN + 3328 * 1024 * 2;
constexpr size_t WS_WUKV = WS_WUQ + 1536 * 384 * 2;
constexpr size_t WS_WGLU = WS_WUKV + 2048 * 256 * 2;
constexpr size_t WS_WOUT = WS_WGLU + 2048 * 512 * 2;
constexpr size_t WS_WQ = WS_WOUT + 1024 * 1024 * 2;
constexpr size_t WS_KEYS = WS_WQ + 2048 * 1024 * 2;
static_assert(WS_KEYS + 16 * 128 * 128 * 2 <= 28 * MiB, "weights region");
constexpr size_t WS_ZQ = 28 * MiB;
constexpr size_t WS_Y = 28 * MiB;
constexpr size_t WS_PU = 28 * MiB, WS_PV = 60 * MiB;
constexpr size_t WS_SU = 82 * MiB;
constexpr size_t WS_GATES = 118 * MiB;
constexpr size_t WS_XM2 = 118 * MiB;
constexpr size_t WS_PQ = 182 * MiB;
constexpr size_t WS_XM = 246 * MiB;
constexpr size_t WS_V = 246 * MiB;
constexpr size_t WS_MERGED = 246 * MiB;
constexpr size_t WS_Q = 318 * MiB;
constexpr size_t WS_T = 318 * MiB;
constexpr size_t WS_KN = 414 * MiB;
constexpr size_t WS_KPE = 486 * MiB;
constexpr size_t WS_ROUTE = 448 * MiB;
constexpr size_t WS_END = 492 * MiB;

#define RLX_AGENT __ATOMIC_RELAXED, __HIP_MEMORY_SCOPE_AGENT
#define LDS_WAIT() asm volatile("s_waitcnt lgkmcnt(0)" ::: "memory")
#define VM_WAIT() asm volatile("s_waitcnt vmcnt(0)" ::: "memory")
typedef __bf16 bf16x2_t __attribute__((ext_vector_type(2)));
__device__ __forceinline__ unsigned cvt_pk_bf16(float lo, float hi) { const f32x2 v = {lo, hi}; const bf16x2_t b = __builtin_convertvector(v, bf16x2_t); return __builtin_bit_cast(unsigned, b); }
__device__ __forceinline__ float bf_lo(unsigned u) { return __builtin_bit_cast(float, u << 16); }
__device__ __forceinline__ float bf_hi(unsigned u) { return __builtin_bit_cast(float, u & 0xffff0000u); }
__device__ __forceinline__ float wave_sum(float v) {
#pragma unroll
    for (int o = 1; o < 64; o <<= 1) v += __shfl_xor(v, o);
    return v;
}
__device__ __forceinline__ int lane_id_fresh() { unsigned z; asm volatile("s_mov_b32 %0, 0" : "=s"(z)); return (int)__builtin_amdgcn_mbcnt_hi(~0u, __builtin_amdgcn_mbcnt_lo(~0u, z)); }
__device__ __forceinline__ float sigmoidf_(float x) { return __builtin_amdgcn_rcpf(1.f + __expf(-x)); }
__device__ __forceinline__ float gelu_tanh(float x) {
    const float u = 0.7978845608028654f * (x + 0.044715f * x * x * x);
    return x * __builtin_amdgcn_rcpf(1.f + __expf(-2.f * u));
}

#define MFMA32(a, b, c) __builtin_amdgcn_mfma_f32_32x32x16_bf16(a, b, c, 0, 0, 0)
#define MFMA_PAD() do { __builtin_amdgcn_sched_barrier(0); asm volatile("s_nop 15\n\ts_nop 15\n\ts_nop 15\n\ts_nop 15\n\ts_nop 15\n\ts_nop 15" ::: "memory"); __builtin_amdgcn_sched_barrier(0); } while (0)

namespace pg8 {
constexpr int BM = 256, BK = 64, HALF = 128, HTB = HALF * BK * 2, STAGE_BYTES = 8 * HTB, NXCD = 8, WGM = 8;
__host__ __device__ __forceinline__ int lds_byte(int r, int c) { const int st = (r >> 4) * 2 + (c >> 5), rr = r & 15, cc = c & 31, ob = rr * 64 + cc * 2; return st * 1024 + (ob ^ (((ob >> 9) & 1) << 5)); }
__host__ __device__ __forceinline__ void stage_rc(int b, int& R, int& C) { const int st = b / 1024, sb = b % 1024, swz = sb ^ (((sb >> 9) & 1) << 5); R = (st >> 1) * 16 + swz / 64; C = (st & 1) * 32 + (swz % 64) / 2; }
__host__ __device__ __forceinline__ int perm32(int rho) { const int n = rho >> 4, i = rho & 15; return 8 * (i >> 2) + 4 * n + (i & 3); }
struct Unit { int pm, pn; };
struct Gemm { const bf16_t* A; const bf16_t* Bt; int lda, ldb, K; };
struct StaticOrder {
    int nM, nN, nwg, G, c, nM2, nN2, pm0;
    __device__ void init(int nM_, int nN_, int G_, int c_, int nM2_ = 0, int nN2_ = 0) { nM = nM_; nN = nN_; nwg = nM * nN; G = G_; c = c_; nM2 = nM2_; nN2 = nN2_; pm0 = nM_; }
    __device__ bool next(int i, Unit& u) const {
        const long L = (long)i * G + c;
        if (L >= nwg) { const int e = (int)(L - nwg); if (e >= nM2 * nN2) return false; u.pm = pm0 + e % nM2; u.pn = e / nM2; return true; }
        int wgid = (int)L; { const int q = nwg / NXCD, r = nwg % NXCD, xcd = wgid % NXCD, off = wgid / NXCD; wgid = (xcd < r ? xcd * (q + 1) : r * (q + 1) + (xcd - r) * q) + off; }
        const int nig = WGM * nN, gid = wgid / nig, fm = gid * WGM, gsz = (nM - fm) < WGM ? (nM - fm) : WGM;
        u.pm = fm + ((wgid % nig) % gsz); u.pn = (wgid % nig) / gsz; return true;
    }
};

template <class Epi, class Sched>
__device__ __forceinline__ void gemm_phase(LAS unsigned char* lds, const Gemm g, const Sched& S, const Epi& E, int tid_) {
    asm volatile("" : "+v"(tid_));
    const int tid = tid_, wid = __builtin_amdgcn_readfirstlane(tid >> 6), lane = tid & 63, wr = wid >> 2, wc = wid & 3, fr = lane & 15, fq = lane >> 4;
    const int K = g.K, nt = K / BK;
    unsigned voffA[2], voffB[2];
#pragma unroll
    for (int i = 0; i < 2; ++i) { int R, C; stage_rc(tid * 16 + i * 8192, R, C); const int Rb = Epi::PERM ? ((R & ~31) + perm32(R & 31)) : R;
        voffA[i] = (unsigned)(R * g.lda + C) * 2u; voffB[i] = (unsigned)(Rb * g.ldb + C) * 2u; }
    const size_t kstep = (size_t)(BK * 2);
    const size_t hstepA = (size_t)HALF * g.lda * 2, hstepB = (size_t)HALF * g.ldb * 2;
    const size_t tstepA = 2 * hstepA, tstepB = 2 * hstepB;
    const unsigned ldsw = (unsigned)wid * 1024u;
    const int aoff = lds_byte(wr * 64 + fr, fq * 8), boff = lds_byte(wc * 32 + fr, fq * 8);
#define PG8_SA(b, h) (((b) * 2 + (h)) * HTB)
#define PG8_SB(b, h) ((4 + (b) * 2 + (h)) * HTB)
#define PG8_STAGE(bufoff, gbase, voff) do { _Pragma("unroll") for (int _i = 0; _i < 2; ++_i) \
        __builtin_amdgcn_global_load_lds((const unsigned*)((const char*)(gbase) + (voff)[_i]), (LAS unsigned*)(lds + (bufoff) + ldsw + _i * 8192), 16, 0, 0); } while (0)
#define PG8_LDA(dst, b, h) do { _Pragma("unroll") for (int m = 0; m < 4; ++m) _Pragma("unroll") for (int k = 0; k < 2; ++k) dst[m][k] = *(const LAS bf16x8*)(lds + PG8_SA(b, h) + aoff + m * 2048 + k * 1024); } while (0)
#define PG8_LDB(dst, b, h) do { _Pragma("unroll") for (int n = 0; n < 2; ++n) _Pragma("unroll") for (int k = 0; k < 2; ++k) dst[n][k] = *(const LAS bf16x8*)(lds + PG8_SB(b, h) + boff + n * 2048 + k * 1024); } while (0)
#define PG8_MMA(ai, bj, At, Bt) do { __builtin_amdgcn_s_setprio(1); _Pragma("unroll") for (int m = 0; m < 4; ++m) _Pragma("unroll") for (int n = 0; n < 2; ++n) _Pragma("unroll") for (int k = 0; k < 2; ++k) \
        acc[ai][bj][m][n] = __builtin_amdgcn_mfma_f32_16x16x32_bf16(Bt[n][k], At[m][k], acc[ai][bj][m][n], 0, 0, 0); __builtin_amdgcn_s_setprio(0); } while (0)
#define PG8_WAIT_V(n) asm volatile("s_waitcnt vmcnt(" #n ")" ::: "memory")
#define PG8_WAIT_L(n) asm volatile("s_waitcnt lgkmcnt(" #n ")" ::: "memory")
#define PG8_BAR __builtin_amdgcn_s_barrier()
#define PG8_SCHED __builtin_amdgcn_sched_barrier(0)
    Unit cur, nxt; int ui = 0;
    if (!S.next(0, cur)) return;
    f32x4 acc[2][2][4][2];
#pragma unroll
    for (int a = 0; a < 2; ++a)
#pragma unroll
        for (int b = 0; b < 2; ++b)
#pragma unroll
            for (int m = 0; m < 4; ++m)
#pragma unroll
                for (int n = 0; n < 2; ++n) acc[a][b][m][n] = (f32x4){0.f, 0.f, 0.f, 0.f};
    bf16x8 At[4][2], B0[2][2], B1[2][2];
    const char* cA = (const char*)g.A + (size_t)cur.pm * tstepA; const char* cB = (const char*)g.Bt + (size_t)cur.pn * tstepB;
    PG8_STAGE(PG8_SB(0, 0), cB, voffB); PG8_STAGE(PG8_SB(0, 1), cB + hstepB, voffB); PG8_STAGE(PG8_SA(0, 0), cA, voffA); PG8_STAGE(PG8_SA(0, 1), cA + hstepA, voffA);
    if (wr == 1) PG8_BAR;
    PG8_WAIT_V(2); PG8_BAR;
    PG8_STAGE(PG8_SB(1, 0), cB + kstep, voffB); PG8_STAGE(PG8_SA(1, 0), cA + kstep, voffA); PG8_STAGE(PG8_SB(1, 1), cB + hstepB + kstep, voffB);
    PG8_WAIT_V(6); PG8_BAR;
    for (;;) {
        const bool has_next = S.next(ui + 1, nxt);
        const char* nA = has_next ? (const char*)g.A + (size_t)nxt.pm * tstepA : cA; const char* nB = has_next ? (const char*)g.Bt + (size_t)nxt.pn * tstepB : cB;
        for (int t = 0; t < nt; t += 2) {
            const bool last = (t == nt - 2);
            const char* a1 = cA + (size_t)(t + 1) * kstep;
            const char* a2 = last ? nA : cA + (size_t)(t + 2) * kstep; const char* b2 = last ? nB : cB + (size_t)(t + 2) * kstep;
            const char* a3 = a2 + kstep; const char* b3 = b2 + kstep;
            PG8_LDB(B0, 0, 0); PG8_LDB(B1, 0, 1); PG8_SCHED; PG8_LDA(At, 0, 0); PG8_STAGE(PG8_SA(1, 1), a1 + hstepA, voffA);
            PG8_WAIT_V(8); PG8_WAIT_L(0); PG8_BAR; PG8_MMA(0, 0, At, B0); PG8_MMA(0, 1, At, B1); PG8_BAR; PG8_SCHED;
            PG8_LDA(At, 0, 1); PG8_STAGE(PG8_SB(0, 0), b2, voffB); PG8_STAGE(PG8_SB(0, 1), b2 + hstepB, voffB); PG8_STAGE(PG8_SA(0, 0), a2, voffA);
            PG8_WAIT_V(8); PG8_WAIT_L(0); PG8_BAR; PG8_MMA(1, 0, At, B0); PG8_MMA(1, 1, At, B1); PG8_BAR; PG8_SCHED;
            PG8_LDB(B0, 1, 0); PG8_LDB(B1, 1, 1); PG8_SCHED; PG8_LDA(At, 1, 0); PG8_STAGE(PG8_SA(0, 1), a2 + hstepA, voffA);
            PG8_WAIT_V(8); PG8_WAIT_L(0); PG8_BAR; PG8_MMA(0, 0, At, B0); PG8_MMA(0, 1, At, B1); PG8_BAR; PG8_SCHED;
            PG8_LDA(At, 1, 1); PG8_STAGE(PG8_SB(1, 0), b3, voffB); PG8_STAGE(PG8_SB(1, 1), b3 + hstepB, voffB); PG8_STAGE(PG8_SA(1, 0), a3, voffA);
            PG8_WAIT_V(8); PG8_WAIT_L(0); PG8_BAR; PG8_MMA(1, 0, At, B0); PG8_MMA(1, 1, At, B1); PG8_BAR; PG8_SCHED;
        }
        if (wr == 0) PG8_BAR;
        MFMA_PAD();
        { const int l2 = lane_id_fresh(); E(acc, cur, wr, wc, l2 & 15, l2 >> 4); }
        if (!has_next) break;
#pragma unroll
        for (int a = 0; a < 2; ++a)
#pragma unroll
            for (int b = 0; b < 2; ++b)
#pragma unroll
                for (int m = 0; m < 4; ++m)
#pragma unroll
                    for (int n = 0; n < 2; ++n) acc[a][b][m][n] = (f32x4){0.f, 0.f, 0.f, 0.f};
        cur = nxt; cA = nA; cB = nB; ++ui;
        if (wr == 1) PG8_BAR;
    }
    PG8_WAIT_V(0);
    PG8_BAR;
#undef PG8_SA
#undef PG8_SB
#undef PG8_STAGE
#undef PG8_LDA
#undef PG8_LDB
#undef PG8_MMA
#undef PG8_WAIT_V
#undef PG8_WAIT_L
#undef PG8_BAR
#undef PG8_SCHED
}
}

typedef f32x4 acc_t[2][2][4][2];
__device__ __forceinline__ u32x4 pack8(const f32x4 a, const f32x4 b) { u32x4 w; w.x = cvt_pk_bf16(a[0], a[1]); w.y = cvt_pk_bf16(a[2], a[3]); w.z = cvt_pk_bf16(b[0], b[1]); w.w = cvt_pk_bf16(b[2], b[3]); return w; }

struct EpiInProj { static constexpr bool PERM = true;
    bf16_t* ZQ; bf16_t* SU; bf16_t* GATES; float* PART;
    __device__ __forceinline__ void operator()(const acc_t& acc, const pg8::Unit& u, int wr, int wc, int fr, int fq) const {
        const int row0 = u.pm * 256 + wr * 64 + fr, pn = u.pn;
#pragma unroll
        for (int ai = 0; ai < 2; ++ai)
#pragma unroll
            for (int m = 0; m < 4; ++m) { const int row = row0 + ai * 128 + m * 16;
#pragma unroll
                for (int bj = 0; bj < 2; ++bj) { f32x4 v0 = acc[ai][bj][m][0], v1 = acc[ai][bj][m][1]; const int c0 = bj * 128 + wc * 32 + 8 * fq;
                    if (pn < 3) {
                        *(u32x4*)(ZQ + (size_t)row * 768 + pn * 256 + c0) = pack8(v0, v1);
                        float ss = (v0[0] * v0[0] + v0[1] * v0[1]) + (v0[2] * v0[2] + v0[3] * v0[3]) + (v1[0] * v1[0] + v1[1] * v1[1]) + (v1[2] * v1[2] + v1[3] * v1[3]);
                        ss += __shfl_xor(ss, 16); ss += __shfl_xor(ss, 32);
                        const int slot = pn * 2 + bj;
                        if (fq == 0 && slot < 5) PART[(size_t)row * 20 + slot * 4 + wc] = ss;
                    } else if (pn < 5) {
                        *(u32x4*)(SU + (size_t)row * 512 + (pn - 3) * 256 + c0) = pack8(v0, v1);
                    } else {
#pragma unroll
                        for (int e = 0; e < 4; ++e) { v0[e] = sigmoidf_(v0[e]); v1[e] = sigmoidf_(v1[e]); }
                        *(u32x4*)(GATES + (size_t)row * 2048 + (pn - 5) * 256 + c0) = pack8(v0, v1);
                    } } }
    }
};
struct EpiUQ { static constexpr bool PERM = true;
    bf16_t* Q; const float* PART;
    __device__ __forceinline__ void operator()(const acc_t& acc, const pg8::Unit& u, int wr, int wc, int fr, int fq) const {
        asm volatile("" : "+v"(fr), "+v"(fq));
        const int row0 = u.pm * 256 + wr * 64 + fr;
#pragma unroll
        for (int ai = 0; ai < 2; ++ai)
#pragma unroll
            for (int m = 0; m < 4; ++m) { asm volatile("" ::: "memory"); const int row = row0 + ai * 128 + m * 16; const int b = row >> 11, l = row & 2047;
                const f32x4* pp = (const f32x4*)(PART + (size_t)row * 20); const f32x4 p0 = pp[0], p1 = pp[1], p2 = pp[2];
                const float ssq = ((p0[0] + p0[1]) + (p0[2] + p0[3])) + ((p1[0] + p1[1]) + (p1[2] + p1[3])) + ((p2[0] + p2[1]) + (p2[2] + p2[3]));
                const float sc = rsqrtf(ssq * (1.f / 384.f) + LN_EPS) * QSCALE;
#pragma unroll
                for (int bj = 0; bj < 2; ++bj) { const f32x4 v0 = acc[ai][bj][m][0] * sc, v1 = acc[ai][bj][m][1] * sc;
                    const int g0 = u.pn * 256 + bj * 128 + wc * 32;
                    const int head = g0 / 192, w0 = g0 - head * 192;
                    *(u32x4*)(Q + ((size_t)(b * NH + head) * SEQ + l) * DK + w0 + 8 * fq) = pack8(v0, v1);
                } }
    }
};
struct EpiUKV { static constexpr bool PERM = true;
    bf16_t* KN; bf16_t* V; const float* PART;
    __device__ __forceinline__ void operator()(const acc_t& acc, const pg8::Unit& u, int wr, int wc, int fr, int fq) const {
        asm volatile("" : "+v"(fr), "+v"(fq));
        const int row0 = u.pm * 256 + wr * 64 + fr;
#pragma unroll
        for (int ai = 0; ai < 2; ++ai)
#pragma unroll
            for (int m = 0; m < 4; ++m) { asm volatile("" ::: "memory"); const int row = row0 + ai * 128 + m * 16;
                int b, key; if (row < MLAT) { b = row >> 11; key = CTXL + (row & 2047); } else { const int r2 = row - MLAT; b = r2 >> 8; key = r2 & 255; }
                const f32x4* pp = (const f32x4*)(PART + (size_t)row * 20 + 12); const f32x4 p0 = pp[0], p1 = pp[1];
                const float ssq = ((p0[0] + p0[1]) + (p0[2] + p0[3])) + ((p1[0] + p1[1]) + (p1[2] + p1[3]));
                const float sc = rsqrtf(ssq * (1.f / 256.f) + LN_EPS);
#pragma unroll
                for (int bj = 0; bj < 2; ++bj) { const f32x4 v0 = acc[ai][bj][m][0] * sc, v1 = acc[ai][bj][m][1] * sc;
                    const int head = u.pn; bf16_t* dst = (bj == 0) ? KN : V;
                    *(u32x4*)(dst + ((size_t)(b * NH + head) * NKEY + key) * 128 + wc * 32 + 8 * fq) = pack8(v0, v1);
                } }
    }
};
struct EpiGLU { static constexpr bool PERM = true;
    const bf16_t* ATT; const bf16_t* GATES; bf16_t* MERGED;
    __device__ __forceinline__ void operator()(const acc_t& acc, const pg8::Unit& u, int wr, int wc, int fr, int fq) const {
        asm volatile("" : "+v"(fr), "+v"(fq));
        const int row0 = u.pm * 256 + wr * 64 + fr; const int head = u.pn, d0 = wc * 32 + 8 * fq, j0 = head * 128 + d0;
#pragma unroll
        for (int ai = 0; ai < 2; ++ai)
#pragma unroll
            for (int m = 0; m < 4; ++m) { asm volatile("" ::: "memory"); const int row = row0 + ai * 128 + m * 16; const int b = row >> 11, l = row & 2047;
                const u32x4 at = *(const u32x4*)(ATT + ((size_t)(b * NH + head) * SEQ + (l & ~255)) * DK + (l & 255) * 128 + d0);
                const u32x4 gs = *(const u32x4*)(GATES + (size_t)row * 2048 + 1024 + j0);
                const f32x4 a0 = acc[ai][0][m][0], a1 = acc[ai][0][m][1], b0 = acc[ai][1][m][0], b1 = acc[ai][1][m][1];
                f32x4 o0, o1;
#if MK_STAGE >= 3
#define GLU1(o, a, bb, atw, gsw, e0) o[e0] = bf_lo(atw) + bf_lo(gsw) * a[e0] * sigmoidf_(bb[e0]); o[e0 + 1] = bf_hi(atw) + bf_hi(gsw) * a[e0 + 1] * sigmoidf_(bb[e0 + 1]);
#else
#define GLU1(o, a, bb, atw, gsw, e0) o[e0] = bf_lo(atw) + 0.f * bf_lo(gsw) * a[e0] * bb[e0]; o[e0 + 1] = bf_hi(atw) + 0.f * bf_hi(gsw) * a[e0 + 1] * bb[e0 + 1];
#endif
                GLU1(o0, a0, b0, at.x, gs.x, 0) GLU1(o0, a0, b0, at.y, gs.y, 2) GLU1(o1, a1, b1, at.z, gs.z, 0) GLU1(o1, a1, b1, at.w, gs.w, 2)
#undef GLU1
                *(u32x4*)(MERGED + (size_t)row * 1024 + j0) = pack8(o0, o1);
            }
    }
};
struct EpiOut { static constexpr bool PERM = true;
    const float* X; const float* MOD; float* T;
    __device__ __forceinline__ void operator()(const acc_t& acc, const pg8::Unit& u, int wr, int wc, int fr, int fq) const {
        asm volatile("" : "+v"(fr), "+v"(fq));
        const int row0 = u.pm * 256 + wr * 64 + fr;
#pragma unroll
        for (int ai = 0; ai < 2; ++ai)
#pragma unroll
            for (int m = 0; m < 4; ++m) { asm volatile("" ::: "memory"); const int row = row0 + ai * 128 + m * 16; const int b = row >> 11;
#pragma unroll
                for (int bj = 0; bj < 2; ++bj) { const int c0 = u.pn * 256 + bj * 128 + wc * 32 + 8 * fq;
                    const f32x4* xp = (const f32x4*)(X + (size_t)row * DM + c0); const f32x4* gp = (const f32x4*)(MOD + (size_t)b * 6144 + 2048 + c0);
                    f32x4* tp = (f32x4*)(T + (size_t)row * DM + c0);
#if MK_STAGE >= 1
                    tp[0] = xp[0] * ALPHA + gp[0] * acc[ai][bj][m][0]; tp[1] = xp[1] * ALPHA + gp[1] * acc[ai][bj][m][1];
#else
                    tp[0] = xp[0] * ALPHA + gp[0] * acc[ai][bj][m][0] * 0.f; tp[1] = xp[1] * ALPHA + gp[1] * acc[ai][bj][m][1] * 0.f;
#endif
                } }
    }
};
struct EpiPQ { static constexpr bool PERM = true;
    bf16_t* PQ;
    __device__ __forceinline__ void operator()(const acc_t& acc, const pg8::Unit& u, int wr, int wc, int fr, int fq) const {
        asm volatile("" : "+v"(fr), "+v"(fq));
        const int row0 = u.pm * 256 + wr * 64 + fr;
#pragma unroll
        for (int ai = 0; ai < 2; ++ai)
#pragma unroll
            for (int m = 0; m < 4; ++m) { const int row = row0 + ai * 128 + m * 16;
#pragma unroll
                for (int bj = 0; bj < 2; ++bj) *(u32x4*)(PQ + (size_t)row * 2048 + u.pn * 256 + bj * 128 + wc * 32 + 8 * fq) = pack8(acc[ai][bj][m][0], acc[ai][bj][m][1]); }
    }
};

#define XB_TMO      128
#define XB_XCNT(j)  (256  + 64 * (j))
#define XB_XSUB(j)  (1280 + 64 * (j))
#define XB_XGEN(j)  (2304 + 64 * (j))
#define XB_TOP      3328
#define XB_TOPGEN   3392
#define XCD_BAR_WORDS 3456
#define XB_SPIN_CAP (1u << 22)
__device__ __forceinline__ unsigned xb_ld(unsigned* p)              { return __hip_atomic_load(p, __ATOMIC_RELAXED, __HIP_MEMORY_SCOPE_AGENT); }
__device__ __forceinline__ unsigned xb_add(unsigned* p, unsigned v) { return __hip_atomic_fetch_add(p, v, __ATOMIC_RELAXED, __HIP_MEMORY_SCOPE_AGENT); }
__device__ __forceinline__ unsigned xb_xcc_id() { return (unsigned)__builtin_amdgcn_s_getreg((3 << 11) | 20) & 0xFu; }
#define XB_SPIN(cond, bar) do { unsigned _sp = 0; while (cond) { __builtin_amdgcn_s_sleep(1); \
    if ((++_sp & 255u) == 0u) { if (xb_ld(&(bar)[XB_TMO])) break; if (_sp > XB_SPIN_CAP) { atomicAdd(&(bar)[XB_TMO], 1u); break; } } } } while (0)
struct XcdBarrier { unsigned* bar; unsigned x; volatile LAS unsigned* st; };
__device__ __forceinline__ XcdBarrier xcd_barrier_post(unsigned* bar, volatile LAS unsigned* st, int tid) {
    XcdBarrier b; b.bar = bar; b.x = xb_xcc_id(); b.st = st;
    if (tid == 0) (void)xb_add(&bar[XB_XCNT(b.x)], 1u);
    return b;
}
__device__ __forceinline__ void xcd_barrier_complete(unsigned* bar, unsigned x, unsigned& nloc, unsigned& nx) {
    const unsigned G = gridDim.x * gridDim.y * gridDim.z;
    unsigned sum, cnt, mine, sp = 0u;
    for (;;) {
        sum = 0u; cnt = 0u; mine = 0u;
#pragma unroll
        for (unsigned j = 0; j < 16; ++j) { const unsigned c = xb_ld(&bar[XB_XCNT(j)]); sum += c; cnt += (c > 0u) ? 1u : 0u; mine = (j == x) ? c : mine; }
        if (sum == G) break;
        __builtin_amdgcn_s_sleep(1);
        if ((++sp & 255u) == 0u) { if (xb_ld(&bar[XB_TMO])) break; if (sp > XB_SPIN_CAP) { atomicAdd(&bar[XB_TMO], 1u); break; } }
    }
    nloc = mine > 0u ? mine : 1u; nx = cnt > 0u ? cnt : 1u;
}
__device__ __forceinline__ void xcd_barrier(const XcdBarrier& b, int tid) {
    asm volatile("s_waitcnt vmcnt(0)" ::: "memory");
    __syncthreads();
    if (tid == 0) {
        unsigned* bar = b.bar;
        __builtin_amdgcn_s_waitcnt(0);
        unsigned nloc = b.st[0], nx = b.st[1];
        if (nloc == 0u) { xcd_barrier_complete(bar, b.x, nloc, nx); b.st[0] = nloc; b.st[1] = nx; }
        const unsigned old = xb_add(&bar[XB_XSUB(b.x)], 1u);
        const unsigned gen = old / nloc;
        if (old + 1u == (gen + 1u) * nloc) {
            __builtin_amdgcn_fence(__ATOMIC_RELEASE, "agent");
            asm volatile("s_waitcnt vmcnt(0)" ::: "memory");
            const unsigned og = xb_add(&bar[XB_TOP], 1u);
            const unsigned tg = og / nx;
            if (og + 1u == (tg + 1u) * nx) xb_add(&bar[XB_TOPGEN], 1u);
            else XB_SPIN(xb_ld(&bar[XB_TOPGEN]) == tg, bar);
            __builtin_amdgcn_fence(__ATOMIC_ACQUIRE, "agent");
            xb_add(&bar[XB_XGEN(b.x)], 1u);
            asm volatile("s_waitcnt vmcnt(0)" ::: "memory");
        } else {
            XB_SPIN(xb_ld(&bar[XB_XGEN(b.x)]) == gen, bar);
            __builtin_amdgcn_fence(__ATOMIC_ACQUIRE, "agent");
            asm volatile("s_waitcnt vmcnt(0)" ::: "memory");
        }
    }
    __syncthreads();
}

__device__ __forceinline__ void transpose_item(const float* W, int ldw, int k0, int nsrc0, bf16_t* WT, int ldt, int ndst0, const float* gk, LAS float* scr, int lane) {
    if (nsrc0 >= 0) {
#pragma unroll 8
        for (int i = 0; i < 32; ++i) { const int kk = 2 * i + (lane >> 5); float v = W[(size_t)(k0 + kk) * ldw + nsrc0 + (lane & 31)]; if (gk) v *= gk[k0 + kk]; scr[kk * 33 + (lane & 31)] = v; }
    } else {
#pragma unroll 8
        for (int i = 0; i < 32; ++i) { const int kk = 2 * i + (lane >> 5); scr[kk * 33 + (lane & 31)] = 0.f; }
    }
    LDS_WAIT(); asm volatile("" ::: "memory");
    const int c = lane & 7;
#pragma unroll
    for (int j = 0; j < 4; ++j) { const int n = (lane >> 3) + 8 * j; const LAS float* s = scr + (8 * c) * 33 + n;
        u32x4 o; o.x = cvt_pk_bf16(s[0 * 33], s[1 * 33]); o.y = cvt_pk_bf16(s[2 * 33], s[3 * 33]); o.z = cvt_pk_bf16(s[4 * 33], s[5 * 33]); o.w = cvt_pk_bf16(s[6 * 33], s[7 * 33]);
        *(u32x4*)(WT + (size_t)(ndst0 + n) * ldt + k0 + 8 * c) = o; }
    LDS_WAIT(); asm volatile("" ::: "memory");
}
__device__ __forceinline__ void modulate_row(const float* xrow, const float* sh, const float* sc, bf16_t* orow, int lane) {
    const f32x4* xr = (const f32x4*)xrow + lane; f32x4 v[4]; float s = 0.f;
#pragma unroll
    for (int j = 0; j < 4; ++j) { v[j] = xr[64 * j]; s += (v[j][0] + v[j][1]) + (v[j][2] + v[j][3]); }
    const float mean = wave_sum(s) * (1.f / DM); float s2 = 0.f;
#pragma unroll
    for (int j = 0; j < 4; ++j) { v[j] = v[j] - mean; s2 += (v[j][0] * v[j][0] + v[j][1] * v[j][1]) + (v[j][2] * v[j][2] + v[j][3] * v[j][3]); }
    const float rstd = rsqrtf(wave_sum(s2) * (1.f / DM) + LN_EPS);
    u32x2* o8 = (u32x2*)orow + lane;
#pragma unroll
    for (int j = 0; j < 4; ++j) { const f32x4 a = ((const f32x4*)sc)[64 * j + lane], b = ((const f32x4*)sh)[64 * j + lane]; const f32x4 y = v[j] * rstd * (a + 1.f) + b;
        u32x2 w; w.x = cvt_pk_bf16(y[0], y[1]); w.y = cvt_pk_bf16(y[2], y[3]); o8[64 * j] = w; }
}
__device__ __forceinline__ void ln1_row(float* trow, const float* g1, const float* b1, const float* sh, const float* sc, bf16_t* orow, int lane) {
    f32x4* xr = (f32x4*)trow + lane; f32x4 v[4]; float s = 0.f;
#pragma unroll
    for (int j = 0; j < 4; ++j) { v[j] = xr[64 * j]; s += (v[j][0] + v[j][1]) + (v[j][2] + v[j][3]); }
    float mean = wave_sum(s) * (1.f / DM); float s2 = 0.f;
#pragma unroll
    for (int j = 0; j < 4; ++j) { v[j] = v[j] - mean; s2 += (v[j][0] * v[j][0] + v[j][1] * v[j][1]) + (v[j][2] * v[j][2] + v[j][3] * v[j][3]); }
    float rstd = rsqrtf(wave_sum(s2) * (1.f / DM) + LN_EPS);
    s = 0.f;
#pragma unroll
    for (int j = 0; j < 4; ++j) { v[j] = v[j] * rstd * ((const f32x4*)g1)[64 * j + lane] + ((const f32x4*)b1)[64 * j + lane]; xr[64 * j] = v[j]; s += (v[j][0] + v[j][1]) + (v[j][2] + v[j][3]); }
    mean = wave_sum(s) * (1.f / DM); s2 = 0.f;
#pragma unroll
    for (int j = 0; j < 4; ++j) { v[j] = v[j] - mean; s2 += (v[j][0] * v[j][0] + v[j][1] * v[j][1]) + (v[j][2] * v[j][2] + v[j][3] * v[j][3]); }
    rstd = rsqrtf(wave_sum(s2) * (1.f / DM) + LN_EPS);
    u32x2* o8 = (u32x2*)orow + lane;
#pragma unroll
    for (int j = 0; j < 4; ++j) { const f32x4 a = ((const f32x4*)sc)[64 * j + lane], b = ((const f32x4*)sh)[64 * j + lane]; const f32x4 y = v[j] * rstd * (a + 1.f) + b;
        u32x2 w; w.x = cvt_pk_bf16(y[0], y[1]); w.y = cvt_pk_bf16(y[2], y[3]); o8[64 * j] = w; }
}

__device__ __forceinline__ int s5_row(int d, int b, int s) {
    if (d == 0) return (s < CTXL) ? (MLAT + b * CTXL + s) : (b * SEQ + (s - CTXL));
    return (s < CTXL) ? (MLAT + b * CTXL + (CTXL - 1 - s)) : (b * SEQ + (SEQ - 1 - (s - CTXL)));
}
typedef const LAS unsigned char* lds_cptr;
__device__ __forceinline__ s16x4 vtr(lds_cptr p) { return __builtin_bit_cast(s16x4, __builtin_amdgcn_ds_read_tr16_b64_v4i16((LAS v4i16_t*)p)); }
__device__ __forceinline__ void s5_passA(const bf16_t* __restrict__ SU, const float* __restrict__ ABAR, const bf16_t* __restrict__ BB, float* __restrict__ E, int unit, int lane) {
    asm volatile("" : "+v"(lane));
    const int j = unit % 7, bp = (unit / 7) & 7, g = (unit / 56) & 31, d = unit / 1792;
    const int r = lane & 31, hA = lane >> 5;
    const int bA = 2 * bp + ((r >> 2) & 1), ti = (r & 3) + 4 * (r >> 3);
    const int s_begin = (j == 0) ? 0 : CTXL + 256 * j, s_end = CTXL + 256 * (j + 1);
    const bf16_t* bbp = BB + (size_t)((d * 32 + g) * 2) * 64 * 16;
    const bf16x8 bre0 = *(const bf16x8*)(bbp + (r * 16 + 8 * hA)), bre1 = *(const bf16x8*)(bbp + ((32 + r) * 16 + 8 * hA));
    const bf16x8 bim0 = *(const bf16x8*)(bbp + ((64 + r) * 16 + 8 * hA)), bim1 = *(const bf16x8*)(bbp + ((96 + r) * 16 + 8 * hA));
    const float* ab = ABAR + (size_t)(d * 32 + g) * 128;
    const float ar0 = ab[2 * r], ai0 = ab[2 * r + 1], ar1 = ab[2 * (32 + r)], ai1 = ab[2 * (32 + r) + 1];
    float hr0 = 0.f, hi0 = 0.f, hr1 = 0.f, hi1 = 0.f;
    bf16x8 ua = *(const bf16x8*)(SU + (size_t)s5_row(d, bA, s_begin + ti) * 512 + g * 16 + 8 * hA);
    for (int s0 = s_begin; s0 < s_end; s0 += 16) {
        const int sn = (s0 + 16 < s_end) ? s0 + 16 : s0;
        const bf16x8 un = *(const bf16x8*)(SU + (size_t)s5_row(d, bA, sn + ti) * 512 + g * 16 + 8 * hA);
        const f32x16 z = {};
        __builtin_amdgcn_sched_barrier(0);
        const f32x16 ur0 = MFMA32(ua, bre0, z), ur1 = MFMA32(ua, bre1, z), ui0 = MFMA32(ua, bim0, z), ui1 = MFMA32(ua, bim1, z);
        MFMA_PAD();
#pragma unroll
        for (int i = 0; i < 16; ++i) {
            const float nr0 = fmaf(ar0, hr0, fmaf(-ai0, hi0, ur0[i])), ni0 = fmaf(ar0, hi0, fmaf(ai0, hr0, ui0[i])); hr0 = nr0; hi0 = ni0;
            const float nr1 = fmaf(ar1, hr1, fmaf(-ai1, hi1, ur1[i])), ni1 = fmaf(ar1, hi1, fmaf(ai1, hr1, ui1[i])); hr1 = nr1; hi1 = ni1;
        }
        ua = un;
    }
    const int b = 2 * bp + (lane >> 5);
    float* e = E + (size_t)(((d * 32 + g) * 16 + b) * 7 + j) * 128;
    e[r] = hr0; e[32 + r] = hr1; e[64 + r] = hi0; e[96 + r] = hi1;
}
constexpr int S5_HT_PITCH = 80;
constexpr int S5_LDS_WAVE = 128 * S5_HT_PITCH;
__device__ __forceinline__ void s5_passB(const bf16_t* __restrict__ SU, const float* __restrict__ ABAR, const float* __restrict__ POW, const bf16_t* __restrict__ BB, const bf16_t* __restrict__ CM,
                                         const float* __restrict__ E, const float* __restrict__ DSK, bf16_t* Y, int unit, int lane, LAS unsigned char* ht) {
    asm volatile("" : "+v"(lane));
    const int k = unit & 7, bp = (unit >> 3) & 7, g = unit >> 6;
    const int r = lane & 31, hA = lane >> 5;
    const int bA = 2 * bp + ((r >> 2) & 1), ti = (r & 3) + 4 * (r >> 3);
    const int bS = 2 * bp + hA;
    const int G4 = lane >> 4, q4 = (lane & 15) >> 2, p4 = lane & 3;
    const lds_cptr trb = (lds_cptr)ht + (8 * hA + q4) * S5_HT_PITCH + (16 * (G4 & 1) + 4 * p4) * 2;
    const int bO = 2 * bp + (r >> 4), tO = r & 15;
#pragma unroll 1
    for (int d = 0; d < 2; ++d) {
        const int j = d == 0 ? k : 7 - k;
        const int s_begin = (j == 0) ? 0 : CTXL + 256 * j, s_end = CTXL + 256 * (j + 1);
        const bf16_t* bbp = BB + (size_t)((d * 32 + g) * 2) * 64 * 16;
        const bf16x8 bre0 = *(const bf16x8*)(bbp + (r * 16 + 8 * hA)), bre1 = *(const bf16x8*)(bbp + ((32 + r) * 16 + 8 * hA));
        const bf16x8 bim0 = *(const bf16x8*)(bbp + ((64 + r) * 16 + 8 * hA)), bim1 = *(const bf16x8*)(bbp + ((96 + r) * 16 + 8 * hA));
        const float* ab = ABAR + (size_t)(d * 32 + g) * 128;
        const float ar0 = ab[2 * r], ai0 = ab[2 * r + 1], ar1 = ab[2 * (32 + r)], ai1 = ab[2 * (32 + r) + 1];
        bf16x8 cm[8];
#pragma unroll
        for (int ks = 0; ks < 8; ++ks) { cm[ks] = (bf16x8){0, 0, 0, 0, 0, 0, 0, 0}; if (r < 16) cm[ks] = *(const bf16x8*)(CM + ((size_t)((d * 32 + g) * 16 + r) * 128 + 16 * ks + 8 * hA)); }
        float hr0 = 0.f, hi0 = 0.f, hr1 = 0.f, hi1 = 0.f;
        { const float* e = E + (size_t)(((d * 32 + g) * 16 + bS) * 7) * 128;
          for (int jj = 0; jj < j; ++jj) { const float* pw = POW + ((size_t)((jj == 0 ? 1 : 0) * 64 + d * 32 + g) * 64) * 2;
              const float pr0 = pw[2 * r], pi0 = pw[2 * r + 1], pr1 = pw[2 * (32 + r)], pi1 = pw[2 * (32 + r) + 1];
              const float er0 = e[jj * 128 + r], er1 = e[jj * 128 + 32 + r], ei0 = e[jj * 128 + 64 + r], ei1 = e[jj * 128 + 96 + r];
              const float nr0 = pr0 * hr0 - pi0 * hi0 + er0, ni0 = pr0 * hi0 + pi0 * hr0 + ei0; hr0 = nr0; hi0 = ni0;
              const float nr1 = pr1 * hr1 - pi1 * hi1 + er1, ni1 = pr1 * hi1 + pi1 * hr1 + ei1; hr1 = nr1; hi1 = ni1; } }
        bf16x8 ua = *(const bf16x8*)(SU + (size_t)s5_row(d, bA, s_begin + ti) * 512 + g * 16 + 8 * hA);
        for (int s0 = s_begin; s0 < s_end; s0 += 16) {
            const int sn = (s0 + 16 < s_end) ? s0 + 16 : s0;
            const bf16x8 un = *(const bf16x8*)(SU + (size_t)s5_row(d, bA, sn + ti) * 512 + g * 16 + 8 * hA);
            const f32x16 z = {};
            __builtin_amdgcn_sched_barrier(0);
            f32x16 ur0 = MFMA32(ua, bre0, z), ur1 = MFMA32(ua, bre1, z), ui0 = MFMA32(ua, bim0, z), ui1 = MFMA32(ua, bim1, z);
            MFMA_PAD();
#pragma unroll
            for (int i = 0; i < 16; ++i) {
                const float nr0 = fmaf(ar0, hr0, fmaf(-ai0, hi0, ur0[i])), ni0 = fmaf(ar0, hi0, fmaf(ai0, hr0, ui0[i])); hr0 = nr0; hi0 = ni0; ur0[i] = nr0; ui0[i] = ni0;
                const float nr1 = fmaf(ar1, hr1, fmaf(-ai1, hi1, ur1[i])), ni1 = fmaf(ar1, hi1, fmaf(ai1, hr1, ui1[i])); hr1 = nr1; hi1 = ni1; ur1[i] = nr1; ui1[i] = ni1;
            }
            if (s0 >= CTXL) {
#define S5_WR(V, R) do { LAS unsigned char* wp = ht + (R) * S5_HT_PITCH + hA * 32; \
                    u32x4 w0, w1; w0.x = cvt_pk_bf16(V[0], V[1]); w0.y = cvt_pk_bf16(V[2], V[3]); w0.z = cvt_pk_bf16(V[4], V[5]); w0.w = cvt_pk_bf16(V[6], V[7]); \
                    w1.x = cvt_pk_bf16(V[8], V[9]); w1.y = cvt_pk_bf16(V[10], V[11]); w1.z = cvt_pk_bf16(V[12], V[13]); w1.w = cvt_pk_bf16(V[14], V[15]); \
                    *(LAS u32x4*)wp = w0; *(LAS u32x4*)(wp + 16) = w1; } while (0)
                S5_WR(ur0, r); S5_WR(ur1, 32 + r); S5_WR(ui0, 64 + r); S5_WR(ui1, 96 + r);
#undef S5_WR
                LDS_WAIT();
                f32x16 ya = {};
#pragma unroll
                for (int ks = 0; ks < 8; ++ks) {
                    const s16x4 lo = vtr(trb + (16 * ks) * S5_HT_PITCH), hi = vtr(trb + (16 * ks + 4) * S5_HT_PITCH);
                    const bf16x8 bfrag = (bf16x8){lo[0], lo[1], lo[2], lo[3], hi[0], hi[1], hi[2], hi[3]};
                    ya = MFMA32(cm[ks], bfrag, ya);
                }
                MFMA_PAD();
                const int row = s5_row(d, bO, s0 + tO);
                bf16_t* yp = Y + (size_t)row * 512 + g * 16 + 4 * hA;
                if (d == 0) {
                    const bf16_t* up = SU + (size_t)row * 512 + g * 16 + 4 * hA;
                    const u32x2 u0 = *(const u32x2*)up, u1 = *(const u32x2*)(up + 8);
                    const f32x4 d0 = *(const f32x4*)(DSK + g * 16 + 4 * hA), d1 = *(const f32x4*)(DSK + g * 16 + 8 + 4 * hA);
                    u32x2 o0, o1;
                    o0.x = cvt_pk_bf16(ya[0] + d0[0] * bf_lo(u0.x), ya[1] + d0[1] * bf_hi(u0.x)); o0.y = cvt_pk_bf16(ya[2] + d0[2] * bf_lo(u0.y), ya[3] + d0[3] * bf_hi(u0.y));
                    o1.x = cvt_pk_bf16(ya[4] + d1[0] * bf_lo(u1.x), ya[5] + d1[1] * bf_hi(u1.x)); o1.y = cvt_pk_bf16(ya[6] + d1[2] * bf_lo(u1.y), ya[7] + d1[3] * bf_hi(u1.y));
                    *(u32x2*)yp = o0; *(u32x2*)(yp + 8) = o1;
                } else {
                    const u32x2 f0 = *(const u32x2*)yp, f1 = *(const u32x2*)(yp + 8);
                    u32x2 o0, o1;
                    o0.x = cvt_pk_bf16(gelu_tanh(ya[0] + bf_lo(f0.x)), gelu_tanh(ya[1] + bf_hi(f0.x))); o0.y = cvt_pk_bf16(gelu_tanh(ya[2] + bf_lo(f0.y)), gelu_tanh(ya[3] + bf_hi(f0.y)));
                    o1.x = cvt_pk_bf16(gelu_tanh(ya[4] + bf_lo(f1.x)), gelu_tanh(ya[5] + bf_hi(f1.x))); o1.y = cvt_pk_bf16(gelu_tanh(ya[6] + bf_lo(f1.y)), gelu_tanh(ya[7] + bf_hi(f1.y)));
                    *(u32x2*)yp = o0; *(u32x2*)(yp + 8) = o1;
                }
                LDS_WAIT();
            }
            ua = un;
        }
        VM_WAIT();
    }
}

namespace att {
constexpr int NW = 8, QBLK = 32, KVBLK = 64;
constexpr int SHM_V = KVBLK * 128 * 2, SHM_K = KVBLK * DK * 2;
constexpr int OFF_V = 0, OFF_K = 2 * SHM_V, OFF_WS = OFF_K + 2 * SHM_K, OFF_QPE = OFF_WS + NW * 64 * 4, LDS_BYTES = OFF_QPE + NW * 4096;
constexpr float THRL = 8.f * 1.4426950408889634f;
#define KSWZ(row, colB) ((row) * 384 + ((colB) ^ (((row) & 7) << 4)))
#define SBAR() __builtin_amdgcn_sched_barrier(0)
__device__ __forceinline__ int crow(int r, int hi) { return (r & 3) + 8 * (r >> 2) + 4 * hi; }
__device__ __forceinline__ void partialSM(f32x16& p0, f32x16& p1, float& m_reg, float& mn, float& alpha) {
    float pmax = p0[0];
#pragma unroll
    for (int r = 1; r < 16; ++r) pmax = fmaxf(pmax, p0[r]);
#pragma unroll
    for (int r = 0; r < 16; ++r) pmax = fmaxf(pmax, p1[r]);
    { auto rr = __builtin_amdgcn_permlane32_swap(__float_as_uint(pmax), __float_as_uint(pmax), false, false);
      pmax = fmaxf(__uint_as_float(rr[0]), __uint_as_float(rr[1])); }
    if (__builtin_expect(__all(pmax - m_reg <= THRL), 1)) { mn = m_reg; alpha = 1.f; }
    else { mn = fmaxf(m_reg, pmax); alpha = __builtin_amdgcn_exp2f(m_reg - mn); m_reg = mn; }
#pragma unroll
    for (int r = 0; r < 16; ++r) p0[r] = p0[r] - mn;
#pragma unroll
    for (int r = 0; r < 16; ++r) p1[r] = p1[r] - mn;
#pragma unroll
    for (int r = 0; r < 16; ++r) p0[r] = __builtin_amdgcn_exp2f(p0[r]);
}
__device__ __forceinline__ void finishSM(f32x16& p0, f32x16& p1, float alpha, float& l_reg, bf16x8& pa0, bf16x8& pa1, bf16x8& pa2, bf16x8& pa3) {
#pragma unroll
    for (int r = 0; r < 16; ++r) p1[r] = __builtin_amdgcn_exp2f(p1[r]);
    float ps = 0;
#pragma unroll
    for (int r = 0; r < 16; ++r) ps += p0[r];
#pragma unroll
    for (int r = 0; r < 16; ++r) ps += p1[r];
    { auto rr = __builtin_amdgcn_permlane32_swap(__float_as_uint(ps), __float_as_uint(ps), false, false);
      ps = __uint_as_float(rr[0]) + __uint_as_float(rr[1]); }
    l_reg = l_reg * alpha + ps;
#define PK4(P, BASE, OUT) do { unsigned a0 = cvt_pk_bf16(P[BASE + 0], P[BASE + 1]), a1 = cvt_pk_bf16(P[BASE + 2], P[BASE + 3]);   \
    unsigned b0 = cvt_pk_bf16(P[BASE + 4], P[BASE + 5]), b1 = cvt_pk_bf16(P[BASE + 6], P[BASE + 7]);                              \
    auto r0 = __builtin_amdgcn_permlane32_swap(a0, b0, false, false); auto r1 = __builtin_amdgcn_permlane32_swap(a1, b1, false, false); \
    u32x4 w = {r0[0], r1[0], r0[1], r1[1]}; OUT = *reinterpret_cast<bf16x8*>(&w); } while (0)
    PK4(p0, 0, pa0); PK4(p0, 8, pa1); PK4(p1, 0, pa2); PK4(p1, 8, pa3);
#undef PK4
}
__device__ __forceinline__ void qkt(f32x16& p0, f32x16& p1, const char* Ks, const bf16x8* qr, const char* qpe, int r32, int hi) {
    p0 = f32x16{}; p1 = f32x16{};
#pragma unroll
    for (int d0 = 0; d0 < 12; ++d0) { const int cb = (d0 * 16 + hi * 8) * 2;
        const bf16x8 b0 = *reinterpret_cast<const bf16x8*>(Ks + KSWZ(r32, cb));
        const bf16x8 b1 = *reinterpret_cast<const bf16x8*>(Ks + KSWZ(32 + r32, cb));
        const bf16x8 q = d0 < 8 ? qr[d0 < 8 ? d0 : 0] : *reinterpret_cast<const bf16x8*>(qpe + (d0 - 8) * 1024);
        p0 = MFMA32(b0, q, p0);
        p1 = MFMA32(b1, q, p1); }
}
__device__ __forceinline__ int v_st(int k, int c) { const int kk = (k & ~0xC) | ((k & 4) << 1) | ((k & 8) >> 1); return ((kk >> 3) * 4 + (c >> 5)) * 512 + ((kk & 7) * 32 + (c & 31)) * 2; }
__device__ __forceinline__ int v_rd_base(int lane) { return ((lane & 3) << 3) | (((lane >> 2) & 3) << 6) | (((lane >> 4) & 1) << 5) | (((lane >> 5) & 1) << 8); }
constexpr int v_rd_off(int d0, int ks, int half) { return d0 * 512 + ks * 4096 + half * 2048; }
template <int OFF> __device__ __forceinline__ s16x4 tr_read(int vb) {
    s16x4 r; asm volatile("ds_read_b64_tr_b16 %0, %1 offset:%2" : "=&v"(r) : "v"(vb), "i"(OFF) : "memory"); return r;
}
template <int D0> __device__ __forceinline__ void pv_one(f32x16& od, int vb, bf16x8 pa0, bf16x8 pa1, bf16x8 pa2, bf16x8 pa3) {
    const s16x4 l0 = tr_read<v_rd_off(D0, 0, 0)>(vb), h0 = tr_read<v_rd_off(D0, 0, 1)>(vb), l1 = tr_read<v_rd_off(D0, 1, 0)>(vb), h1 = tr_read<v_rd_off(D0, 1, 1)>(vb);
    const s16x4 l2 = tr_read<v_rd_off(D0, 2, 0)>(vb), h2 = tr_read<v_rd_off(D0, 2, 1)>(vb), l3 = tr_read<v_rd_off(D0, 3, 0)>(vb), h3 = tr_read<v_rd_off(D0, 3, 1)>(vb);
    asm volatile("s_waitcnt lgkmcnt(0)" ::: "memory"); SBAR();
#define PK(L, H) (bf16x8){L[0], L[1], L[2], L[3], H[0], H[1], H[2], H[3]}
    od = MFMA32(pa0, PK(l0, h0), od);
    od = MFMA32(pa1, PK(l1, h1), od);
    od = MFMA32(pa2, PK(l2, h2), od);
    od = MFMA32(pa3, PK(l3, h3), od);
#undef PK
}
__device__ __forceinline__ void pv_d0(f32x16* o, int vb, bf16x8 pa0, bf16x8 pa1, bf16x8 pa2, bf16x8 pa3) {
    pv_one<0>(o[0], vb, pa0, pa1, pa2, pa3); pv_one<1>(o[1], vb, pa0, pa1, pa2, pa3); pv_one<2>(o[2], vb, pa0, pa1, pa2, pa3); pv_one<3>(o[3], vb, pa0, pa1, pa2, pa3);
}
__device__ __forceinline__ void attn_unit(bf16_t* Qu, const bf16_t* __restrict__ Kh, const bf16_t* __restrict__ Pb, const bf16_t* __restrict__ Vh, const bf16_t* __restrict__ Gm, const float* __restrict__ ROPEt, int l0, char* lds, int tid_) {
    asm volatile("" : "+v"(tid_));
    const int tid = tid_, wid = __builtin_amdgcn_readfirstlane(tid >> 6), lane = tid & 63, r32 = lane & 31, hi = lane >> 5;
    char* V_lds = lds + OFF_V; char* K_lds = lds + OFF_K;
    float* ws = (float*)(lds + OFF_WS) + wid * 64; float* li_l = ws; float* al_l = ws + 32;
    float m_reg = -1e30f, l_reg = 0; f32x16 o[4] = {}; bf16x8 qr[8]; char* qpe = lds + OFF_QPE + wid * 4096 + lane * 16;
    const bf16_t* Qw = Qu + (size_t)(wid * QBLK + r32) * DK + hi * 8;
#pragma unroll
    for (int d0 = 0; d0 < 8; ++d0) qr[d0] = *reinterpret_cast<const bf16x8*>(Qw + d0 * 16);
    { const int l = l0 + wid * QBLK + r32;
#pragma unroll
      for (int part = 0; part < 2; ++part) { const int pos = part == 0 ? (l >> 6) : (l & 63);
          const u32x4 x1 = *reinterpret_cast<const u32x4*>(Qw + (8 + 2 * part) * 16), x2 = *reinterpret_cast<const u32x4*>(Qw + (9 + 2 * part) * 16);
          const f32x4* tp = (const f32x4*)(ROPEt + (size_t)pos * 32 + hi * 16); const f32x4 t0 = tp[0], t1 = tp[1], t2 = tp[2], t3 = tp[3];
          u32x4 o1, o2;
#define ROT2(X1, X2, T, O1, O2) { const float a0 = bf_lo(X1), a1 = bf_hi(X1), b0 = bf_lo(X2), b1 = bf_hi(X2); \
          O1 = cvt_pk_bf16(a0 * T[0] - b0 * T[1], a1 * T[2] - b1 * T[3]); O2 = cvt_pk_bf16(b0 * T[0] + a0 * T[1], b1 * T[2] + a1 * T[3]); }
          ROT2(x1.x, x2.x, t0, o1.x, o2.x) ROT2(x1.y, x2.y, t1, o1.y, o2.y) ROT2(x1.z, x2.z, t2, o1.z, o2.z) ROT2(x1.w, x2.w, t3, o1.w, o2.w)
#undef ROT2
          *reinterpret_cast<u32x4*>(qpe + (2 * part) * 1024) = o1; *reinterpret_cast<u32x4*>(qpe + (2 * part + 1) * 1024) = o2; } }
    const int sr = tid >> 4, sc = (tid & 15) * 8, vst0 = v_st(sr, sc), vst1 = v_st(32 + sr, sc);
    const int pr = tid >> 3, pc = (tid & 7) * 8;
    const int vb0 = (int)(uintptr_t)V_lds + v_rd_base(lane);
    bf16x8 vs0, vs1, ks0, ks1, ps0;
    const unsigned go0 = (unsigned)(sr * 128 + sc) * 2u, go1 = go0 + 8192u, go2 = (unsigned)(pr * 64 + pc) * 2u;
#define SLOAD(k0) do { const char* vt_ = (const char*)Vh + (size_t)(k0) * 256; const char* kt_ = (const char*)Kh + (size_t)(k0) * 256; const char* pt_ = (const char*)Pb + (size_t)(k0) * 128; \
    vs0 = *(const bf16x8*)(vt_ + go0); vs1 = *(const bf16x8*)(vt_ + go1); ks0 = *(const bf16x8*)(kt_ + go0); ks1 = *(const bf16x8*)(kt_ + go1); \
    ps0 = *(const bf16x8*)(pt_ + go2); } while (0)
#define SWRITE(b) do { *(bf16x8*)(V_lds + (b) * SHM_V + vst0) = vs0; *(bf16x8*)(V_lds + (b) * SHM_V + vst1) = vs1; const int kc = sc * 2;  \
    *(bf16x8*)(K_lds + (b) * SHM_K + KSWZ(sr, kc)) = ks0; *(bf16x8*)(K_lds + (b) * SHM_K + KSWZ(32 + sr, kc)) = ks1;                       \
    *(bf16x8*)(K_lds + (b) * SHM_K + KSWZ(pr, 256 + pc * 2)) = ps0; } while (0)
#define SWAIT() asm volatile("s_waitcnt vmcnt(0)" ::: "memory")
#define RESC(a) do { if (__any((a) < 1.f)) { if (hi == 0) al_l[r32] = (a); asm volatile("s_waitcnt lgkmcnt(0)" ::: "memory"); \
    _Pragma("unroll") for (int d = 0; d < 4; ++d) _Pragma("unroll") for (int r = 0; r < 16; ++r) o[d][r] *= al_l[crow(r, hi)]; } } while (0)
    f32x16 pA0, pA1, pB0, pB1; float mnA, mnB, alA, alB; bf16x8 pa0, pa1, pa2, pa3; constexpr int NT = NKEY / KVBLK;
    SLOAD(0); SWAIT(); SWRITE(0); __syncthreads();
    qkt(pA0, pA1, K_lds, qr, qpe, r32, hi); partialSM(pA0, pA1, m_reg, mnA, alA);
    SLOAD(KVBLK);
    SWAIT(); SWRITE(1); __syncthreads();
    for (int j = 1; j + 1 < NT; j += 2) {
        SBAR(); qkt(pB0, pB1, K_lds + SHM_K, qr, qpe, r32, hi);
        finishSM(pA0, pA1, alA, l_reg, pa0, pa1, pa2, pa3); SBAR();
        SLOAD((j + 1) * KVBLK); SBAR();
        pv_d0(o, vb0, pa0, pa1, pa2, pa3); partialSM(pB0, pB1, m_reg, mnB, alB);
        __syncthreads(); SWAIT(); SWRITE(0);
        RESC(alB); __syncthreads();
        SBAR(); qkt(pA0, pA1, K_lds, qr, qpe, r32, hi);
        finishSM(pB0, pB1, alB, l_reg, pa0, pa1, pa2, pa3); SBAR();
        SLOAD((j + 2) * KVBLK); SBAR();
        pv_d0(o, vb0 + SHM_V, pa0, pa1, pa2, pa3); partialSM(pA0, pA1, m_reg, mnA, alA);
        __syncthreads(); SWAIT(); SWRITE(1);
        RESC(alA); __syncthreads();
    }
    SBAR(); qkt(pB0, pB1, K_lds + SHM_K, qr, qpe, r32, hi);
    finishSM(pA0, pA1, alA, l_reg, pa0, pa1, pa2, pa3); SBAR();
    pv_d0(o, vb0, pa0, pa1, pa2, pa3); partialSM(pB0, pB1, m_reg, mnB, alB);
    __syncthreads(); RESC(alB);
    finishSM(pB0, pB1, alB, l_reg, pa0, pa1, pa2, pa3); SBAR();
    pv_d0(o, vb0 + SHM_V, pa0, pa1, pa2, pa3);
    if (hi == 0) li_l[r32] = l_reg; asm volatile("s_waitcnt lgkmcnt(0)" ::: "memory");
    __syncthreads();
    { char* ot = lds + wid * (32 * 272);
#pragma unroll
      for (int r = 0; r < 16; ++r) { const int orow = crow(r, hi); const float rl = __builtin_amdgcn_rcpf(li_l[orow]);
#pragma unroll
          for (int d0 = 0; d0 < 4; ++d0) *(bf16_t*)(ot + orow * 272 + (d0 * 32 + r32) * 2) = (bf16_t)(cvt_pk_bf16(o[d0][r] * rl, 0.f) & 0xffffu); }
      asm volatile("s_waitcnt lgkmcnt(0)" ::: "memory");
      bf16_t* Ow = Qu + (size_t)(wid * QBLK) * 128; const bf16_t* Gw = Gm + (size_t)(wid * QBLK) * 2048;
#pragma unroll
      for (int it = 0; it < 8; ++it) { const int idx = it * 64 + lane, row = idx >> 4, ch = idx & 15;
          const u32x4 ov = *(const u32x4*)(ot + row * 272 + ch * 16); const u32x4 gv = *(const u32x4*)(Gw + (size_t)row * 2048 + ch * 8);
          u32x4 w; w.x = cvt_pk_bf16(bf_lo(ov.x) * bf_lo(gv.x), bf_hi(ov.x) * bf_hi(gv.x)); w.y = cvt_pk_bf16(bf_lo(ov.y) * bf_lo(gv.y), bf_hi(ov.y) * bf_hi(gv.y));
          w.z = cvt_pk_bf16(bf_lo(ov.z) * bf_lo(gv.z), bf_hi(ov.z) * bf_hi(gv.z)); w.w = cvt_pk_bf16(bf_lo(ov.w) * bf_lo(gv.w), bf_hi(ov.w) * bf_hi(gv.w));
          *(u32x4*)(Ow + (size_t)row * 128 + ch * 8) = w; } }
    __syncthreads();
#undef SLOAD
#undef SWRITE
#undef SWAIT
#undef RESC
}
#undef KSWZ
#undef SBAR
}


namespace peer {
__device__ __forceinline__ int f2key(float f) { const int b = __builtin_bit_cast(int, f); return b ^ ((b >> 31) & 0x7fffffff); }
__device__ __forceinline__ float key2f(int k) { return __builtin_bit_cast(float, k ^ ((k >> 31) & 0x7fffffff)); }
__device__ __forceinline__ void ce_desc(int& a, int& b) { const int hi = a > b ? a : b, lo = a > b ? b : a; a = hi; b = lo; }
__device__ __forceinline__ void sort16_desc(int (&v)[16]) {
#pragma unroll
    for (int k = 2; k <= 16; k <<= 1)
#pragma unroll
        for (int j = k >> 1; j > 0; j >>= 1)
#pragma unroll
            for (int i = 0; i < 16; ++i) { const int l = i ^ j; if (l > i) { if ((i & k) == 0) ce_desc(v[i], v[l]); else ce_desc(v[l], v[i]); } }
}
__device__ __forceinline__ void merge_top16(int (&a)[16], const int (&b)[16]) {
#pragma unroll
    for (int i = 0; i < 16; ++i) a[i] = a[i] > b[15 - i] ? a[i] : b[15 - i];
#pragma unroll
    for (int j = 8; j > 0; j >>= 1)
#pragma unroll
        for (int i = 0; i < 16; ++i) { const int l = i ^ j; if (l > i) ce_desc(a[i], a[l]); }
}
__device__ __forceinline__ int lut16(const int (&P)[4], int a) { const int s = a >> 2; const int v = (P[0] & -(int)(s == 0)) | (P[1] & -(int)(s == 1)) | (P[2] & -(int)(s == 2)) | (P[3] & -(int)(s == 3)); return (v >> (8 * (a & 3))) & 127; }
constexpr int KSW_BYTES = 2 * 128 * 256;
__device__ __forceinline__ int ksw(int z, int key, int colB) { return (z * 128 + key) * 256 + (colB ^ ((key & 7) << 4)); }

__device__ constexpr int G2A[16] = {1, 1, 1, 1, 1, 1, 1, 2, 2, 2, 2, 3, 3, 3, 4, 4}, G2B[16] = {1, 2, 3, 4, 5, 6, 7, 1, 2, 3, 4, 1, 2, 3, 1, 2};
__device__ constexpr int G3A[3] = {5, 6, 7}, G3B[3] = {1, 1, 1};

__device__ __forceinline__ void route_unit(const bf16_t* __restrict__ PQ, const char* KL, unsigned* __restrict__ RIDX, float* __restrict__ RW, int tok0, int h, int lane) {
    const int r32 = lane & 31, hi = lane >> 5;
    int X[2][16];
#pragma unroll
    for (int z = 0; z < 2; ++z) {
        bf16x8 qf[8];
#ifdef MK_X_ROUTEIN
        const bf16_t* qp = PQ + (size_t)(tok0 + r32) * 1024 + (h & 3) * 256 + z * 128 + hi * 8;
#else
        const bf16_t* qp = PQ + (size_t)(tok0 + r32) * 2048 + h * 256 + z * 128 + hi * 8;
#endif
#pragma unroll
        for (int ks = 0; ks < 8; ++ks) qf[ks] = *(const bf16x8*)(qp + ks * 16);
        f32x16 acc[4];
#pragma unroll
        for (int kt = 0; kt < 4; ++kt) { acc[kt] = f32x16{};
#pragma unroll
            for (int ks = 0; ks < 8; ++ks) { const bf16x8 kf = *(const bf16x8*)(KL + ksw(z, kt * 32 + r32, (ks * 16 + hi * 8) * 2)); acc[kt] = MFMA32(kf, qf[ks], acc[kt]); } }
        MFMA_PAD();
        int g0[16], g1[16];
#pragma unroll
        for (int half = 0; half < 2; ++half) {
#pragma unroll
            for (int i = 0; i < 16; ++i) { g0[i] = (f2key(acc[2 * half][i]) & ~127) | (64 * half + (i & 3) + 8 * (i >> 2) + 4 * hi);
                                           g1[i] = (f2key(acc[2 * half + 1][i]) & ~127) | (64 * half + 32 + (i & 3) + 8 * (i >> 2) + 4 * hi); }
            sort16_desc(g0); sort16_desc(g1); merge_top16(g0, g1);
            if (half == 0) {
#pragma unroll
                for (int i = 0; i < 16; ++i) X[z][i] = g0[i];
            } else merge_top16(X[z], g0);
        }
    }
    int T0[16], T1[16];
    { int P[16];
#pragma unroll
      for (int i = 0; i < 16; ++i) { auto rr = __builtin_amdgcn_permlane32_swap((unsigned)X[0][i], (unsigned)X[1][i], false, false); T0[i] = (int)rr[0]; P[i] = (int)rr[1]; }
      merge_top16(T0, P);
#pragma unroll
      for (int i = 0; i < 16; ++i) { auto rr = __builtin_amdgcn_permlane32_swap((unsigned)T0[i], (unsigned)T0[i], false, false); T0[i] = (int)rr[0]; T1[i] = (int)rr[1]; } }
    float f0[16], f1[16]; int I0[4] = {0, 0, 0, 0}, I1[4] = {0, 0, 0, 0};
#pragma unroll
    for (int a = 0; a < 16; ++a) { f0[a] = key2f(T0[a] & ~127); f1[a] = key2f(T1[a] & ~127); I0[a >> 2] |= (T0[a] & 127) << (8 * (a & 3)); I1[a >> 2] |= (T1[a] & 127) << (8 * (a & 3)); }
    int C0[16], C1[16], C2[16], C3[16];
#pragma unroll
    for (int b = 0; b < 16; ++b) C0[b] = (f2key(f0[0] + f1[b]) & ~255) | b;
#pragma unroll
    for (int a = 1; a < 16; ++a) C1[a - 1] = (f2key(f0[a] + f1[0]) & ~255) | (a << 4);
    C1[15] = (int)0x80000000;
#pragma unroll
    for (int c = 0; c < 16; ++c) C2[c] = (f2key(f0[G2A[c]] + f1[G2B[c]]) & ~255) | (G2A[c] << 4) | G2B[c];
#pragma unroll
    for (int c = 0; c < 16; ++c) C3[c] = (int)0x80000000;
#pragma unroll
    for (int c = 0; c < 3; ++c) C3[c] = (f2key(f0[G3A[c]] + f1[G3B[c]]) & ~255) | (G3A[c] << 4) | G3B[c];
    ce_desc(C3[0], C3[1]); ce_desc(C3[1], C3[2]); ce_desc(C3[0], C3[1]);
    sort16_desc(C2);
    merge_top16(C0, C1); merge_top16(C2, C3); merge_top16(C0, C2);
    float sc[16]; float ssum = 0.f; const float smax = key2f(C0[0] & ~255);
#pragma unroll
    for (int k = 0; k < 16; ++k) { sc[k] = __expf(key2f(C0[k] & ~255) - smax); ssum += sc[k]; }
    const float rs = __builtin_amdgcn_rcpf(ssum);
    {
        unsigned* ip = RIDX + (size_t)(tok0 + r32) * 128 + h * 16; float* wp = RW + (size_t)(tok0 + r32) * 128 + h * 16;
#pragma unroll
        for (int k4 = 0; k4 < 4; ++k4) { u32x4 iv; f32x4 wv;
#pragma unroll
            for (int e = 0; e < 4; ++e) { const int k = 4 * k4 + e, ab = C0[k] & 255; iv[e] = (unsigned)(lut16(I0, ab >> 4) * 128 + lut16(I1, ab & 15)); wv[e] = sc[k] * rs; }
            *(u32x4*)(ip + 4 * k4) = iv; *(f32x4*)(wp + 4 * k4) = wv; }
    }
}

constexpr float PU_SCALE = 256.f, PV_SCALE = 16.f;
#define DPP_ADD(s, ctrl) s += __builtin_bit_cast(float, __builtin_amdgcn_update_dpp(0, __builtin_bit_cast(int, s), ctrl, 0xF, 0xF, true))
__device__ __forceinline__ float dot16_fp8(const u32x4 w, const float (&x)[16]) {
    const f32x2 a0 = __builtin_amdgcn_cvt_pk_f32_fp8((int)w.x, false), a1 = __builtin_amdgcn_cvt_pk_f32_fp8((int)w.x, true), a2 = __builtin_amdgcn_cvt_pk_f32_fp8((int)w.y, false), a3 = __builtin_amdgcn_cvt_pk_f32_fp8((int)w.y, true);
    const f32x2 a4 = __builtin_amdgcn_cvt_pk_f32_fp8((int)w.z, false), a5 = __builtin_amdgcn_cvt_pk_f32_fp8((int)w.z, true), a6 = __builtin_amdgcn_cvt_pk_f32_fp8((int)w.w, false), a7 = __builtin_amdgcn_cvt_pk_f32_fp8((int)w.w, true);
    float c = a0[0] * x[0]; c = fmaf(a0[1], x[1], c); c = fmaf(a1[0], x[2], c); c = fmaf(a1[1], x[3], c); c = fmaf(a2[0], x[4], c); c = fmaf(a2[1], x[5], c); c = fmaf(a3[0], x[6], c); c = fmaf(a3[1], x[7], c);
    c = fmaf(a4[0], x[8], c); c = fmaf(a4[1], x[9], c); c = fmaf(a5[0], x[10], c); c = fmaf(a5[1], x[11], c); c = fmaf(a6[0], x[12], c); c = fmaf(a6[1], x[13], c); c = fmaf(a7[0], x[14], c); c = fmaf(a7[1], x[15], c);
    return c;
}
__device__ __forceinline__ void acc16_fp8(const u32x4 w, const float a, float (&f)[16]) {
    const f32x2 a0 = __builtin_amdgcn_cvt_pk_f32_fp8((int)w.x, false), a1 = __builtin_amdgcn_cvt_pk_f32_fp8((int)w.x, true), a2 = __builtin_amdgcn_cvt_pk_f32_fp8((int)w.y, false), a3 = __builtin_amdgcn_cvt_pk_f32_fp8((int)w.y, true);
    const f32x2 a4 = __builtin_amdgcn_cvt_pk_f32_fp8((int)w.z, false), a5 = __builtin_amdgcn_cvt_pk_f32_fp8((int)w.z, true), a6 = __builtin_amdgcn_cvt_pk_f32_fp8((int)w.w, false), a7 = __builtin_amdgcn_cvt_pk_f32_fp8((int)w.w, true);
    f[0] = fmaf(a, a0[0], f[0]); f[1] = fmaf(a, a0[1], f[1]); f[2] = fmaf(a, a1[0], f[2]); f[3] = fmaf(a, a1[1], f[3]); f[4] = fmaf(a, a2[0], f[4]); f[5] = fmaf(a, a2[1], f[5]); f[6] = fmaf(a, a3[0], f[6]); f[7] = fmaf(a, a3[1], f[7]);
    f[8] = fmaf(a, a4[0], f[8]); f[9] = fmaf(a, a4[1], f[9]); f[10] = fmaf(a, a5[0], f[10]); f[11] = fmaf(a, a5[1], f[11]); f[12] = fmaf(a, a6[0], f[12]); f[13] = fmaf(a, a6[1], f[13]); f[14] = fmaf(a, a7[0], f[14]); f[15] = fmaf(a, a7[1], f[15]);
}
__device__ __forceinline__ void batch_compute(const u32x4 u0, const u32x4 u1, const u32x4 u2, const u32x4 u3, const u32x4 v0, const u32x4 v1, const u32x4 v2, const u32x4 v3,
                                              const float g0, const float g1, const float g2, const float g3, const float (&x)[16], float (&f)[16], int lane) {
    const float p0 = dot16_fp8(u0, x), p1 = dot16_fp8(u1, x), p2 = dot16_fp8(u2, x), p3 = dot16_fp8(u3, x);
    const bool up32 = lane >= 32;
    float k0 = up32 ? p2 : p0, k1 = up32 ? p3 : p1, s0 = up32 ? p0 : p2, s1 = up32 ? p1 : p3;
    { auto r0 = __builtin_amdgcn_permlane32_swap(__builtin_bit_cast(unsigned, s0), __builtin_bit_cast(unsigned, s0), false, false);
      auto r1 = __builtin_amdgcn_permlane32_swap(__builtin_bit_cast(unsigned, s1), __builtin_bit_cast(unsigned, s1), false, false);
      k0 += __builtin_bit_cast(float, up32 ? r0[0] : r0[1]); k1 += __builtin_bit_cast(float, up32 ? r1[0] : r1[1]); }
    const bool odd16 = (lane & 16) != 0;
    float kk = odd16 ? k1 : k0, ss = odd16 ? k0 : k1;
    ss = __shfl_xor(ss, 16); kk += ss;
    DPP_ADD(kk, 0xB1); DPP_ADD(kk, 0x4E); DPP_ADD(kk, 0x141); DPP_ADD(kk, 0x140);
    const int grp = lane >> 4;
    const float gg = grp == 0 ? g0 : (grp == 1 ? g1 : (grp == 2 ? g2 : g3));
    const float act = gelu_tanh(kk * (1.f / PU_SCALE)) * gg * (1.f / PV_SCALE);
    acc16_fp8(v0, __builtin_bit_cast(float, __builtin_amdgcn_readlane(__builtin_bit_cast(unsigned, act), 0)), f);
    acc16_fp8(v1, __builtin_bit_cast(float, __builtin_amdgcn_readlane(__builtin_bit_cast(unsigned, act), 16)), f);
    acc16_fp8(v2, __builtin_bit_cast(float, __builtin_amdgcn_readlane(__builtin_bit_cast(unsigned, act), 32)), f);
    acc16_fp8(v3, __builtin_bit_cast(float, __builtin_amdgcn_readlane(__builtin_bit_cast(unsigned, act), 48)), f);
}
__device__ __forceinline__ void gather_token(const bf16_t* __restrict__ xrow, const unsigned* __restrict__ ridx, const float* __restrict__ rw, const unsigned char* __restrict__ PU, const unsigned char* __restrict__ PV,
                                             float (&f)[16], int lane) {
    float x[16];
    { const u32x4 x0 = *(const u32x4*)(xrow + 16 * lane), x1 = *(const u32x4*)(xrow + 16 * lane + 8);
      x[0] = bf_lo(x0.x); x[1] = bf_hi(x0.x); x[2] = bf_lo(x0.y); x[3] = bf_hi(x0.y); x[4] = bf_lo(x0.z); x[5] = bf_hi(x0.z); x[6] = bf_lo(x0.w); x[7] = bf_hi(x0.w);
      x[8] = bf_lo(x1.x); x[9] = bf_hi(x1.x); x[10] = bf_lo(x1.y); x[11] = bf_hi(x1.y); x[12] = bf_lo(x1.z); x[13] = bf_hi(x1.z); x[14] = bf_lo(x1.w); x[15] = bf_hi(x1.w); }
    const unsigned id_lo = ridx[lane], id_hi = ridx[64 + lane]; const float w_lo = rw[lane], w_hi = rw[64 + lane];
#pragma unroll
    for (int i = 0; i < 16; ++i) f[i] = 0.f;
#define BLQ(bt_, q, U, V, Gq) { const int src = (4 * (bt_) + (q)) & 63; const unsigned e = (bt_) < 16 ? __builtin_amdgcn_readlane(id_lo, src) : __builtin_amdgcn_readlane(id_hi, src); \
    Gq = __builtin_bit_cast(float, (bt_) < 16 ? __builtin_amdgcn_readlane(__builtin_bit_cast(unsigned, w_lo), src) : __builtin_amdgcn_readlane(__builtin_bit_cast(unsigned, w_hi), src)); \
    U = *(const u32x4*)(PU + (size_t)e * 1024 + 16 * lane); V = *(const u32x4*)(PV + (size_t)e * 1024 + 16 * lane); }
#define BLOAD_A(bt_) do { BLQ(bt_, 0, au0, av0, ag0) BLQ(bt_, 1, au1, av1, ag1) BLQ(bt_, 2, au2, av2, ag2) BLQ(bt_, 3, au3, av3, ag3) } while (0)
#define BLOAD_B(bt_) do { BLQ(bt_, 0, bu0, bv0, bg0) BLQ(bt_, 1, bu1, bv1, bg1) BLQ(bt_, 2, bu2, bv2, bg2) BLQ(bt_, 3, bu3, bv3, bg3) } while (0)
    u32x4 au0, au1, au2, au3, av0, av1, av2, av3, bu0, bu1, bu2, bu3, bv0, bv1, bv2, bv3; float ag0, ag1, ag2, ag3, bg0, bg1, bg2, bg3;
    BLOAD_A(0);
#pragma unroll 1
    for (int bt = 0; bt < 32; bt += 2) {
        BLOAD_B(bt + 1);
        batch_compute(au0, au1, au2, au3, av0, av1, av2, av3, ag0, ag1, ag2, ag3, x, f, lane);
        { const int bn = bt + 2 < 32 ? bt + 2 : bt; BLOAD_A(bn); }
        batch_compute(bu0, bu1, bu2, bu3, bv0, bv1, bv2, bv3, bg0, bg1, bg2, bg3, x, f, lane);
    }
#undef BLQ
#undef BLOAD_A
#undef BLOAD_B
}
#undef DPP_ADD
}


#ifdef MK_X_HASH
__device__ __forceinline__ void hash_range(unsigned char* ws, size_t off, size_t bytes, int word, int gt, int NGT) {
    const unsigned* p = (const unsigned*)(ws + off); const size_t n = bytes / 4; unsigned h = 0u;
    for (size_t i = gt; i < n; i += NGT) h += p[i] * ((unsigned)i * 2654435761u + 12345u);
    atomicAdd((unsigned*)(ws + WS_CTL) + 8192 + word, h);
}
#endif
constexpr int NWAVES = 8, RING_BYTES = 131072, LDSCTL_OFF = RING_BYTES, MISC_OFF = LDSCTL_OFF + 320, LDS_BYTES = 147456;
constexpr int NPH = 11;
struct Args { const float* in[29]; float* out; unsigned char* ws; int ph_lo, ph_hi; };
static_assert(sizeof(Args) == 29 * 8 + 8 + 8 + 8, "Args has no padding");
enum { I_X = 0, I_C, I_CTX, I_CCTX, I_WMOD, I_BMOD, I_WIN, I_QNG, I_KVNG, I_WUQ, I_WUKV, I_S5ARE, I_S5AIM, I_S5LDT, I_S5BRE, I_S5BIM, I_S5CRE, I_S5CIM, I_S5D, I_WGLU, I_WOUT,
       I_LN1G, I_LN1B, I_PWQ, I_PKEYS, I_PU, I_PV, I_LN2G, I_LN2B };

__global__ void __launch_bounds__(NWAVES * 64, 2) mk_fwd(Args args) {
    extern __shared__ __attribute__((aligned(16))) unsigned char lds[];
    LAS unsigned char* ldsl = (LAS unsigned char*)lds;
    volatile LAS unsigned* MISC = (volatile LAS unsigned*)(ldsl + MISC_OFF);
    const int wave = __builtin_amdgcn_readfirstlane(threadIdx.x >> 6);
    const int G = gridDim.x; const int bx = blockIdx.x; const int vcu = (G % 8 == 0) ? (bx % 8) * (G / 8) + bx / 8 : bx;
    const int gw = vcu * NWAVES + wave, NGW = G * NWAVES;
    unsigned char* ws = args.ws;
    { const int tid = wave * 64 + lane_id_fresh(); for (int u = tid; u < (LDS_BYTES - LDSCTL_OFF) / 4; u += NWAVES * 64) ((LAS unsigned*)(ldsl + LDSCTL_OFF))[u] = 0u; }
    __syncthreads();
    XcdBarrier bar; bar.bar = (unsigned*)(ws + WS_CTL); bar.x = 0; bar.st = nullptr;
    if (MK_N_LAUNCHES == 1) bar = xcd_barrier_post((unsigned*)(ws + WS_CTL), MISC + 8, wave * 64 + lane_id_fresh());
    const int lo = args.ph_lo, hi = args.ph_hi;
#ifndef MK_ONLY
#define MK_ONLY -1
#endif
#define IN(k) ((MK_ONLY < 0 || MK_ONLY == (k)) && lo <= (k) && (k) < hi)
#ifdef MK_X_HASH
#define HR(off, bytes, w) hash_range(ws, off, bytes, w, gt_, NGT_)
#define SEAM(k) do { if (IN(k) && IN((k) + 1)) { xcd_barrier(bar, wave * 64 + lane_id_fresh()); { const int gt_ = bx * 512 + wave * 64 + lane_id_fresh(), NGT_ = G * 512; \
    if ((k) == 2) { HR(WS_S5ABAR, (size_t)(0.6 * MiB), 0); HR(WS_SU, 36 * MiB, 1); } \
    if ((k) == 3) { HR(WS_S5E, (size_t)(3.5 * MiB), 2); HR(WS_Q, 96 * MiB, 20); HR(WS_KN, 72 * MiB, 21); HR(WS_V, 72 * MiB, 22); HR(WS_KPE, (size_t)(4.5 * MiB), 23); } \
    if ((k) == 4) { HR(WS_Q, 96 * MiB, 12); HR(WS_Y, 32 * MiB, 13); } \
    if ((k) == 5) HR(WS_MERGED, 64 * MiB, 14); \
    if ((k) == 6) HR(WS_T, 128 * MiB, 15); \
    if ((k) == 7) { HR(WS_T, 128 * MiB, 16); HR(WS_XM2, 64 * MiB, 16); HR(WS_PU, 64 * MiB, 16); } \
    if ((k) == 8) HR(WS_PQ, 128 * MiB, 17); \
    if ((k) == 9) HR(WS_ROUTE, 32 * MiB, 18); } \
    xcd_barrier(bar, wave * 64 + lane_id_fresh()); } } while (0)
#else
#define SEAM(k) do { if (IN(k) && IN((k) + 1)) { xcd_barrier(bar, wave * 64 + lane_id_fresh()); } } while (0)
#endif
#define MOD ((float*)(ws + WS_MOD))
#define ABAR ((float*)(ws + WS_S5ABAR))
#define POW ((float*)(ws + WS_S5POW))
#define BB ((bf16_t*)(ws + WS_S5BB))
#define CM ((bf16_t*)(ws + WS_S5CM))
#define ROPE ((float*)(ws + WS_ROPE))
#define PART ((float*)(ws + WS_PART))
#define S5E ((float*)(ws + WS_S5E))
#define WIN ((bf16_t*)(ws + WS_WIN))
#define WUQ ((bf16_t*)(ws + WS_WUQ))
#define WUKV ((bf16_t*)(ws + WS_WUKV))
#define WGLU ((bf16_t*)(ws + WS_WGLU))
#define WOUT ((bf16_t*)(ws + WS_WOUT))
#define WQ ((bf16_t*)(ws + WS_WQ))
#define KEYS ((bf16_t*)(ws + WS_KEYS))
#define ZQ ((bf16_t*)(ws + WS_ZQ))
#define YB ((bf16_t*)(ws + WS_Y))
#define SU ((bf16_t*)(ws + WS_SU))
#define GATES ((bf16_t*)(ws + WS_GATES))
#define XM ((bf16_t*)(ws + WS_XM))
#define VB ((bf16_t*)(ws + WS_V))
#define MERGED ((bf16_t*)(ws + WS_MERGED))
#define QB ((bf16_t*)(ws + WS_Q))
#define KN ((bf16_t*)(ws + WS_KN))
#define KPE ((bf16_t*)(ws + WS_KPE))
#define TB ((float*)(ws + WS_T))
#define XM2 ((bf16_t*)(ws + WS_XM2))
#define PQ ((bf16_t*)(ws + WS_PQ))
#define PUB ((bf16_t*)(ws + WS_PU))
#define PVB ((bf16_t*)(ws + WS_PV))
    if (IN(0)) { const int lane = lane_id_fresh(), tid = wave * 64 + lane; (void)tid;
        if (bx < 96) {
            LAS float* sl = (LAS float*)ldsl;
            for (int idx = tid; idx < 17 * 1024; idx += 512) { const int b = idx >> 10, k = idx & 1023; const float cv = (b < 16) ? args.in[I_C][b * 1024 + k] : args.in[I_CCTX][k];
                sl[k * 20 + b] = cv * __builtin_amdgcn_rcpf(1.f + __expf(-cv)); }
            __syncthreads();
            LAS float* red = (LAS float*)(ldsl + 81920);
            for (int item = bx; item < 96; item += G) { const int n0 = item * 64;
                float acc[17];
#pragma unroll
                for (int b = 0; b < 17; ++b) acc[b] = 0.f;
                const float* wp = args.in[I_WMOD] + (size_t)(wave * 128) * 6144 + n0 + lane;
#pragma unroll 4
                for (int kk = 0; kk < 128; ++kk) { const float w = wp[(size_t)kk * 6144]; const LAS float* s = sl + (wave * 128 + kk) * 20;
                    const f32x4 s0 = *(const LAS f32x4*)s, s1 = *(const LAS f32x4*)(s + 4), s2 = *(const LAS f32x4*)(s + 8), s3 = *(const LAS f32x4*)(s + 12); const float s4 = s[16];
                    acc[0] += w * s0[0]; acc[1] += w * s0[1]; acc[2] += w * s0[2]; acc[3] += w * s0[3]; acc[4] += w * s1[0]; acc[5] += w * s1[1]; acc[6] += w * s1[2]; acc[7] += w * s1[3];
                    acc[8] += w * s2[0]; acc[9] += w * s2[1]; acc[10] += w * s2[2]; acc[11] += w * s2[3]; acc[12] += w * s3[0]; acc[13] += w * s3[1]; acc[14] += w * s3[2]; acc[15] += w * s3[3]; acc[16] += w * s4; }
#pragma unroll
                for (int b = 0; b < 17; ++b) red[(wave * 17 + b) * 64 + lane] = acc[b];
                __syncthreads();
                for (int idx = tid; idx < 17 * 64; idx += 512) { const int b = idx >> 6, ln = idx & 63; float s = args.in[I_BMOD][n0 + ln];
#pragma unroll
                    for (int w = 0; w < 8; ++w) s += red[(w * 17 + b) * 64 + ln];
                    MOD[(size_t)b * 6144 + n0 + ln] = s; }
                __syncthreads();
            }
        }
        {
            LAS float* scr = (LAS float*)(ldsl + wave * 16384);
            constexpr int I_1 = 16 * 104, I_2 = 6 * 48, I_3 = 4 * 64, I_4 = 8 * 64, I_5 = 16 * 32, I_6 = 16 * 64, NITEMS = I_1 + I_2 + I_3 + I_4 + I_5 + I_6;
            for (int it = gw; it < NITEMS; it += NGW) { int r = it;
                if (r < I_1) { const int kb = r / 104, nb = r % 104, nd = nb * 32;
                    const int ns = nd < 704 ? nd : (nd < 768 ? -1 : nd - 64);
                    transpose_item(args.in[I_WIN], INW, kb * 64, ns, WIN, 1024, nd, nullptr, scr, lane); continue; } r -= I_1;
                if (r < I_2) { const int kb = r / 48, nb = r % 48; transpose_item(args.in[I_WUQ], 1536, kb * 64, nb * 32, WUQ, 384, nb * 32, args.in[I_QNG], scr, lane); continue; } r -= I_2;
                if (r < I_3) { const int kb = r / 64, nb = r % 64; transpose_item(args.in[I_WUKV], 2048, kb * 64, nb * 32, WUKV, 256, nb * 32, args.in[I_KVNG], scr, lane); continue; } r -= I_3;
                if (r < I_4) { const int kb = r / 64, nb = r % 64, nd = nb * 32, tile = nd >> 8, wi = nd & 255;
                    const int ns = wi < 128 ? tile * 128 + wi : 1024 + tile * 128 + (wi - 128);
                    transpose_item(args.in[I_WGLU], 2048, kb * 64, ns, WGLU, 512, nd, nullptr, scr, lane); continue; } r -= I_4;
                if (r < I_5) { const int kb = r / 32, nb = r % 32; transpose_item(args.in[I_WOUT], 1024, kb * 64, nb * 32, WOUT, 1024, nb * 32, nullptr, scr, lane); continue; } r -= I_5;
                { const int kb = r / 64, nb = r % 64; transpose_item(args.in[I_PWQ], 2048, kb * 64, nb * 32, WQ, 1024, nb * 32, nullptr, scr, lane); }
            }
        }
        const int gt = bx * 512 + tid, NGT = G * 512;
#ifdef MK_X_SWEEP
        { f32x4 accv = {0.f, 0.f, 0.f, 0.f};
          for (int i = gt; i < MLAT * DM / 4; i += NGT) { const f32x4 t = ((const f32x4*)args.in[I_X])[i]; accv += t; }
          asm volatile("" :: "v"(accv[0]), "v"(accv[1]), "v"(accv[2]), "v"(accv[3])); }
#endif
#ifdef MK_X_P0POISON
        for (size_t i = gt; i < (508 * MiB - WS_ZQ) / 16; i += NGT) ((u32x4*)(ws + WS_ZQ))[i] = (u32x4){0xAAAAAAAAu, 0xAAAAAAAAu, 0xAAAAAAAAu, 0xAAAAAAAAu};
        for (size_t i = gt; i < (7 * MiB) / 16; i += NGT) ((u32x4*)(ws + 3 * MiB))[i] = (u32x4){0xAAAAAAAAu, 0xAAAAAAAAu, 0xAAAAAAAAu, 0xAAAAAAAAu};
#endif
        for (int i = gt; i < 16 * 128 * 128 / 8; i += NGT) {
            const f32x4 a = ((const f32x4*)args.in[I_PKEYS])[2 * i], b = ((const f32x4*)args.in[I_PKEYS])[2 * i + 1]; ((u32x4*)KEYS)[i] = pack8(a, b); }
        for (int i = gt; i < 4096; i += NGT) {
            const int p = i & 63, dg = i >> 6;
            const double dt = exp((double)args.in[I_S5LDT][dg]), ar = args.in[I_S5ARE][i], ai = args.in[I_S5AIM][i];
            const double mag = exp(ar * dt), abr = mag * cos(ai * dt), abi = mag * sin(ai * dt), den = ar * ar + ai * ai;
            const double fr = ((abr - 1.0) * ar + abi * ai) / den, fi = (abi * ar - (abr - 1.0) * ai) / den;
            ABAR[2 * i] = (float)abr; ABAR[2 * i + 1] = (float)abi;
            { const double m1 = exp(ar * dt * 256.0), m2 = exp(ar * dt * 512.0);
              POW[2 * i] = (float)(m1 * cos(ai * dt * 256.0)); POW[2 * i + 1] = (float)(m1 * sin(ai * dt * 256.0));
              POW[8192 + 2 * i] = (float)(m2 * cos(ai * dt * 512.0)); POW[8192 + 2 * i + 1] = (float)(m2 * sin(ai * dt * 512.0)); }
            for (int c = 0; c < 16; ++c) { const double br = args.in[I_S5BRE][(size_t)i * 16 + c], bi = args.in[I_S5BIM][(size_t)i * 16 + c];
                BB[((size_t)(dg * 2 + 0) * 64 + p) * 16 + c] = (bf16_t)(cvt_pk_bf16((float)(fr * br - fi * bi), 0.f) & 0xffffu);
                BB[((size_t)(dg * 2 + 1) * 64 + p) * 16 + c] = (bf16_t)(cvt_pk_bf16((float)(fr * bi + fi * br), 0.f) & 0xffffu);
                CM[((size_t)dg * 16 + c) * 128 + p] = (bf16_t)(cvt_pk_bf16(args.in[I_S5CRE][((size_t)dg * 16 + c) * 64 + p], 0.f) & 0xffffu);
                CM[((size_t)dg * 16 + c) * 128 + 64 + p] = (bf16_t)(cvt_pk_bf16(-args.in[I_S5CIM][((size_t)dg * 16 + c) * 64 + p], 0.f) & 0xffffu); }
        }
        for (int i = gt; i < 1024; i += NGT) { const int pos = i >> 4, idx = i & 15;
            const double ang = (double)pos * exp(-9.210340371976184 * (double)idx / 16.0); ROPE[2 * i] = (float)cos(ang); ROPE[2 * i + 1] = (float)sin(ang); }
    }
    SEAM(0);
    if (IN(1)) { const int lane = lane_id_fresh(), tid = wave * 64 + lane; (void)tid;
        for (int m = gw; m < MTOT; m += NGW) {
            const int b = (m < MLAT) ? (m >> 11) : 16; const float* xr = (m < MLAT) ? args.in[I_X] + (size_t)m * DM : args.in[I_CTX] + (size_t)(m - MLAT) * DM;
            modulate_row(xr, MOD + (size_t)b * 6144, MOD + (size_t)b * 6144 + 1024, XM + (size_t)m * DM, lane); }
    }
    SEAM(1);
    if (IN(2)) {
        pg8::Gemm g{XM, WIN, 1024, 1024, 1024}; pg8::StaticOrder S; S.init(MLAT / 256, 13, G, bx, MCTX / 256, 5);
        EpiInProj E{ZQ, SU, GATES, PART};
        pg8::gemm_phase(ldsl, g, S, E, wave * 64 + lane_id_fresh());
    }
    SEAM(2);
    if (IN(3)) { const int lane = lane_id_fresh(), tid = wave * 64 + lane; (void)tid;
        { pg8::Gemm g{ZQ, WUQ, 768, 384, 384}; pg8::StaticOrder S; S.init(MLAT / 256, 6, G, bx); EpiUQ E{QB, PART}; pg8::gemm_phase(ldsl, g, S, E, wave * 64 + lane_id_fresh()); }
        { pg8::Gemm g{ZQ + 384, WUKV, 768, 256, 256}; pg8::StaticOrder S; S.init(MTOT / 256, 8, G, bx); EpiUKV E{KN, VB, PART}; pg8::gemm_phase(ldsl, g, S, E, wave * 64 + lane_id_fresh()); }
        const int gt = bx * 512 + tid, NGT = G * 512;
        for (int i = gt; i < MTOT * 32; i += NGT) {
            const int row = i >> 5, pp = i & 31, part = pp >> 4, idx = pp & 15;
            const bf16_t* z = ZQ + (size_t)row * 768 + 640 + part * 32 + idx; const float x1 = bf_lo((unsigned)z[0]), x2 = bf_lo((unsigned)z[16]);
            float o1 = x1, o2 = x2; int b, key;
            if (row < MLAT) { b = row >> 11; const int l = row & 2047; key = CTXL + l; const int pos = part == 0 ? (l >> 6) : (l & 63); const float cs = ROPE[(pos * 16 + idx) * 2], sn = ROPE[(pos * 16 + idx) * 2 + 1];
                o1 = x1 * cs - x2 * sn; o2 = x2 * cs + x1 * sn; }
            else { const int r2 = row - MLAT; b = r2 >> 8; key = r2 & 255; }
            bf16_t* kp = KPE + ((size_t)b * NKEY + key) * 64 + part * 32 + idx;
            kp[0] = (bf16_t)(cvt_pk_bf16(o1, 0.f) & 0xffffu); kp[16] = (bf16_t)(cvt_pk_bf16(o2, 0.f) & 0xffffu); }
#if MK_STAGE >= 3
        for (int u = gw; u < 2 * 32 * 8 * 7; u += NGW) s5_passA(SU, ABAR, BB, S5E, u, lane);
#ifdef MK_X_DUPA
        for (int u = gw; u < 2 * 32 * 8 * 7; u += NGW) s5_passA(SU, ABAR, BB, (float*)(ws + 492 * MiB), u, lane);
#endif
#endif
    }
    SEAM(3);
    if (IN(4)) { const int lane = lane_id_fresh(), tid = wave * 64 + lane; (void)tid;
#if MK_STAGE >= 2
#pragma unroll 1
        for (int U = vcu; U < 1024; U += G) { const int bh = U >> 3, qb = U & 7, b = bh >> 3, h = bh & 7;
            att::attn_unit(QB + ((size_t)bh * SEQ + qb * 256) * DK, KN + (size_t)bh * NKEY * 128, KPE + (size_t)b * NKEY * 64, VB + (size_t)bh * NKEY * 128,
                           GATES + ((size_t)(b * SEQ + qb * 256)) * 2048 + h * 128, ROPE, qb * 256, (char*)lds, wave * 64 + lane_id_fresh()); }
#endif
#if MK_STAGE >= 3
        for (int u = gw; u < 2048; u += NGW) s5_passB(SU, ABAR, POW, BB, CM, S5E, args.in[I_S5D], YB, u, lane, ldsl + wave * S5_LDS_WAVE);
#endif
    }
    SEAM(4);
    if (IN(5)) {
        pg8::Gemm g{YB, WGLU, 512, 512, 512}; pg8::StaticOrder S; S.init(MLAT / 256, 8, G, bx); EpiGLU E{QB, GATES, MERGED}; pg8::gemm_phase(ldsl, g, S, E, wave * 64 + lane_id_fresh());
    }
    SEAM(5);
    if (IN(6)) {
        pg8::Gemm g{MERGED, WOUT, 1024, 1024, 1024}; pg8::StaticOrder S; S.init(MLAT / 256, 4, G, bx); EpiOut E{args.in[I_X], MOD, TB}; pg8::gemm_phase(ldsl, g, S, E, wave * 64 + lane_id_fresh());
    }
    SEAM(6);
    if (IN(7)) { const int lane = lane_id_fresh(), tid = wave * 64 + lane; (void)tid;
        for (int m = gw; m < MLAT; m += NGW) { const int b = m >> 11;
            ln1_row(TB + (size_t)m * DM, args.in[I_LN1G], args.in[I_LN1B], MOD + (size_t)b * 6144 + 3072, MOD + (size_t)b * 6144 + 4096, XM2 + (size_t)m * DM, lane); }
#if MK_STAGE >= 5
        const int gt = bx * 512 + tid, NGT = G * 512;
        for (int i = gt; i < 2 * PEXP * DM / 16; i += NGT) { const bool isU = i < PEXP * DM / 16; const int j = isU ? i : i - PEXP * DM / 16;
            const f32x4* src = (const f32x4*)(isU ? args.in[I_PU] : args.in[I_PV]) + 4 * (size_t)j; const float sc_ = isU ? peer::PU_SCALE : peer::PV_SCALE; u32x4 w;
#pragma unroll
            for (int d = 0; d < 4; ++d) { const f32x4 t = src[d] * sc_; int p = __builtin_amdgcn_cvt_pk_fp8_f32(t[0], t[1], 0, false); p = __builtin_amdgcn_cvt_pk_fp8_f32(t[2], t[3], p, true); w[d] = (unsigned)p; }
            ((u32x4*)(ws + WS_PU + (isU ? 0 : 16 * MiB)))[j] = w; }
#endif
    }
    SEAM(7);
#if MK_STAGE >= 5
    if (IN(8)) {
        pg8::Gemm g{XM2, WQ, 1024, 1024, 1024}; pg8::StaticOrder S; S.init(MLAT / 256, 8, G, bx); EpiPQ E{PQ}; pg8::gemm_phase(ldsl, g, S, E, wave * 64 + lane_id_fresh());
    }
#endif
    SEAM(8);
#if MK_STAGE >= 5
    if (IN(9)) { const int lane = lane_id_fresh(), tid = wave * 64 + lane; const int h = bx & 7;
        for (int c = tid; c < 4096; c += 512) { const int z = c >> 11, key = (c >> 4) & 127, c16 = c & 15;
            *(LAS u32x4*)(ldsl + peer::ksw(z, key, c16 * 16)) = *(const u32x4*)(KEYS + ((size_t)(h * 2 + z) * 128 + key) * 128 + c16 * 8); }
        __syncthreads();
#ifdef MK_X_LINROUTE
        { const int gt = bx * 512 + tid, NGT = G * 512; unsigned* RI = (unsigned*)(ws + WS_ROUTE); float* RWp = (float*)(ws + WS_ROUTE + 16 * MiB);
          for (int i = gt; i < MLAT * 128; i += NGT) { const int tok = i >> 7, k = i & 127; const u32x4 a = *(const u32x4*)(PQ + (size_t)tok * 2048 + k * 16), b = *(const u32x4*)(PQ + (size_t)tok * 2048 + k * 16 + 8);
              const float sm = (bf_lo(a.x) + bf_hi(a.x) + bf_lo(a.y) + bf_hi(a.y) + bf_lo(a.z) + bf_hi(a.z) + bf_lo(a.w) + bf_hi(a.w)) + (bf_lo(b.x) + bf_hi(b.x) + bf_lo(b.y) + bf_hi(b.y) + bf_lo(b.z) + bf_hi(b.z) + bf_lo(b.w) + bf_hi(b.w));
              RI[i] = ((unsigned)tok * 131u + (unsigned)k * 1237u) & 16383u; RWp[i] = sm * (1.f / 128.f); } }
#else
#pragma unroll 1
        for (int j = wave; j < 32; j += 8) { int l2 = lane; asm volatile("" : "+v"(l2));
#ifdef MK_X_ROUTEIN
            peer::route_unit(XM2, (const char*)lds,
#else
            peer::route_unit(PQ, (const char*)lds,
#endif
                (unsigned*)(ws + WS_ROUTE), (float*)(ws + WS_ROUTE + 16 * MiB), ((bx >> 3) * 32 + j) * 32, h, l2); }
#ifdef MK_X_DUP
#pragma unroll 1
        for (int j = wave; j < 32; j += 8) { int l2 = lane; asm volatile("" : "+v"(l2));
            peer::route_unit(PQ, (const char*)lds, (unsigned*)(ws + 480 * MiB), (float*)(ws + 496 * MiB), ((bx >> 3) * 32 + j) * 32, h, l2); }
#endif
#endif
    }
#endif
    SEAM(9);
    if (IN(10)) { const int lane = lane_id_fresh();
#pragma unroll 1
        for (int m = gw; m < MLAT; m += NGW) { const int b = m >> 11;
            float v[16];
#if MK_STAGE >= 5
            { float f[16];
              peer::gather_token(XM2 + (size_t)m * DM, (const unsigned*)(ws + WS_ROUTE) + (size_t)m * 128, (const float*)(ws + WS_ROUTE + 16 * MiB) + (size_t)m * 128, ws + WS_PU, ws + WS_PU + 16 * MiB, f, lane);
              const f32x4* gp = (const f32x4*)(MOD + (size_t)b * 6144 + 5120 + 16 * lane);
#pragma unroll
              for (int d = 0; d < 4; ++d) { const f32x4 g = gp[d];
#pragma unroll
                  for (int e = 0; e < 4; ++e) v[4 * d + e] = g[e] * f[4 * d + e]; } }
#else
#pragma unroll
            for (int i = 0; i < 16; ++i) v[i] = 0.f;
#endif
            float s = 0.f;
            { const f32x4* hp = (const f32x4*)(TB + (size_t)m * DM + 16 * lane);
#pragma unroll
              for (int d = 0; d < 4; ++d) { const f32x4 h = hp[d];
#pragma unroll
                  for (int e = 0; e < 4; ++e) v[4 * d + e] += ALPHA * h[e]; } }
#pragma unroll
            for (int i = 0; i < 16; ++i) s += v[i];
            const float mean = wave_sum(s) * (1.f / DM); float s2 = 0.f;
#pragma unroll
            for (int i = 0; i < 16; ++i) { v[i] -= mean; s2 += v[i] * v[i]; }
            const float rstd = rsqrtf(wave_sum(s2) * (1.f / DM) + LN_EPS);
            { const f32x4* gp = (const f32x4*)(args.in[I_LN2G] + 16 * lane); const f32x4* bp = (const f32x4*)(args.in[I_LN2B] + 16 * lane); f32x4* op = (f32x4*)(args.out + (size_t)m * DM + 16 * lane);
#pragma unroll
              for (int d = 0; d < 4; ++d) { const f32x4 g = gp[d], bb = bp[d]; f32x4 o;
#pragma unroll
                  for (int e = 0; e < 4; ++e) o[e] = v[4 * d + e] * rstd * g[e] + bb[e];
                  op[d] = o; } }
        }
    }
#undef IN
#undef SEAM
}

extern "C" void kernel_launch(void* const* d_in, const int* in_sizes, int n_in, void* d_out, int out_size, void* d_ws, size_t ws_size, hipStream_t stream) {
    static int grid = 0;
    if (grid == 0) {
        if (n_in != 29 || in_sizes[0] != MLAT * DM || out_size != MLAT * DM || ws_size < WS_END) {
            fprintf(stderr, "kernel_launch: unexpected problem: n_in %d in0 %d out %d ws %zu (need %zu)\n", n_in, n_in > 0 ? in_sizes[0] : -1, out_size, ws_size, (size_t)WS_END); grid = -1; return; }
        int dev = 0, cus = 0;
        if (hipGetDevice(&dev) != hipSuccess || hipDeviceGetAttribute(&cus, hipDeviceAttributeMultiprocessorCount, dev) != hipSuccess) { grid = -1; return; }
        if (hipFuncSetAttribute((const void*)mk_fwd, hipFuncAttributeMaxDynamicSharedMemorySize, LDS_BYTES) != hipSuccess) { fprintf(stderr, "kernel_launch: hipFuncSetAttribute failed\n"); grid = -1; return; }
        int per_cu = 0;
        if (hipOccupancyMaxActiveBlocksPerMultiprocessor(&per_cu, (const void*)mk_fwd, NWAVES * 64, LDS_BYTES) != hipSuccess || per_cu < 1)
            fprintf(stderr, "kernel_launch: occupancy query reports %d blocks per CU\n", per_cu);
        (void)hipGetLastError();
        grid = cus;
    }
    if (grid < 0) return;
    if (hipMemsetAsync((char*)d_ws + WS_CTL, 0, CTL_ZERO_BYTES, stream) != hipSuccess) return;
    Args a{};
    for (int i = 0; i < 29; ++i) a.in[i] = (const float*)d_in[i];
    a.out = (float*)d_out; a.ws = (unsigned char*)d_ws;
#if MK_N_LAUNCHES == 1
    a.ph_lo = 0; a.ph_hi = NPH;
    hipLaunchKernelGGL(mk_fwd, dim3(grid), dim3(NWAVES * 64), LDS_BYTES, stream, a);
#else
    for (int p = 0; p < NPH; ++p) { a.ph_lo = p; a.ph_hi = p + 1; hipLaunchKernelGGL(mk_fwd, dim3(grid), dim3(NWAVES * 64), LDS_BYTES, stream, a); }
#endif
    const hipError_t le = hipPeekAtLastError();
    if (le != hipSuccess) fprintf(stderr, "kernel_launch: launch failed: %s\n", hipGetErrorName(le));
}
```

```cpp
#include <hip/hip_runtime.h>
#include <cstdio>
#include <cstdint>

#define GAS __attribute__((address_space(1)))
#define LAS __attribute__((address_space(3)))
typedef unsigned short bf16_t;
typedef short bf16x8 __attribute__((ext_vector_type(8)));
typedef short s16x4 __attribute__((ext_vector_type(4)));
typedef short v4i16_t __attribute__((ext_vector_type(4)));
typedef float f32x2 __attribute__((ext_vector_type(2)));
typedef float f32x4 __attribute__((ext_vector_type(4)));
typedef float f32x16 __attribute__((ext_vector_type(16)));
typedef unsigned u32x2 __attribute__((ext_vector_type(2)));
typedef unsigned u32x4 __attribute__((ext_vector_type(4)));


#ifndef MK_TSEL
#define MK_TSEL -1
#endif
#ifndef MK_N_LAUNCHES
#define MK_N_LAUNCHES 1
#endif

constexpr int DM = 1024, NB = 16, SEQ = 2048, CTXL = 256, MLAT = NB * SEQ, MCTX = NB * CTXL, MTOT = MLAT + MCTX;
constexpr int NH = 8, DK = 192, DV = 128, QRANK = 384, KVRANK = 256, NKEY = CTXL + SEQ;
constexpr int INW = 3264;
constexpr int S5W = 512, S5G = 32, S5C = 16, S5P = 64;
constexpr int PEH = 8, PEK = 128, PEXP = 16384, PETOP = 16;
constexpr float LN_EPS = 1e-6f;
constexpr float ALPHA = 1.189207115002721f;
constexpr float QSCALE = 0.07216878364870322f * 1.4426950408889634f;

constexpr size_t MiB = 1u << 20;
constexpr size_t WS_CTL = 0, CTL_ZERO_BYTES = 64 * 1024;
constexpr size_t WS_MOD = 1 * MiB;
constexpr size_t WS_S5ABAR = 1 * MiB + 512 * 1024;
constexpr size_t WS_S5POW = WS_S5ABAR + 32768;
constexpr size_t WS_S5BB = WS_S5POW + 65536;
constexpr size_t WS_S5CM = WS_S5BB + 262144;
constexpr size_t WS_ROPE = WS_S5CM + 262144;
constexpr size_t WS_PART = 3 * MiB;
constexpr size_t WS_S5E = 6 * MiB;
constexpr size_t WS_WIN = 10 * MiB;
constexpr size_t WS_WUQ = WS_WIN + 3328 * 1024 * 2;
constexpr size_t WS_WUKV = WS_WUQ + 1536 * 384 * 2;
constexpr size_t WS_WGLU = WS_WUKV + 2048 * 256 * 2;
constexpr size_t WS_WOUT = WS_WGLU + 2048 * 512 * 2;
constexpr size_t WS_WQ = WS_WOUT + 1024 * 1024 * 2;
constexpr size_t WS_KEYS = WS_WQ + 2048 * 1024 * 2;
static_assert(WS_KEYS + 16 * 128 * 128 * 2 <= 28 * MiB, "weights region");
constexpr size_t WS_ZQ = 28 * MiB;
constexpr size_t WS_Y = 28 * MiB;
constexpr size_t WS_PU = 28 * MiB, WS_PV = 60 * MiB;
constexpr size_t WS_SU = 82 * MiB;
constexpr size_t WS_GATES = 118 * MiB;
constexpr size_t WS_XM2 = 118 * MiB;
constexpr size_t WS_PQ = 182 * MiB;
constexpr size_t WS_XM = 246 * MiB;
constexpr size_t WS_V = 246 * MiB;
constexpr size_t WS_MERGED = 246 * MiB;
constexpr size_t WS_Q = 318 * MiB;
constexpr size_t WS_T = 318 * MiB;
constexpr size_t WS_KN = 414 * MiB;
constexpr size_t WS_KPE = 486 * MiB;
constexpr size_t WS_ROUTE = 448 * MiB;
constexpr size_t WS_END = 492 * MiB;

#define RLX_AGENT __ATOMIC_RELAXED, __HIP_MEMORY_SCOPE_AGENT
#define LDS_WAIT() asm volatile("s_waitcnt lgkmcnt(0)" ::: "memory")
#define VM_WAIT() asm volatile("s_waitcnt vmcnt(0)" ::: "memory")
typedef __bf16 bf16x2_t __attribute__((ext_vector_type(2)));
__device__ __forceinline__ unsigned cvt_pk_bf16(float lo, float hi) { const f32x2 v = {lo, hi}; const bf16x2_t b = __builtin_convertvector(v, bf16x2_t); return __builtin_bit_cast(unsigned, b); }
__device__ __forceinline__ float bf_lo(unsigned u) { return __builtin_bit_cast(float, u << 16); }
__device__ __forceinline__ float bf_hi(unsigned u) { return __builtin_bit_cast(float, u & 0xffff0000u); }
__device__ __forceinline__ float wave_sum(float v) {
#pragma unroll
    for (int o = 1; o < 64; o <<= 1) v += __shfl_xor(v, o);
    return v;
}
__device__ __forceinline__ int lane_id_fresh() { unsigned z; asm volatile("s_mov_b32 %0, 0" : "=s"(z)); return (int)__builtin_amdgcn_mbcnt_hi(~0u, __builtin_amdgcn_mbcnt_lo(~0u, z)); }
__device__ __forceinline__ float sigmoidf_(float x) { return __builtin_amdgcn_rcpf(1.f + __expf(-x)); }
__device__ __forceinline__ float gelu_tanh(float x) {
    const float u = 0.7978845608028654f * (x + 0.044715f * x * x * x);
    return x * __builtin_amdgcn_rcpf(1.f + __expf(-2.f * u));
}

#define MFMA32(a, b, c) __builtin_amdgcn_mfma_f32_32x32x16_bf16(a, b, c, 0, 0, 0)
#define MFMA_PAD() do { __builtin_amdgcn_sched_barrier(0); asm volatile("s_nop 15\n\ts_nop 15\n\ts_nop 15\n\ts_nop 15\n\ts_nop 15\n\ts_nop 15" ::: "memory"); __builtin_amdgcn_sched_barrier(0); } while (0)

namespace pg8 {
constexpr int BM = 256, BK = 64, HALF = 128, HTB = HALF * BK * 2, STAGE_BYTES = 8 * HTB, NXCD = 8, WGM = 8;
__host__ __device__ __forceinline__ int lds_byte(int r, int c) { const int st = (r >> 4) * 2 + (c >> 5), rr = r & 15, cc = c & 31, ob = rr * 64 + cc * 2; return st * 1024 + (ob ^ (((ob >> 9) & 1) << 5)); }
__host__ __device__ __forceinline__ void stage_rc(int b, int& R, int& C) { const int st = b / 1024, sb = b % 1024, swz = sb ^ (((sb >> 9) & 1) << 5); R = (st >> 1) * 16 + swz / 64; C = (st & 1) * 32 + (swz % 64) / 2; }
__host__ __device__ __forceinline__ int perm32(int rho) { const int n = rho >> 4, i = rho & 15; return 8 * (i >> 2) + 4 * n + (i & 3); }
struct Unit { int pm, pn; };
struct Gemm { const bf16_t* A; const bf16_t* Bt; int lda, ldb, K; };
struct StaticOrder {
    int nM, nN, nwg, G, c, nM2, nN2, pm0;
    __device__ void init(int nM_, int nN_, int G_, int c_, int nM2_ = 0, int nN2_ = 0) { nM = nM_; nN = nN_; nwg = nM * nN; G = G_; c = c_; nM2 = nM2_; nN2 = nN2_; pm0 = nM_; }
    __device__ bool next(int i, Unit& u) const {
        const long L = (long)i * G + c;
        if (L >= nwg) { const int e = (int)(L - nwg); if (e >= nM2 * nN2) return false; u.pm = pm0 + e % nM2; u.pn = e / nM2; return true; }
        int wgid = (int)L; { const int q = nwg / NXCD, r = nwg % NXCD, xcd = wgid % NXCD, off = wgid / NXCD; wgid = (xcd < r ? xcd * (q + 1) : r * (q + 1) + (xcd - r) * q) + off; }
        const int nig = WGM * nN, gid = wgid / nig, fm = gid * WGM, gsz = (nM - fm) < WGM ? (nM - fm) : WGM;
        u.pm = fm + ((wgid % nig) % gsz); u.pn = (wgid % nig) / gsz; return true;
    }
};

template <class Epi, class Sched>
__device__ __forceinline__ void gemm_phase(LAS unsigned char* lds, const Gemm g, const Sched& S, const Epi& E, int tid_) {
    asm volatile("" : "+v"(tid_));
    const int tid = tid_, wid = __builtin_amdgcn_readfirstlane(tid >> 6), lane = tid & 63, wr = wid >> 2, wc = wid & 3, fr = lane & 15, fq = lane >> 4;
    const int K = g.K, nt = K / BK;
    unsigned voffA[2], voffB[2];
#pragma unroll
    for (int i = 0; i < 2; ++i) { int R, C; stage_rc(tid * 16 + i * 8192, R, C); const int Rb = Epi::PERM ? ((R & ~31) + perm32(R & 31)) : R;
        voffA[i] = (unsigned)(R * g.lda + C) * 2u; voffB[i] = (unsigned)(Rb * g.ldb + C) * 2u; }
    const size_t kstep = (size_t)(BK * 2);
    const size_t hstepA = (size_t)HALF * g.lda * 2, hstepB = (size_t)HALF * g.ldb * 2;
    const size_t tstepA = 2 * hstepA, tstepB = 2 * hstepB;
    const unsigned ldsw = (unsigned)wid * 1024u;
    const int aoff = lds_byte(wr * 64 + fr, fq * 8), boff = lds_byte(wc * 32 + fr, fq * 8);
#define PG8_SA(b, h) (((b) * 2 + (h)) * HTB)
#define PG8_SB(b, h) ((4 + (b) * 2 + (h)) * HTB)
#define PG8_STAGE(bufoff, gbase, voff) do { _Pragma("unroll") for (int _i = 0; _i < 2; ++_i) \
        __builtin_amdgcn_global_load_lds((const unsigned*)((const char*)(gbase) + (voff)[_i]), (LAS unsigned*)(lds + (bufoff) + ldsw + _i * 8192), 16, 0, 0); } while (0)
#define PG8_LDA(dst, b, h) do { _Pragma("unroll") for (int m = 0; m < 4; ++m) _Pragma("unroll") for (int k = 0; k < 2; ++k) dst[m][k] = *(const LAS bf16x8*)(lds + PG8_SA(b, h) + aoff + m * 2048 + k * 1024); } while (0)
#define PG8_LDB(dst, b, h) do { _Pragma("unroll") for (int n = 0; n < 2; ++n) _Pragma("unroll") for (int k = 0; k < 2; ++k) dst[n][k] = *(const LAS bf16x8*)(lds + PG8_SB(b, h) + boff + n * 2048 + k * 1024); } while (0)
#define PG8_MMA(ai, bj, At, Bt) do { __builtin_amdgcn_s_setprio(1); _Pragma("unroll") for (int m = 0; m < 4; ++m) _Pragma("unroll") for (int n = 0; n < 2; ++n) _Pragma("unroll") for (int k = 0; k < 2; ++k) \
        acc[ai][bj][m][n] = __builtin_amdgcn_mfma_f32_16x16x32_bf16(Bt[n][k], At[m][k], acc[ai][bj][m][n], 0, 0, 0); __builtin_amdgcn_s_setprio(0); } while (0)
#define PG8_WAIT_V(n) asm volatile("s_waitcnt vmcnt(" #n ")" ::: "memory")
#define PG8_WAIT_L(n) asm volatile("s_waitcnt lgkmcnt(" #n ")" ::: "memory")
#define PG8_BAR __builtin_amdgcn_s_barrier()
#define PG8_SCHED __builtin_amdgcn_sched_barrier(0)
    Unit cur, nxt; int ui = 0;
    if (!S.next(0, cur)) return;
    f32x4 acc[2][2][4][2];
#pragma unroll
    for (int a = 0; a < 2; ++a)
#pragma unroll
        for (int b = 0; b < 2; ++b)
#pragma unroll
            for (int m = 0; m < 4; ++m)
#pragma unroll
                for (int n = 0; n < 2; ++n) acc[a][b][m][n] = (f32x4){0.f, 0.f, 0.f, 0.f};
    bf16x8 At[4][2], B0[2][2], B1[2][2];
    const char* cA = (const char*)g.A + (size_t)cur.pm * tstepA; const char* cB = (const char*)g.Bt + (size_t)cur.pn * tstepB;
    PG8_STAGE(PG8_SB(0, 0), cB, voffB); PG8_STAGE(PG8_SB(0, 1), cB + hstepB, voffB); PG8_STAGE(PG8_SA(0, 0), cA, voffA); PG8_STAGE(PG8_SA(0, 1), cA + hstepA, voffA);
    if (wr == 1) PG8_BAR;
    PG8_WAIT_V(2); PG8_BAR;
    PG8_STAGE(PG8_SB(1, 0), cB + kstep, voffB); PG8_STAGE(PG8_SA(1, 0), cA + kstep, voffA); PG8_STAGE(PG8_SB(1, 1), cB + hstepB + kstep, voffB);
    PG8_WAIT_V(6); PG8_BAR;
    for (;;) {
        const bool has_next = S.next(ui + 1, nxt);
        const char* nA = has_next ? (const char*)g.A + (size_t)nxt.pm * tstepA : cA; const char* nB = has_next ? (const char*)g.Bt + (size_t)nxt.pn * tstepB : cB;
        for (int t = 0; t < nt; t += 2) {
            const bool last = (t == nt - 2);
            const char* a1 = cA + (size_t)(t + 1) * kstep;
            const char* a2 = last ? nA : cA + (size_t)(t + 2) * kstep; const char* b2 = last ? nB : cB + (size_t)(t + 2) * kstep;
            const char* a3 = a2 + kstep; const char* b3 = b2 + kstep;
            PG8_LDB(B0, 0, 0); PG8_LDB(B1, 0, 1); PG8_SCHED; PG8_LDA(At, 0, 0); PG8_STAGE(PG8_SA(1, 1), a1 + hstepA, voffA);
            PG8_WAIT_V(8); PG8_WAIT_L(0); PG8_BAR; PG8_MMA(0, 0, At, B0); PG8_MMA(0, 1, At, B1); PG8_BAR; PG8_SCHED;
            PG8_LDA(At, 0, 1); PG8_STAGE(PG8_SB(0, 0), b2, voffB); PG8_STAGE(PG8_SB(0, 1), b2 + hstepB, voffB); PG8_STAGE(PG8_SA(0, 0), a2, voffA);
            PG8_WAIT_V(8); PG8_WAIT_L(0); PG8_BAR; PG8_MMA(1, 0, At, B0); PG8_MMA(1, 1, At, B1); PG8_BAR; PG8_SCHED;
            PG8_LDB(B0, 1, 0); PG8_LDB(B1, 1, 1); PG8_SCHED; PG8_LDA(At, 1, 0); PG8_STAGE(PG8_SA(0, 1), a2 + hstepA, voffA);
            PG8_WAIT_V(8); PG8_WAIT_L(0); PG8_BAR; PG8_MMA(0, 0, At, B0); PG8_MMA(0, 1, At, B1); PG8_BAR; PG8_SCHED;
            PG8_LDA(At, 1, 1); PG8_STAGE(PG8_SB(1, 0), b3, voffB); PG8_STAGE(PG8_SB(1, 1), b3 + hstepB, voffB); PG8_STAGE(PG8_SA(1, 0), a3, voffA);
            PG8_WAIT_V(8); PG8_WAIT_L(0); PG8_BAR; PG8_MMA(1, 0, At, B0); PG8_MMA(1, 1, At, B1); PG8_BAR; PG8_SCHED;
        }
        if (wr == 0) PG8_BAR;
        MFMA_PAD();
        { const int l2 = lane_id_fresh(); E(acc, cur, wr, wc, l2 & 15, l2 >> 4); }
        if (!has_next) break;
#pragma unroll
        for (int a = 0; a < 2; ++a)
#pragma unroll
            for (int b = 0; b < 2; ++b)
#pragma unroll
                for (int m = 0; m < 4; ++m)
#pragma unroll
                    for (int n = 0; n < 2; ++n) acc[a][b][m][n] = (f32x4){0.f, 0.f, 0.f, 0.f};
        cur = nxt; cA = nA; cB = nB; ++ui;
        if (wr == 1) PG8_BAR;
    }
    PG8_WAIT_V(0);
    PG8_BAR;
#undef PG8_SA
#undef PG8_SB
#undef PG8_STAGE
#undef PG8_LDA
#undef PG8_LDB
#undef PG8_MMA
#undef PG8_WAIT_V
#undef PG8_WAIT_L
#undef PG8_BAR
#undef PG8_SCHED
}
}

typedef f32x4 acc_t[2][2][4][2];
__device__ __forceinline__ u32x4 pack8(const f32x4 a, const f32x4 b) { u32x4 w; w.x = cvt_pk_bf16(a[0], a[1]); w.y = cvt_pk_bf16(a[2], a[3]); w.z = cvt_pk_bf16(b[0], b[1]); w.w = cvt_pk_bf16(b[2], b[3]); return w; }

struct EpiInProj { static constexpr bool PERM = true;
    bf16_t* ZQ; bf16_t* SU; bf16_t* GATES; float* PART;
    __device__ __forceinline__ void operator()(const acc_t& acc, const pg8::Unit& u, int wr, int wc, int fr, int fq) const {
        const int row0 = u.pm * 256 + wr * 64 + fr, pn = u.pn;
#pragma unroll
        for (int ai = 0; ai < 2; ++ai)
#pragma unroll
            for (int m = 0; m < 4; ++m) { const int row = row0 + ai * 128 + m * 16;
#pragma unroll
                for (int bj = 0; bj < 2; ++bj) { f32x4 v0 = acc[ai][bj][m][0], v1 = acc[ai][bj][m][1]; const int c0 = bj * 128 + wc * 32 + 8 * fq;
                    if (pn < 3) {
                        *(u32x4*)(ZQ + (size_t)row * 768 + pn * 256 + c0) = pack8(v0, v1);
                        float ss = (v0[0] * v0[0] + v0[1] * v0[1]) + (v0[2] * v0[2] + v0[3] * v0[3]) + (v1[0] * v1[0] + v1[1] * v1[1]) + (v1[2] * v1[2] + v1[3] * v1[3]);
                        ss += __shfl_xor(ss, 16); ss += __shfl_xor(ss, 32);
                        const int slot = pn * 2 + bj;
                        if (fq == 0 && slot < 5) PART[(size_t)row * 20 + slot * 4 + wc] = ss;
                    } else if (pn < 5) {
                        *(u32x4*)(SU + (size_t)row * 512 + (pn - 3) * 256 + c0) = pack8(v0, v1);
                    } else {
#pragma unroll
                        for (int e = 0; e < 4; ++e) { v0[e] = sigmoidf_(v0[e]); v1[e] = sigmoidf_(v1[e]); }
                        *(u32x4*)(GATES + (size_t)row * 2048 + (pn - 5) * 256 + c0) = pack8(v0, v1);
                    } } }
    }
};
struct EpiUQ { static constexpr bool PERM = true;
    bf16_t* Q; const float* PART;
    __device__ __forceinline__ void operator()(const acc_t& acc, const pg8::Unit& u, int wr, int wc, int fr, int fq) const {
        asm volatile("" : "+v"(fr), "+v"(fq));
        const int row0 = u.pm * 256 + wr * 64 + fr;
#pragma unroll
        for (int ai = 0; ai < 2; ++ai)
#pragma unroll
            for (int m = 0; m < 4; ++m) { asm volatile("" ::: "memory"); const int row = row0 + ai * 128 + m * 16; const int b = row >> 11, l = row & 2047;
                const f32x4* pp = (const f32x4*)(PART + (size_t)row * 20); const f32x4 p0 = pp[0], p1 = pp[1], p2 = pp[2];
                const float ssq = ((p0[0] + p0[1]) + (p0[2] + p0[3])) + ((p1[0] + p1[1]) + (p1[2] + p1[3])) + ((p2[0] + p2[1]) + (p2[2] + p2[3]));
                const float sc = rsqrtf(ssq * (1.f / 384.f) + LN_EPS) * QSCALE;
#pragma unroll
                for (int bj = 0; bj < 2; ++bj) { const f32x4 v0 = acc[ai][bj][m][0] * sc, v1 = acc[ai][bj][m][1] * sc;
                    const int g0 = u.pn * 256 + bj * 128 + wc * 32;
                    const int head = g0 / 192, w0 = g0 - head * 192;
                    *(u32x4*)(Q + ((size_t)(b * NH + head) * SEQ + l) * DK + w0 + 8 * fq) = pack8(v0, v1);
                } }
    }
};
struct EpiUKV { static constexpr bool PERM = true;
    bf16_t* KN; bf16_t* V; const float* PART;
    __device__ __forceinline__ void operator()(const acc_t& acc, const pg8::Unit& u, int wr, int wc, int fr, int fq) const {
        asm volatile("" : "+v"(fr), "+v"(fq));
        const int row0 = u.pm * 256 + wr * 64 + fr;
#pragma unroll
        for (int ai = 0; ai < 2; ++ai)
#pragma unroll
            for (int m = 0; m < 4; ++m) { asm volatile("" ::: "memory"); const int row = row0 + ai * 128 + m * 16;
                int b, key; if (row < MLAT) { b = row >> 11; key = CTXL + (row & 2047); } else { const int r2 = row - MLAT; b = r2 >> 8; key = r2 & 255; }
                const f32x4* pp = (const f32x4*)(PART + (size_t)row * 20 + 12); const f32x4 p0 = pp[0], p1 = pp[1];
                const float ssq = ((p0[0] + p0[1]) + (p0[2] + p0[3])) + ((p1[0] + p1[1]) + (p1[2] + p1[3]));
                const float sc = rsqrtf(ssq * (1.f / 256.f) + LN_EPS);
#pragma unroll
                for (int bj = 0; bj < 2; ++bj) { const f32x4 v0 = acc[ai][bj][m][0] * sc, v1 = acc[ai][bj][m][1] * sc;
                    const int head = u.pn; bf16_t* dst = (bj == 0) ? KN : V;
                    *(u32x4*)(dst + ((size_t)(b * NH + head) * NKEY + key) * 128 + wc * 32 + 8 * fq) = pack8(v0, v1);
                } }
    }
};
struct EpiGLU { static constexpr bool PERM = true;
    const bf16_t* ATT; const bf16_t* GATES; bf16_t* MERGED;
    __device__ __forceinline__ void operator()(const acc_t& acc, const pg8::Unit& u, int wr, int wc, int fr, int fq) const {
        asm volatile("" : "+v"(fr), "+v"(fq));
        const int row0 = u.pm * 256 + wr * 64 + fr; const int head = u.pn, d0 = wc * 32 + 8 * fq, j0 = head * 128 + d0;
#define GLU_LD(it_, AT, GS) do { const int row_ = row0 + ((it_) >> 2) * 128 + ((it_) & 3) * 16; const int b_ = row_ >> 11, l_ = row_ & 2047; \
        AT = *(const u32x4*)(ATT + ((size_t)(b_ * NH + head) * SEQ + (l_ & ~255)) * DK + (l_ & 255) * 128 + d0); GS = *(const u32x4*)(GATES + (size_t)row_ * 2048 + 1024 + j0); } while (0)
        u32x4 atn, gsn; GLU_LD(0, atn, gsn);
#pragma unroll
        for (int it = 0; it < 8; ++it) { const int ai = it >> 2, m = it & 3, row = row0 + ai * 128 + m * 16;
            const u32x4 at = atn, gs = gsn;
            if (it + 1 < 8) GLU_LD(it + 1, atn, gsn);
            asm volatile("" ::: "memory");
            const f32x4 a0 = acc[ai][0][m][0], a1 = acc[ai][0][m][1], b0 = acc[ai][1][m][0], b1 = acc[ai][1][m][1];
            f32x4 o0, o1;
#define GLU1(o, a, bb, atw, gsw, e0) o[e0] = bf_lo(atw) + bf_lo(gsw) * a[e0] * sigmoidf_(bb[e0]); o[e0 + 1] = bf_hi(atw) + bf_hi(gsw) * a[e0 + 1] * sigmoidf_(bb[e0 + 1]);
            GLU1(o0, a0, b0, at.x, gs.x, 0) GLU1(o0, a0, b0, at.y, gs.y, 2) GLU1(o1, a1, b1, at.z, gs.z, 0) GLU1(o1, a1, b1, at.w, gs.w, 2)
#undef GLU1
            *(u32x4*)(MERGED + (size_t)row * 1024 + j0) = pack8(o0, o1);
        }
#undef GLU_LD
    }
};
struct EpiOut { static constexpr bool PERM = true;
    const float* X; const float* MOD; bf16_t* T;
    __device__ __forceinline__ void operator()(const acc_t& acc, const pg8::Unit& u, int wr, int wc, int fr, int fq) const {
        asm volatile("" : "+v"(fr), "+v"(fq));
        const int row0 = u.pm * 256 + wr * 64 + fr, c0 = u.pn * 256 + wc * 32 + 8 * fq;
        const float* gpb = MOD + (size_t)(row0 >> 11) * 6144 + 2048 + c0;
        const f32x4 g00 = *(const f32x4*)gpb, g01 = *(const f32x4*)(gpb + 4), g10 = *(const f32x4*)(gpb + 128), g11 = *(const f32x4*)(gpb + 132);
#define OUT_LD(it_, X00, X01, X10, X11) do { const float* xp_ = X + (size_t)(row0 + ((it_) >> 2) * 128 + ((it_) & 3) * 16) * DM + c0; \
        X00 = *(const f32x4*)xp_; X01 = *(const f32x4*)(xp_ + 4); X10 = *(const f32x4*)(xp_ + 128); X11 = *(const f32x4*)(xp_ + 132); } while (0)
        f32x4 n00, n01, n10, n11; OUT_LD(0, n00, n01, n10, n11);
#pragma unroll
        for (int it = 0; it < 8; ++it) { const int ai = it >> 2, m = it & 3, row = row0 + ai * 128 + m * 16;
            const f32x4 x00 = n00, x01 = n01, x10 = n10, x11 = n11;
            if (it + 1 < 8) OUT_LD(it + 1, n00, n01, n10, n11);
            asm volatile("" ::: "memory");
            { const f32x4 t0 = x00 * ALPHA + g00 * acc[ai][0][m][0], t1 = x01 * ALPHA + g01 * acc[ai][0][m][1];
              u32x4 w; w.x = cvt_pk_bf16(t0[0], t0[1]); w.y = cvt_pk_bf16(t0[2], t0[3]); w.z = cvt_pk_bf16(t1[0], t1[1]); w.w = cvt_pk_bf16(t1[2], t1[3]);
              *(u32x4*)(T + (size_t)row * DM + c0) = w; }
            { const f32x4 t0 = x10 * ALPHA + g10 * acc[ai][1][m][0], t1 = x11 * ALPHA + g11 * acc[ai][1][m][1];
              u32x4 w; w.x = cvt_pk_bf16(t0[0], t0[1]); w.y = cvt_pk_bf16(t0[2], t0[3]); w.z = cvt_pk_bf16(t1[0], t1[1]); w.w = cvt_pk_bf16(t1[2], t1[3]);
              *(u32x4*)(T + (size_t)row * DM + c0 + 128) = w; }
        }
#undef OUT_LD
    }
};
struct EpiPQ { static constexpr bool PERM = true;
    bf16_t* PQ;
    __device__ __forceinline__ void operator()(const acc_t& acc, const pg8::Unit& u, int wr, int wc, int fr, int fq) const {
        asm volatile("" : "+v"(fr), "+v"(fq));
        const int row0 = u.pm * 256 + wr * 64 + fr;
#pragma unroll
        for (int ai = 0; ai < 2; ++ai)
#pragma unroll
            for (int m = 0; m < 4; ++m) { const int row = row0 + ai * 128 + m * 16;
#pragma unroll
                for (int bj = 0; bj < 2; ++bj) *(u32x4*)(PQ + (size_t)row * 2048 + u.pn * 256 + bj * 128 + wc * 32 + 8 * fq) = pack8(acc[ai][bj][m][0], acc[ai][bj][m][1]); }
    }
};

#define XB_TMO      128
#define XB_XCNT(j)  (256  + 64 * (j))
#define XB_XSUB(j)  (1280 + 64 * (j))
#define XB_XGEN(j)  (2304 + 64 * (j))
#define XB_TOP      3328
#define XB_TOPGEN   3392
#define XCD_BAR_WORDS 3456
#define XB_SPIN_CAP (1u << 22)
__device__ __forceinline__ unsigned xb_ld(unsigned* p)              { return __hip_atomic_load(p, __ATOMIC_RELAXED, __HIP_MEMORY_SCOPE_AGENT); }
__device__ __forceinline__ unsigned xb_add(unsigned* p, unsigned v) { return __hip_atomic_fetch_add(p, v, __ATOMIC_RELAXED, __HIP_MEMORY_SCOPE_AGENT); }
__device__ __forceinline__ unsigned xb_xcc_id() { return (unsigned)__builtin_amdgcn_s_getreg((3 << 11) | 20) & 0xFu; }
#define XB_SPIN(cond, bar) do { unsigned _sp = 0; while (cond) { __builtin_amdgcn_s_sleep(1); \
    if ((++_sp & 255u) == 0u) { if (xb_ld(&(bar)[XB_TMO])) break; if (_sp > XB_SPIN_CAP) { atomicAdd(&(bar)[XB_TMO], 1u); break; } } } } while (0)
struct XcdBarrier { unsigned* bar; unsigned x; volatile LAS unsigned* st; };
__device__ __forceinline__ XcdBarrier xcd_barrier_post(unsigned* bar, volatile LAS unsigned* st, int tid) {
    XcdBarrier b; b.bar = bar; b.x = xb_xcc_id(); b.st = st;
    if (tid == 0) (void)xb_add(&bar[XB_XCNT(b.x)], 1u);
    return b;
}
__device__ __forceinline__ void xcd_barrier_complete(unsigned* bar, unsigned x, unsigned& nloc, unsigned& nx) {
    const unsigned G = gridDim.x * gridDim.y * gridDim.z;
    unsigned sum, cnt, mine, sp = 0u;
    for (;;) {
        sum = 0u; cnt = 0u; mine = 0u;
#pragma unroll
        for (unsigned j = 0; j < 16; ++j) { const unsigned c = xb_ld(&bar[XB_XCNT(j)]); sum += c; cnt += (c > 0u) ? 1u : 0u; mine = (j == x) ? c : mine; }
        if (sum == G) break;
        __builtin_amdgcn_s_sleep(1);
        if ((++sp & 255u) == 0u) { if (xb_ld(&bar[XB_TMO])) break; if (sp > XB_SPIN_CAP) { atomicAdd(&bar[XB_TMO], 1u); break; } }
    }
    nloc = mine > 0u ? mine : 1u; nx = cnt > 0u ? cnt : 1u;
}
__device__ __forceinline__ void xcd_barrier(const XcdBarrier& b, int tid) {
    asm volatile("s_waitcnt vmcnt(0)" ::: "memory");
    __syncthreads();
    if (tid == 0) {
        unsigned* bar = b.bar;
        __builtin_amdgcn_s_waitcnt(0);
        unsigned nloc = b.st[0], nx = b.st[1];
        if (nloc == 0u) { xcd_barrier_complete(bar, b.x, nloc, nx); b.st[0] = nloc; b.st[1] = nx; }
        const unsigned old = xb_add(&bar[XB_XSUB(b.x)], 1u);
        const unsigned gen = old / nloc;
        if (old + 1u == (gen + 1u) * nloc) {
            __builtin_amdgcn_fence(__ATOMIC_RELEASE, "agent");
            asm volatile("s_waitcnt vmcnt(0)" ::: "memory");
            const unsigned og = xb_add(&bar[XB_TOP], 1u);
            const unsigned tg = og / nx;
            if (og + 1u == (tg + 1u) * nx) xb_add(&bar[XB_TOPGEN], 1u);
            else XB_SPIN(xb_ld(&bar[XB_TOPGEN]) == tg, bar);
            __builtin_amdgcn_fence(__ATOMIC_ACQUIRE, "agent");
            xb_add(&bar[XB_XGEN(b.x)], 1u);
            asm volatile("s_waitcnt vmcnt(0)" ::: "memory");
        } else {
            XB_SPIN(xb_ld(&bar[XB_XGEN(b.x)]) == gen, bar);
            __builtin_amdgcn_fence(__ATOMIC_ACQUIRE, "agent");
            asm volatile("s_waitcnt vmcnt(0)" ::: "memory");
        }
    }
    __syncthreads();
}

__device__ __forceinline__ void transpose_item(const float* W, int ldw, int k0, int nsrc0, bf16_t* WT, int ldt, int ndst0, const float* gk, LAS float* scr, int lane) {
    if (nsrc0 >= 0) {
#pragma unroll 8
        for (int i = 0; i < 32; ++i) { const int kk = 2 * i + (lane >> 5); float v = W[(size_t)(k0 + kk) * ldw + nsrc0 + (lane & 31)]; if (gk) v *= gk[k0 + kk]; scr[kk * 33 + (lane & 31)] = v; }
    } else {
#pragma unroll 8
        for (int i = 0; i < 32; ++i) { const int kk = 2 * i + (lane >> 5); scr[kk * 33 + (lane & 31)] = 0.f; }
    }
    LDS_WAIT(); asm volatile("" ::: "memory");
    const int c = lane & 7;
#pragma unroll
    for (int j = 0; j < 4; ++j) { const int n = (lane >> 3) + 8 * j; const LAS float* s = scr + (8 * c) * 33 + n;
        u32x4 o; o.x = cvt_pk_bf16(s[0 * 33], s[1 * 33]); o.y = cvt_pk_bf16(s[2 * 33], s[3 * 33]); o.z = cvt_pk_bf16(s[4 * 33], s[5 * 33]); o.w = cvt_pk_bf16(s[6 * 33], s[7 * 33]);
        *(u32x4*)(WT + (size_t)(ndst0 + n) * ldt + k0 + 8 * c) = o; }
    LDS_WAIT(); asm volatile("" ::: "memory");
}
__device__ __forceinline__ void modulate_row(const float* xrow, const float* sh, const float* sc, bf16_t* orow, int lane) {
    const f32x4* xr = (const f32x4*)xrow + lane; f32x4 v[4]; float s = 0.f;
#pragma unroll
    for (int j = 0; j < 4; ++j) { v[j] = xr[64 * j]; s += (v[j][0] + v[j][1]) + (v[j][2] + v[j][3]); }
    const float mean = wave_sum(s) * (1.f / DM); float s2 = 0.f;
#pragma unroll
    for (int j = 0; j < 4; ++j) { v[j] = v[j] - mean; s2 += (v[j][0] * v[j][0] + v[j][1] * v[j][1]) + (v[j][2] * v[j][2] + v[j][3] * v[j][3]); }
    const float rstd = rsqrtf(wave_sum(s2) * (1.f / DM) + LN_EPS);
    u32x2* o8 = (u32x2*)orow + lane;
#pragma unroll
    for (int j = 0; j < 4; ++j) { const f32x4 a = ((const f32x4*)sc)[64 * j + lane], b = ((const f32x4*)sh)[64 * j + lane]; const f32x4 y = v[j] * rstd * (a + 1.f) + b;
        u32x2 w; w.x = cvt_pk_bf16(y[0], y[1]); w.y = cvt_pk_bf16(y[2], y[3]); o8[64 * j] = w; }
}
__device__ __forceinline__ void modulate_row_r(f32x4 (&v)[4], const f32x4 (&a1)[4], const f32x4 (&bs)[4], bf16_t* orow, int lane) {
    float s = 0.f;
#pragma unroll
    for (int j = 0; j < 4; ++j) s += (v[j][0] + v[j][1]) + (v[j][2] + v[j][3]);
    const float mean = wave_sum(s) * (1.f / DM); float s2 = 0.f;
#pragma unroll
    for (int j = 0; j < 4; ++j) { v[j] = v[j] - mean; s2 += (v[j][0] * v[j][0] + v[j][1] * v[j][1]) + (v[j][2] * v[j][2] + v[j][3] * v[j][3]); }
    const float rstd = rsqrtf(wave_sum(s2) * (1.f / DM) + LN_EPS);
    u32x2* o8 = (u32x2*)orow + lane;
#pragma unroll
    for (int j = 0; j < 4; ++j) { const f32x4 y = v[j] * rstd * (a1[j] + 1.f) + bs[j]; u32x2 w; w.x = cvt_pk_bf16(y[0], y[1]); w.y = cvt_pk_bf16(y[2], y[3]); o8[64 * j] = w; }
}
__device__ __forceinline__ void modulate_row_v(f32x4 (&v)[4], const float* sh, const float* sc, bf16_t* orow, int lane) {
    float s = 0.f;
#pragma unroll
    for (int j = 0; j < 4; ++j) s += (v[j][0] + v[j][1]) + (v[j][2] + v[j][3]);
    const float mean = wave_sum(s) * (1.f / DM); float s2 = 0.f;
#pragma unroll
    for (int j = 0; j < 4; ++j) { v[j] = v[j] - mean; s2 += (v[j][0] * v[j][0] + v[j][1] * v[j][1]) + (v[j][2] * v[j][2] + v[j][3] * v[j][3]); }
    const float rstd = rsqrtf(wave_sum(s2) * (1.f / DM) + LN_EPS);
    u32x2* o8 = (u32x2*)orow + lane;
#pragma unroll
    for (int j = 0; j < 4; ++j) { const f32x4 a = ((const f32x4*)sc)[64 * j + lane], b = ((const f32x4*)sh)[64 * j + lane]; const f32x4 y = v[j] * rstd * (a + 1.f) + b;
        u32x2 w; w.x = cvt_pk_bf16(y[0], y[1]); w.y = cvt_pk_bf16(y[2], y[3]); o8[64 * j] = w; }
}
__device__ __forceinline__ void ln1_row(f32x4 (&v)[4], float* stat, const f32x4 (&g1v)[4], const f32x4 (&b1v)[4], const f32x4 (&a1)[4], const f32x4 (&bs)[4], bf16_t* orow, int lane) {
    float s = 0.f;
#pragma unroll
    for (int j = 0; j < 4; ++j) s += (v[j][0] + v[j][1]) + (v[j][2] + v[j][3]);
    float mean = wave_sum(s) * (1.f / DM); float s2 = 0.f;
#pragma unroll
    for (int j = 0; j < 4; ++j) { v[j] = v[j] - mean; s2 += (v[j][0] * v[j][0] + v[j][1] * v[j][1]) + (v[j][2] * v[j][2] + v[j][3] * v[j][3]); }
    float rstd = rsqrtf(wave_sum(s2) * (1.f / DM) + LN_EPS);
    s = 0.f;
    if (lane == 0) { stat[0] = mean; stat[1] = rstd; }
#pragma unroll
    for (int j = 0; j < 4; ++j) { v[j] = v[j] * rstd * g1v[j] + b1v[j]; s += (v[j][0] + v[j][1]) + (v[j][2] + v[j][3]); }
    mean = wave_sum(s) * (1.f / DM); s2 = 0.f;
#pragma unroll
    for (int j = 0; j < 4; ++j) { v[j] = v[j] - mean; s2 += (v[j][0] * v[j][0] + v[j][1] * v[j][1]) + (v[j][2] * v[j][2] + v[j][3] * v[j][3]); }
    rstd = rsqrtf(wave_sum(s2) * (1.f / DM) + LN_EPS);
    u32x2* o8 = (u32x2*)orow + lane;
#pragma unroll
    for (int j = 0; j < 4; ++j) { const f32x4 y = v[j] * rstd * (a1[j] + 1.f) + bs[j]; u32x2 w; w.x = cvt_pk_bf16(y[0], y[1]); w.y = cvt_pk_bf16(y[2], y[3]); o8[64 * j] = w; }
}

__device__ __forceinline__ int s5_row(int d, int b, int s) {
    if (d == 0) return (s < CTXL) ? (MLAT + b * CTXL + s) : (b * SEQ + (s - CTXL));
    return (s < CTXL) ? (MLAT + b * CTXL + (CTXL - 1 - s)) : (b * SEQ + (SEQ - 1 - (s - CTXL)));
}
typedef const LAS unsigned char* lds_cptr;
__device__ __forceinline__ s16x4 vtr(lds_cptr p) { return __builtin_bit_cast(s16x4, __builtin_amdgcn_ds_read_tr16_b64_v4i16((LAS v4i16_t*)p)); }
__device__ __forceinline__ void s5_passA(const bf16_t* __restrict__ SU, const float* __restrict__ ABAR, const bf16_t* __restrict__ BB, float* __restrict__ E, int unit, int lane) {
    asm volatile("" : "+v"(lane));
    const int rest = unit >> 2, j = rest & 7, bp = (rest >> 3) & 7, g = ((rest >> 6) & 7) * 4 + (unit & 3), d = rest >> 9;
    const int r = lane & 31, hA = lane >> 5;
    const int bA = 2 * bp + ((r >> 2) & 1), ti = (r & 3) + 4 * (r >> 3);
    const int s_begin = 256 * j, s_end = s_begin + 256;
    const bf16_t* bbp = BB + (size_t)((d * 32 + g) * 2) * 64 * 16;
    const bf16x8 bre0 = *(const bf16x8*)(bbp + (r * 16 + 8 * hA)), bre1 = *(const bf16x8*)(bbp + ((32 + r) * 16 + 8 * hA));
    const bf16x8 bim0 = *(const bf16x8*)(bbp + ((64 + r) * 16 + 8 * hA)), bim1 = *(const bf16x8*)(bbp + ((96 + r) * 16 + 8 * hA));
    const float* ab = ABAR + (size_t)(d * 32 + g) * 128;
    const float ar0 = ab[2 * r], ai0 = ab[2 * r + 1], ar1 = ab[2 * (32 + r)], ai1 = ab[2 * (32 + r) + 1];
    float hr0 = 0.f, hi0 = 0.f, hr1 = 0.f, hi1 = 0.f;
    bf16x8 ua = *(const bf16x8*)(SU + (size_t)s5_row(d, bA, s_begin + ti) * 512 + g * 16 + 8 * hA);
    for (int s0 = s_begin; s0 < s_end; s0 += 16) {
        const int sn = (s0 + 16 < s_end) ? s0 + 16 : s0;
        const bf16x8 un = *(const bf16x8*)(SU + (size_t)s5_row(d, bA, sn + ti) * 512 + g * 16 + 8 * hA);
        const f32x16 z = {};
        __builtin_amdgcn_sched_barrier(0);
        const f32x16 ur0 = MFMA32(ua, bre0, z), ur1 = MFMA32(ua, bre1, z), ui0 = MFMA32(ua, bim0, z), ui1 = MFMA32(ua, bim1, z);
        MFMA_PAD();
#pragma unroll
        for (int i = 0; i < 16; ++i) {
            const float nr0 = fmaf(ar0, hr0, fmaf(-ai0, hi0, ur0[i])), ni0 = fmaf(ar0, hi0, fmaf(ai0, hr0, ui0[i])); hr0 = nr0; hi0 = ni0;
            const float nr1 = fmaf(ar1, hr1, fmaf(-ai1, hi1, ur1[i])), ni1 = fmaf(ar1, hi1, fmaf(ai1, hr1, ui1[i])); hr1 = nr1; hi1 = ni1;
        }
        ua = un;
    }
    const int b = 2 * bp + (lane >> 5);
    float* e = E + (size_t)(((d * 32 + g) * 16 + b) * 8 + j) * 128;
    e[r] = hr0; e[32 + r] = hr1; e[64 + r] = hi0; e[96 + r] = hi1;
}
constexpr int S5_HT_PITCH = 80;
constexpr int S5_LDS_WAVE = 128 * S5_HT_PITCH;
__device__ __forceinline__ void s5_passB(const bf16_t* __restrict__ SU, const float* __restrict__ ABAR, const float* __restrict__ POW, const bf16_t* __restrict__ BB, const bf16_t* __restrict__ CM,
                                         const float* __restrict__ E, const float* __restrict__ DSK, bf16_t* Y, int unit, int lane, LAS unsigned char* ht) {
    asm volatile("" : "+v"(lane));
    const int k = (unit >> 2) & 7, bp = (unit >> 5) & 7, g = (unit >> 8) * 4 + (unit & 3);
    const int r = lane & 31, hA = lane >> 5;
    const int bA = 2 * bp + ((r >> 2) & 1), ti = (r & 3) + 4 * (r >> 3);
    const int bS = 2 * bp + hA;
    const int G4 = lane >> 4, q4 = (lane & 15) >> 2, p4 = lane & 3;
    const lds_cptr trb = (lds_cptr)ht + (8 * hA + q4) * S5_HT_PITCH + (16 * (G4 & 1) + 4 * p4) * 2;
    const int bO = 2 * bp + (r >> 4), tO = r & 15;
    const f32x4 d0 = *(const f32x4*)(DSK + g * 16 + 4 * hA), d1 = *(const f32x4*)(DSK + g * 16 + 8 + 4 * hA);
#pragma unroll 1
    for (int d = 0; d < 2; ++d) {
        const int j = d == 0 ? k : 7 - k;
        const int s_begin = CTXL + 256 * j, s_end = s_begin + 256;
        const bf16_t* bbp = BB + (size_t)((d * 32 + g) * 2) * 64 * 16;
        const bf16x8 bre0 = *(const bf16x8*)(bbp + (r * 16 + 8 * hA)), bre1 = *(const bf16x8*)(bbp + ((32 + r) * 16 + 8 * hA));
        const bf16x8 bim0 = *(const bf16x8*)(bbp + ((64 + r) * 16 + 8 * hA)), bim1 = *(const bf16x8*)(bbp + ((96 + r) * 16 + 8 * hA));
        const float* ab = ABAR + (size_t)(d * 32 + g) * 128;
        const float ar0 = ab[2 * r], ai0 = ab[2 * r + 1], ar1 = ab[2 * (32 + r)], ai1 = ab[2 * (32 + r) + 1];
        bf16x8 cm[8];
#pragma unroll
        for (int ks = 0; ks < 8; ++ks) { cm[ks] = (bf16x8){0, 0, 0, 0, 0, 0, 0, 0}; if (r < 16) cm[ks] = *(const bf16x8*)(CM + ((size_t)((d * 32 + g) * 16 + r) * 128 + 16 * ks + 8 * hA)); }
        float hr0 = 0.f, hi0 = 0.f, hr1 = 0.f, hi1 = 0.f;
        { const float* e = E + (size_t)(((d * 32 + g) * 16 + bS) * 8) * 128;
          const float* pw = POW + ((size_t)(d * 32 + g) * 64) * 2;
          const float pr0 = pw[2 * r], pi0 = pw[2 * r + 1], pr1 = pw[2 * (32 + r)], pi1 = pw[2 * (32 + r) + 1];
          float er0[8], er1[8], ei0[8], ei1[8];
#pragma unroll
          for (int jj = 0; jj < 8; ++jj) { er0[jj] = e[jj * 128 + r]; er1[jj] = e[jj * 128 + 32 + r]; ei0[jj] = e[jj * 128 + 64 + r]; ei1[jj] = e[jj * 128 + 96 + r]; }
#pragma unroll
          for (int jj = 0; jj < 8; ++jj) if (jj <= j) {
              const float nr0 = pr0 * hr0 - pi0 * hi0 + er0[jj], ni0 = pr0 * hi0 + pi0 * hr0 + ei0[jj]; hr0 = nr0; hi0 = ni0;
              const float nr1 = pr1 * hr1 - pi1 * hi1 + er1[jj], ni1 = pr1 * hi1 + pi1 * hr1 + ei1[jj]; hr1 = nr1; hi1 = ni1; } }
        bf16x8 ua = *(const bf16x8*)(SU + (size_t)s5_row(d, bA, s_begin + ti) * 512 + g * 16 + 8 * hA);
        for (int s0 = s_begin; s0 < s_end; s0 += 16) {
            const int sn = (s0 + 16 < s_end) ? s0 + 16 : s0;
            const bf16x8 un = *(const bf16x8*)(SU + (size_t)s5_row(d, bA, sn + ti) * 512 + g * 16 + 8 * hA);
            const f32x16 z = {};
            const int row = s5_row(d, bO, (s0 >= CTXL ? s0 : CTXL) + tO);
            const bf16_t* pre = (d == 0 ? SU : (const bf16_t*)Y) + (size_t)row * 512 + g * 16 + 4 * hA;
            const u32x2 pre0 = *(const u32x2*)pre, pre1 = *(const u32x2*)(pre + 8);
            __builtin_amdgcn_sched_barrier(0);
            f32x16 ur0 = MFMA32(ua, bre0, z), ur1 = MFMA32(ua, bre1, z), ui0 = MFMA32(ua, bim0, z), ui1 = MFMA32(ua, bim1, z);
            MFMA_PAD();
#pragma unroll
            for (int i = 0; i < 16; ++i) {
                const float nr0 = fmaf(ar0, hr0, fmaf(-ai0, hi0, ur0[i])), ni0 = fmaf(ar0, hi0, fmaf(ai0, hr0, ui0[i])); hr0 = nr0; hi0 = ni0; ur0[i] = nr0; ui0[i] = ni0;
                const float nr1 = fmaf(ar1, hr1, fmaf(-ai1, hi1, ur1[i])), ni1 = fmaf(ar1, hi1, fmaf(ai1, hr1, ui1[i])); hr1 = nr1; hi1 = ni1; ur1[i] = nr1; ui1[i] = ni1;
            }
            if (s0 >= CTXL) {
#define S5_WR(V, R) do { LAS unsigned char* wp = ht + (R) * S5_HT_PITCH + hA * 32; \
                    u32x4 w0, w1; w0.x = cvt_pk_bf16(V[0], V[1]); w0.y = cvt_pk_bf16(V[2], V[3]); w0.z = cvt_pk_bf16(V[4], V[5]); w0.w = cvt_pk_bf16(V[6], V[7]); \
                    w1.x = cvt_pk_bf16(V[8], V[9]); w1.y = cvt_pk_bf16(V[10], V[11]); w1.z = cvt_pk_bf16(V[12], V[13]); w1.w = cvt_pk_bf16(V[14], V[15]); \
                    *(LAS u32x4*)wp = w0; *(LAS u32x4*)(wp + 16) = w1; } while (0)
                S5_WR(ur0, r); S5_WR(ur1, 32 + r); S5_WR(ui0, 64 + r); S5_WR(ui1, 96 + r);
#undef S5_WR
                LDS_WAIT();
                f32x16 ya = {}, yb = {};
#pragma unroll
                for (int ks = 0; ks < 8; ++ks) {
                    const s16x4 lo = vtr(trb + (16 * ks) * S5_HT_PITCH), hi = vtr(trb + (16 * ks + 4) * S5_HT_PITCH);
                    const bf16x8 bfrag = (bf16x8){lo[0], lo[1], lo[2], lo[3], hi[0], hi[1], hi[2], hi[3]};
                    if (ks & 1) yb = MFMA32(cm[ks], bfrag, yb); else ya = MFMA32(cm[ks], bfrag, ya);
                }
                MFMA_PAD();
#pragma unroll
                for (int i = 0; i < 8; ++i) ya[i] += yb[i];
                bf16_t* yp = Y + (size_t)row * 512 + g * 16 + 4 * hA;
                if (d == 0) {
                    const u32x2 u0 = pre0, u1 = pre1;
                    u32x2 o0, o1;
                    o0.x = cvt_pk_bf16(ya[0] + d0[0] * bf_lo(u0.x), ya[1] + d0[1] * bf_hi(u0.x)); o0.y = cvt_pk_bf16(ya[2] + d0[2] * bf_lo(u0.y), ya[3] + d0[3] * bf_hi(u0.y));
                    o1.x = cvt_pk_bf16(ya[4] + d1[0] * bf_lo(u1.x), ya[5] + d1[1] * bf_hi(u1.x)); o1.y = cvt_pk_bf16(ya[6] + d1[2] * bf_lo(u1.y), ya[7] + d1[3] * bf_hi(u1.y));
                    *(u32x2*)yp = o0; *(u32x2*)(yp + 8) = o1;
                } else {
                    const u32x2 f0 = pre0, f1 = pre1;
                    u32x2 o0, o1;
                    o0.x = cvt_pk_bf16(gelu_tanh(ya[0] + bf_lo(f0.x)), gelu_tanh(ya[1] + bf_hi(f0.x))); o0.y = cvt_pk_bf16(gelu_tanh(ya[2] + bf_lo(f0.y)), gelu_tanh(ya[3] + bf_hi(f0.y)));
                    o1.x = cvt_pk_bf16(gelu_tanh(ya[4] + bf_lo(f1.x)), gelu_tanh(ya[5] + bf_hi(f1.x))); o1.y = cvt_pk_bf16(gelu_tanh(ya[6] + bf_lo(f1.y)), gelu_tanh(ya[7] + bf_hi(f1.y)));
                    *(u32x2*)yp = o0; *(u32x2*)(yp + 8) = o1;
                }
                LDS_WAIT();
            }
            ua = un;
        }
        VM_WAIT();
    }
}

namespace att {
constexpr int NW = 8, QBLK = 32, KVBLK = 64;
constexpr int SHM_V = KVBLK * 128 * 2, SHM_K = KVBLK * DK * 2;
constexpr int OFF_V = 0, OFF_K = 2 * SHM_V, OFF_WS = OFF_K + 2 * SHM_K, OFF_QPE = OFF_WS + NW * 64 * 4, LDS_BYTES = OFF_QPE + NW * 4096;
constexpr float THRL = 8.f * 1.4426950408889634f;
#define KSWZ(row, colB) ((row) * 384 + ((colB) ^ (((row) & 7) << 4)))
#define SBAR() __builtin_amdgcn_sched_barrier(0)
__device__ __forceinline__ int crow(int r, int hi) { return (r & 3) + 8 * (r >> 2) + 4 * hi; }
__device__ __forceinline__ void partialSM(f32x16& p0, f32x16& p1, float& m_reg, float& mn, float& alpha) {
    float pmax = p0[0];
#pragma unroll
    for (int r = 1; r < 16; ++r) pmax = fmaxf(pmax, p0[r]);
#pragma unroll
    for (int r = 0; r < 16; ++r) pmax = fmaxf(pmax, p1[r]);
    { auto rr = __builtin_amdgcn_permlane32_swap(__float_as_uint(pmax), __float_as_uint(pmax), false, false);
      pmax = fmaxf(__uint_as_float(rr[0]), __uint_as_float(rr[1])); }
    if (__builtin_expect(__all(pmax - m_reg <= THRL), 1)) { mn = m_reg; alpha = 1.f; }
    else { mn = fmaxf(m_reg, pmax); alpha = __builtin_amdgcn_exp2f(m_reg - mn); m_reg = mn; }
#pragma unroll
    for (int r = 0; r < 16; ++r) p0[r] = p0[r] - mn;
#pragma unroll
    for (int r = 0; r < 16; ++r) p1[r] = p1[r] - mn;
#pragma unroll
    for (int r = 0; r < 16; ++r) p0[r] = __builtin_amdgcn_exp2f(p0[r]);
}
__device__ __forceinline__ void finishSM(f32x16& p0, f32x16& p1, float alpha, float& l_reg, bf16x8& pa0, bf16x8& pa1, bf16x8& pa2, bf16x8& pa3) {
#pragma unroll
    for (int r = 0; r < 16; ++r) p1[r] = __builtin_amdgcn_exp2f(p1[r]);
    float ps = 0;
#pragma unroll
    for (int r = 0; r < 16; ++r) ps += p0[r];
#pragma unroll
    for (int r = 0; r < 16; ++r) ps += p1[r];
    { auto rr = __builtin_amdgcn_permlane32_swap(__float_as_uint(ps), __float_as_uint(ps), false, false);
      ps = __uint_as_float(rr[0]) + __uint_as_float(rr[1]); }
    l_reg = l_reg * alpha + ps;
#define PK4(P, BASE, OUT) do { unsigned a0 = cvt_pk_bf16(P[BASE + 0], P[BASE + 1]), a1 = cvt_pk_bf16(P[BASE + 2], P[BASE + 3]);   \
    unsigned b0 = cvt_pk_bf16(P[BASE + 4], P[BASE + 5]), b1 = cvt_pk_bf16(P[BASE + 6], P[BASE + 7]);                              \
    auto r0 = __builtin_amdgcn_permlane32_swap(a0, b0, false, false); auto r1 = __builtin_amdgcn_permlane32_swap(a1, b1, false, false); \
    u32x4 w = {r0[0], r1[0], r0[1], r1[1]}; OUT = *reinterpret_cast<bf16x8*>(&w); } while (0)
    PK4(p0, 0, pa0); PK4(p0, 8, pa1); PK4(p1, 0, pa2); PK4(p1, 8, pa3);
#undef PK4
}
__device__ __forceinline__ void qkt(f32x16& p0, f32x16& p1, const char* Ks, const bf16x8* qr, const char* qpe, int r32, int hi) {
    p0 = f32x16{}; p1 = f32x16{};
#pragma unroll
    for (int d0 = 0; d0 < 12; ++d0) { const int cb = (d0 * 16 + hi * 8) * 2;
        const bf16x8 b0 = *reinterpret_cast<const bf16x8*>(Ks + KSWZ(r32, cb));
        const bf16x8 b1 = *reinterpret_cast<const bf16x8*>(Ks + KSWZ(32 + r32, cb));
        const bf16x8 q = d0 < 8 ? qr[d0 < 8 ? d0 : 0] : *reinterpret_cast<const bf16x8*>(qpe + (d0 - 8) * 1024);
        p0 = MFMA32(b0, q, p0);
        p1 = MFMA32(b1, q, p1); }
}
__device__ __forceinline__ int v_st(int k, int c) { const int kk = (k & ~0xC) | ((k & 4) << 1) | ((k & 8) >> 1); return ((kk >> 3) * 4 + (c >> 5)) * 512 + ((kk & 7) * 32 + (c & 31)) * 2; }
__device__ __forceinline__ int v_rd_base(int lane) { return ((lane & 3) << 3) | (((lane >> 2) & 3) << 6) | (((lane >> 4) & 1) << 5) | (((lane >> 5) & 1) << 8); }
constexpr int v_rd_off(int d0, int ks, int half) { return d0 * 512 + ks * 4096 + half * 2048; }
template <int OFF> __device__ __forceinline__ s16x4 tr_read(int vb) {
    s16x4 r; asm volatile("ds_read_b64_tr_b16 %0, %1 offset:%2" : "=&v"(r) : "v"(vb), "i"(OFF) : "memory"); return r;
}
template <int D0> __device__ __forceinline__ void pv_one(f32x16& od, int vb, bf16x8 pa0, bf16x8 pa1, bf16x8 pa2, bf16x8 pa3) {
    const s16x4 l0 = tr_read<v_rd_off(D0, 0, 0)>(vb), h0 = tr_read<v_rd_off(D0, 0, 1)>(vb), l1 = tr_read<v_rd_off(D0, 1, 0)>(vb), h1 = tr_read<v_rd_off(D0, 1, 1)>(vb);
    const s16x4 l2 = tr_read<v_rd_off(D0, 2, 0)>(vb), h2 = tr_read<v_rd_off(D0, 2, 1)>(vb), l3 = tr_read<v_rd_off(D0, 3, 0)>(vb), h3 = tr_read<v_rd_off(D0, 3, 1)>(vb);
    asm volatile("s_waitcnt lgkmcnt(0)" ::: "memory"); SBAR();
#define PK(L, H) (bf16x8){L[0], L[1], L[2], L[3], H[0], H[1], H[2], H[3]}
    od = MFMA32(pa0, PK(l0, h0), od);
    od = MFMA32(pa1, PK(l1, h1), od);
    od = MFMA32(pa2, PK(l2, h2), od);
    od = MFMA32(pa3, PK(l3, h3), od);
#undef PK
}
__device__ __forceinline__ void pv_d0(f32x16* o, int vb, bf16x8 pa0, bf16x8 pa1, bf16x8 pa2, bf16x8 pa3) {
    pv_one<0>(o[0], vb, pa0, pa1, pa2, pa3); pv_one<1>(o[1], vb, pa0, pa1, pa2, pa3); pv_one<2>(o[2], vb, pa0, pa1, pa2, pa3); pv_one<3>(o[3], vb, pa0, pa1, pa2, pa3);
}
__device__ __forceinline__ void attn_unit(bf16_t* Qu, const bf16_t* __restrict__ Kh, const bf16_t* __restrict__ Pb, const bf16_t* __restrict__ Vh, const bf16_t* __restrict__ Gm, const float* __restrict__ ROPEt, int l0, char* lds, int tid_) {
    asm volatile("" : "+v"(tid_));
    const int tid = tid_, wid = __builtin_amdgcn_readfirstlane(tid >> 6), lane = tid & 63, r32 = lane & 31, hi = lane >> 5;
    char* V_lds = lds + OFF_V; char* K_lds = lds + OFF_K;
    float* ws = (float*)(lds + OFF_WS) + wid * 64; float* li_l = ws; float* al_l = ws + 32;
    float m_reg = -1e30f, l_reg = 0; f32x16 o[4] = {}; bf16x8 qr[8]; char* qpe = lds + OFF_QPE + wid * 4096 + lane * 16;
    const bf16_t* Qw = Qu + (size_t)(wid * QBLK + r32) * DK + hi * 8;
#pragma unroll
    for (int d0 = 0; d0 < 8; ++d0) qr[d0] = *reinterpret_cast<const bf16x8*>(Qw + d0 * 16);
    { const int l = l0 + wid * QBLK + r32;
#pragma unroll
      for (int part = 0; part < 2; ++part) { const int pos = part == 0 ? (l >> 6) : (l & 63);
          const u32x4 x1 = *reinterpret_cast<const u32x4*>(Qw + (8 + 2 * part) * 16), x2 = *reinterpret_cast<const u32x4*>(Qw + (9 + 2 * part) * 16);
          const f32x4* tp = (const f32x4*)(ROPEt + (size_t)pos * 32 + hi * 16); const f32x4 t0 = tp[0], t1 = tp[1], t2 = tp[2], t3 = tp[3];
          u32x4 o1, o2;
#define ROT2(X1, X2, T, O1, O2) { const float a0 = bf_lo(X1), a1 = bf_hi(X1), b0 = bf_lo(X2), b1 = bf_hi(X2); \
          O1 = cvt_pk_bf16(a0 * T[0] - b0 * T[1], a1 * T[2] - b1 * T[3]); O2 = cvt_pk_bf16(b0 * T[0] + a0 * T[1], b1 * T[2] + a1 * T[3]); }
          ROT2(x1.x, x2.x, t0, o1.x, o2.x) ROT2(x1.y, x2.y, t1, o1.y, o2.y) ROT2(x1.z, x2.z, t2, o1.z, o2.z) ROT2(x1.w, x2.w, t3, o1.w, o2.w)
#undef ROT2
          *reinterpret_cast<u32x4*>(qpe + (2 * part) * 1024) = o1; *reinterpret_cast<u32x4*>(qpe + (2 * part + 1) * 1024) = o2; } }
    const int sr = tid >> 4, sc = (tid & 15) * 8, vst0 = v_st(sr, sc), vst1 = v_st(32 + sr, sc);
    const int pr = tid >> 3, pc = (tid & 7) * 8;
    const int vb0 = (int)(uintptr_t)V_lds + v_rd_base(lane);
    bf16x8 vs0, vs1, ks0, ks1, ps0;
    const unsigned go0 = (unsigned)(sr * 128 + sc) * 2u, go1 = go0 + 8192u, go2 = (unsigned)(pr * 64 + pc) * 2u;
#define SLOAD(k0) do { const char* vt_ = (const char*)Vh + (size_t)(k0) * 256; const char* kt_ = (const char*)Kh + (size_t)(k0) * 256; const char* pt_ = (const char*)Pb + (size_t)(k0) * 128; \
    vs0 = *(const bf16x8*)(vt_ + go0); vs1 = *(const bf16x8*)(vt_ + go1); ks0 = *(const bf16x8*)(kt_ + go0); ks1 = *(const bf16x8*)(kt_ + go1); \
    ps0 = *(const bf16x8*)(pt_ + go2); } while (0)
#define SWRITE(b) do { *(bf16x8*)(V_lds + (b) * SHM_V + vst0) = vs0; *(bf16x8*)(V_lds + (b) * SHM_V + vst1) = vs1; const int kc = sc * 2;  \
    *(bf16x8*)(K_lds + (b) * SHM_K + KSWZ(sr, kc)) = ks0; *(bf16x8*)(K_lds + (b) * SHM_K + KSWZ(32 + sr, kc)) = ks1;                       \
    *(bf16x8*)(K_lds + (b) * SHM_K + KSWZ(pr, 256 + pc * 2)) = ps0; } while (0)
#define SWAIT() asm volatile("s_waitcnt vmcnt(0)" ::: "memory")
#define RESC(a) do { if (__any((a) < 1.f)) { if (hi == 0) al_l[r32] = (a); asm volatile("s_waitcnt lgkmcnt(0)" ::: "memory"); \
    _Pragma("unroll") for (int d = 0; d < 4; ++d) _Pragma("unroll") for (int r = 0; r < 16; ++r) o[d][r] *= al_l[crow(r, hi)]; } } while (0)
    f32x16 pA0, pA1, pB0, pB1; float mnA, mnB, alA, alB; bf16x8 pa0, pa1, pa2, pa3; constexpr int NT = NKEY / KVBLK;
    SLOAD(0); SWAIT(); SWRITE(0); __syncthreads();
    qkt(pA0, pA1, K_lds, qr, qpe, r32, hi); partialSM(pA0, pA1, m_reg, mnA, alA);
    SLOAD(KVBLK);
    SWAIT(); SWRITE(1); __syncthreads();
    for (int j = 1; j + 1 < NT; j += 2) {
        SBAR(); qkt(pB0, pB1, K_lds + SHM_K, qr, qpe, r32, hi);
        finishSM(pA0, pA1, alA, l_reg, pa0, pa1, pa2, pa3); SBAR();
        SLOAD((j + 1) * KVBLK); SBAR();
        pv_d0(o, vb0, pa0, pa1, pa2, pa3); partialSM(pB0, pB1, m_reg, mnB, alB);
        __syncthreads(); SWAIT(); SWRITE(0);
        RESC(alB); __syncthreads();
        SBAR(); qkt(pA0, pA1, K_lds, qr, qpe, r32, hi);
        finishSM(pB0, pB1, alB, l_reg, pa0, pa1, pa2, pa3); SBAR();
        SLOAD((j + 2) * KVBLK); SBAR();
        pv_d0(o, vb0 + SHM_V, pa0, pa1, pa2, pa3); partialSM(pA0, pA1, m_reg, mnA, alA);
        __syncthreads(); SWAIT(); SWRITE(1);
        RESC(alA); __syncthreads();
    }
    SBAR(); qkt(pB0, pB1, K_lds + SHM_K, qr, qpe, r32, hi);
    finishSM(pA0, pA1, alA, l_reg, pa0, pa1, pa2, pa3); SBAR();
    pv_d0(o, vb0, pa0, pa1, pa2, pa3); partialSM(pB0, pB1, m_reg, mnB, alB);
    __syncthreads(); RESC(alB);
    finishSM(pB0, pB1, alB, l_reg, pa0, pa1, pa2, pa3); SBAR();
    pv_d0(o, vb0 + SHM_V, pa0, pa1, pa2, pa3);
    u32x4 gv[8];
    { const bf16_t* Gw = Gm + (size_t)(wid * QBLK) * 2048;
#pragma unroll
      for (int it = 0; it < 8; ++it) { const int idx = it * 64 + lane, row = idx >> 4, ch = idx & 15; gv[it] = *(const u32x4*)(Gw + (size_t)row * 2048 + ch * 8); } }
    if (hi == 0) li_l[r32] = l_reg; asm volatile("s_waitcnt lgkmcnt(0)" ::: "memory");
    __syncthreads();
    { char* ot = lds + wid * (32 * 272);
#pragma unroll
      for (int r = 0; r < 16; ++r) { const int orow = crow(r, hi); const float rl = __builtin_amdgcn_rcpf(li_l[orow]);
#pragma unroll
          for (int d0 = 0; d0 < 4; ++d0) *(bf16_t*)(ot + orow * 272 + (d0 * 32 + r32) * 2) = (bf16_t)(cvt_pk_bf16(o[d0][r] * rl, 0.f) & 0xffffu); }
      asm volatile("s_waitcnt lgkmcnt(0)" ::: "memory");
      bf16_t* Ow = Qu + (size_t)(wid * QBLK) * 128;
#pragma unroll
      for (int it = 0; it < 8; ++it) { const int idx = it * 64 + lane, row = idx >> 4, ch = idx & 15;
          const u32x4 ov = *(const u32x4*)(ot + row * 272 + ch * 16); const u32x4 g4 = gv[it];
          u32x4 w; w.x = cvt_pk_bf16(bf_lo(ov.x) * bf_lo(g4.x), bf_hi(ov.x) * bf_hi(g4.x)); w.y = cvt_pk_bf16(bf_lo(ov.y) * bf_lo(g4.y), bf_hi(ov.y) * bf_hi(g4.y));
          w.z = cvt_pk_bf16(bf_lo(ov.z) * bf_lo(g4.z), bf_hi(ov.z) * bf_hi(g4.z)); w.w = cvt_pk_bf16(bf_lo(ov.w) * bf_lo(g4.w), bf_hi(ov.w) * bf_hi(g4.w));
          *(u32x4*)(Ow + (size_t)row * 128 + ch * 8) = w; } }
    __syncthreads();
#undef SLOAD
#undef SWRITE
#undef SWAIT
#undef RESC
}
#undef KSWZ
#undef SBAR
}


namespace peer {
__device__ __forceinline__ int f2key(float f) { const int b = __builtin_bit_cast(int, f); return b ^ ((b >> 31) & 0x7fffffff); }
__device__ __forceinline__ float key2f(int k) { return __builtin_bit_cast(float, k ^ ((k >> 31) & 0x7fffffff)); }
__device__ __forceinline__ void ce_desc(int& a, int& b) { const int hi = a > b ? a : b, lo = a > b ? b : a; a = hi; b = lo; }
__device__ __forceinline__ void sort16_desc(int (&v)[16]) {
#pragma unroll
    for (int k = 2; k <= 16; k <<= 1)
#pragma unroll
        for (int j = k >> 1; j > 0; j >>= 1)
#pragma unroll
            for (int i = 0; i < 16; ++i) { const int l = i ^ j; if (l > i) { if ((i & k) == 0) ce_desc(v[i], v[l]); else ce_desc(v[l], v[i]); } }
}
__device__ __forceinline__ void merge_top16(int (&a)[16], const int (&b)[16]) {
#pragma unroll
    for (int i = 0; i < 16; ++i) a[i] = a[i] > b[15 - i] ? a[i] : b[15 - i];
#pragma unroll
    for (int j = 8; j > 0; j >>= 1)
#pragma unroll
        for (int i = 0; i < 16; ++i) { const int l = i ^ j; if (l > i) ce_desc(a[i], a[l]); }
}
__device__ __forceinline__ int lut16(const int (&P)[4], int a) { const int s = a >> 2; const int v = (P[0] & -(int)(s == 0)) | (P[1] & -(int)(s == 1)) | (P[2] & -(int)(s == 2)) | (P[3] & -(int)(s == 3)); return (v >> (8 * (a & 3))) & 127; }
constexpr int KSW_BYTES = 2 * 128 * 256;
__device__ __forceinline__ int ksw(int z, int key, int colB) { return (z * 128 + key) * 256 + (colB ^ ((key & 7) << 4)); }

__device__ constexpr int G2A[16] = {1, 1, 1, 1, 1, 1, 1, 2, 2, 2, 2, 3, 3, 3, 4, 4}, G2B[16] = {1, 2, 3, 4, 5, 6, 7, 1, 2, 3, 4, 1, 2, 3, 1, 2};
__device__ constexpr int G3A[3] = {5, 6, 7}, G3B[3] = {1, 1, 1};

__device__ __forceinline__ void route_unit(const bf16_t* __restrict__ PQ, const char* KL, unsigned* __restrict__ RIDX, float* __restrict__ RW, int tok0, int h, int lane) {
    const int r32 = lane & 31, hi = lane >> 5;
    int X[2][16];
#pragma unroll
    for (int z = 0; z < 2; ++z) {
        bf16x8 qf[8];
        const bf16_t* qp = PQ + (size_t)(tok0 + r32) * 2048 + h * 256 + z * 128 + hi * 8;
#pragma unroll
        for (int ks = 0; ks < 8; ++ks) qf[ks] = *(const bf16x8*)(qp + ks * 16);
        f32x16 acc[4];
#pragma unroll
        for (int kt = 0; kt < 4; ++kt) { acc[kt] = f32x16{};
#pragma unroll
            for (int ks = 0; ks < 8; ++ks) { const bf16x8 kf = *(const bf16x8*)(KL + ksw(z, kt * 32 + r32, (ks * 16 + hi * 8) * 2)); acc[kt] = MFMA32(kf, qf[ks], acc[kt]); } }
        MFMA_PAD();
        int g0[16], g1[16];
#pragma unroll
        for (int half = 0; half < 2; ++half) {
#pragma unroll
            for (int i = 0; i < 16; ++i) { g0[i] = (f2key(acc[2 * half][i]) & ~127) | (64 * half + (i & 3) + 8 * (i >> 2) + 4 * hi);
                                           g1[i] = (f2key(acc[2 * half + 1][i]) & ~127) | (64 * half + 32 + (i & 3) + 8 * (i >> 2) + 4 * hi); }
            sort16_desc(g0); sort16_desc(g1); merge_top16(g0, g1);
            if (half == 0) {
#pragma unroll
                for (int i = 0; i < 16; ++i) X[z][i] = g0[i];
            } else merge_top16(X[z], g0);
        }
    }
    int T0[16], T1[16];
    { int P[16];
#pragma unroll
      for (int i = 0; i < 16; ++i) { auto rr = __builtin_amdgcn_permlane32_swap((unsigned)X[0][i], (unsigned)X[1][i], false, false); T0[i] = (int)rr[0]; P[i] = (int)rr[1]; }
      merge_top16(T0, P);
#pragma unroll
      for (int i = 0; i < 16; ++i) { auto rr = __builtin_amdgcn_permlane32_swap((unsigned)T0[i], (unsigned)T0[i], false, false); T0[i] = (int)rr[0]; T1[i] = (int)rr[1]; } }
    float f0[16], f1[16]; int I0[4] = {0, 0, 0, 0}, I1[4] = {0, 0, 0, 0};
#pragma unroll
    for (int a = 0; a < 16; ++a) { f0[a] = key2f(T0[a] & ~127); f1[a] = key2f(T1[a] & ~127); I0[a >> 2] |= (T0[a] & 127) << (8 * (a & 3)); I1[a >> 2] |= (T1[a] & 127) << (8 * (a & 3)); }
    int C0[16], C1[16], C2[16], C3[16];
#pragma unroll
    for (int b = 0; b < 16; ++b) C0[b] = (f2key(f0[0] + f1[b]) & ~255) | b;
#pragma unroll
    for (int a = 1; a < 16; ++a) C1[a - 1] = (f2key(f0[a] + f1[0]) & ~255) | (a << 4);
    C1[15] = (int)0x80000000;
#pragma unroll
    for (int c = 0; c < 16; ++c) C2[c] = (f2key(f0[G2A[c]] + f1[G2B[c]]) & ~255) | (G2A[c] << 4) | G2B[c];
#pragma unroll
    for (int c = 0; c < 16; ++c) C3[c] = (int)0x80000000;
#pragma unroll
    for (int c = 0; c < 3; ++c) C3[c] = (f2key(f0[G3A[c]] + f1[G3B[c]]) & ~255) | (G3A[c] << 4) | G3B[c];
    ce_desc(C3[0], C3[1]); ce_desc(C3[1], C3[2]); ce_desc(C3[0], C3[1]);
    sort16_desc(C2);
    merge_top16(C0, C1); merge_top16(C2, C3); merge_top16(C0, C2);
    float sc[16]; float ssum = 0.f; const float smax = key2f(C0[0] & ~255);
#pragma unroll
    for (int k = 0; k < 16; ++k) { sc[k] = __expf(key2f(C0[k] & ~255) - smax); ssum += sc[k]; }
    const float rs = __builtin_amdgcn_rcpf(ssum);
    {
        unsigned* ip = RIDX + (size_t)(tok0 + r32) * 128 + h * 16; float* wp = RW + (size_t)(tok0 + r32) * 128 + h * 16;
#pragma unroll
        for (int k4 = 0; k4 < 4; ++k4) { u32x4 iv; f32x4 wv;
#pragma unroll
            for (int e = 0; e < 4; ++e) { const int k = 4 * k4 + e, ab = C0[k] & 255; iv[e] = (unsigned)(lut16(I0, ab >> 4) * 128 + lut16(I1, ab & 15)); wv[e] = sc[k] * rs; }
            *(u32x4*)(ip + 4 * k4) = iv; *(f32x4*)(wp + 4 * k4) = wv; }
    }
}

constexpr float PU_SCALE = 256.f, PV_SCALE = 16.f;
#define DPP_ADD(s, ctrl) s += __builtin_bit_cast(float, __builtin_amdgcn_update_dpp(0, __builtin_bit_cast(int, s), ctrl, 0xF, 0xF, true))
__device__ __forceinline__ void acc16_fp8(const u32x4 w, const float a, float (&f)[16]) {
    const f32x2 a0 = __builtin_amdgcn_cvt_pk_f32_fp8((int)w.x, false), a1 = __builtin_amdgcn_cvt_pk_f32_fp8((int)w.x, true), a2 = __builtin_amdgcn_cvt_pk_f32_fp8((int)w.y, false), a3 = __builtin_amdgcn_cvt_pk_f32_fp8((int)w.y, true);
    const f32x2 a4 = __builtin_amdgcn_cvt_pk_f32_fp8((int)w.z, false), a5 = __builtin_amdgcn_cvt_pk_f32_fp8((int)w.z, true), a6 = __builtin_amdgcn_cvt_pk_f32_fp8((int)w.w, false), a7 = __builtin_amdgcn_cvt_pk_f32_fp8((int)w.w, true);
    f[0] = fmaf(a, a0[0], f[0]); f[1] = fmaf(a, a0[1], f[1]); f[2] = fmaf(a, a1[0], f[2]); f[3] = fmaf(a, a1[1], f[3]); f[4] = fmaf(a, a2[0], f[4]); f[5] = fmaf(a, a2[1], f[5]); f[6] = fmaf(a, a3[0], f[6]); f[7] = fmaf(a, a3[1], f[7]);
    f[8] = fmaf(a, a4[0], f[8]); f[9] = fmaf(a, a4[1], f[9]); f[10] = fmaf(a, a5[0], f[10]); f[11] = fmaf(a, a5[1], f[11]); f[12] = fmaf(a, a6[0], f[12]); f[13] = fmaf(a, a6[1], f[13]); f[14] = fmaf(a, a7[0], f[14]); f[15] = fmaf(a, a7[1], f[15]);
}
constexpr int TOK_PER_WAVE = 4;
constexpr int LIST_BYTES = 128 * 8, TOKLDS_BYTES = LIST_BYTES + 512;
__device__ __forceinline__ void bucket_token(const unsigned i0, const unsigned i1, const float w0, const float w1, LAS unsigned char* tl, int lane) {
    LAS unsigned* hist = (LAS unsigned*)(tl + LIST_BYTES); LAS unsigned* ent = (LAS unsigned*)tl; LAS float* wt = (LAS float*)(tl + 512);
    hist[lane] = 0u; hist[64 + lane] = 0u;
    LDS_WAIT();
    const unsigned r0 = __hip_atomic_fetch_add(hist + (i0 >> 7), 1u, __ATOMIC_RELAXED, __HIP_MEMORY_SCOPE_WORKGROUP);
    const unsigned r1 = __hip_atomic_fetch_add(hist + (i1 >> 7), 1u, __ATOMIC_RELAXED, __HIP_MEMORY_SCOPE_WORKGROUP);
    LDS_WAIT();
    const unsigned c0 = hist[2 * lane], c1 = hist[2 * lane + 1], tot = c0 + c1;
    unsigned incl = tot;
#pragma unroll
    for (int d = 1; d < 64; d <<= 1) { const unsigned o = (unsigned)__shfl_up((int)incl, d); if (lane >= d) incl += o; }
    LDS_WAIT();
    hist[2 * lane] = incl - tot; hist[2 * lane + 1] = incl - tot + c0;
    LDS_WAIT();
    { const unsigned p = hist[i0 >> 7] + r0; ent[p] = i0; wt[p] = w0; }
    { const unsigned p = hist[i1 >> 7] + r1; ent[p] = i1; wt[p] = w1; }
}
constexpr float X_SCALE = 16.f;
constexpr int XOP_BYTES = 2048, DESC_MAX = 128;
constexpr int WAVE_LDS = TOK_PER_WAVE * TOKLDS_BYTES + TOK_PER_WAVE * XOP_BYTES + DESC_MAX * 4;
__device__ __forceinline__ float sat8(float v) { return fminf(fmaxf(v, -440.f), 440.f); }
__device__ __forceinline__ void xop_store(const u32x4 x0, const u32x4 x1, LAS unsigned char* xo, int lane) {
    float x[16];
    x[0] = bf_lo(x0.x); x[1] = bf_hi(x0.x); x[2] = bf_lo(x0.y); x[3] = bf_hi(x0.y); x[4] = bf_lo(x0.z); x[5] = bf_hi(x0.z); x[6] = bf_lo(x0.w); x[7] = bf_hi(x0.w);
    x[8] = bf_lo(x1.x); x[9] = bf_hi(x1.x); x[10] = bf_lo(x1.y); x[11] = bf_hi(x1.y); x[12] = bf_lo(x1.z); x[13] = bf_hi(x1.z); x[14] = bf_lo(x1.w); x[15] = bf_hi(x1.w);
    u32x4 hi, lo;
#pragma unroll
    for (int d = 0; d < 4; ++d) {
        const float a0 = sat8(x[4 * d] * X_SCALE), a1 = sat8(x[4 * d + 1] * X_SCALE), a2 = sat8(x[4 * d + 2] * X_SCALE), a3 = sat8(x[4 * d + 3] * X_SCALE);
        int h = __builtin_amdgcn_cvt_pk_fp8_f32(a0, a1, 0, false); h = __builtin_amdgcn_cvt_pk_fp8_f32(a2, a3, h, true);
        const f32x2 b0 = __builtin_amdgcn_cvt_pk_f32_fp8(h, false), b1 = __builtin_amdgcn_cvt_pk_f32_fp8(h, true);
        int l = __builtin_amdgcn_cvt_pk_fp8_f32(a0 - b0[0], a1 - b0[1], 0, false); l = __builtin_amdgcn_cvt_pk_fp8_f32(a2 - b1[0], a3 - b1[1], l, true);
        hi[d] = (unsigned)h; lo[d] = (unsigned)l; }
    *(LAS u32x4*)(xo + 16 * lane) = hi; *(LAS u32x4*)(xo + 1024 + 16 * lane) = lo;
}
__device__ __forceinline__ void build_recs(LAS unsigned char* wl, int lane) {
    LAS unsigned* hist = (LAS unsigned*)(wl + LIST_BYTES);
    const int q0 = lane, q1 = lane + 64;
    const LAS unsigned* l0 = (const LAS unsigned*)(wl + (q0 >> 5) * TOKLDS_BYTES) + 4 * (q0 & 31); const LAS unsigned* l1 = (const LAS unsigned*)(wl + (q1 >> 5) * TOKLDS_BYTES) + 4 * (q1 & 31);
    const u32x4 ea = *(const LAS u32x4*)l0, wa = *(const LAS u32x4*)(l0 + 128), eb = *(const LAS u32x4*)l1, wb = *(const LAS u32x4*)(l1 + 128);
    const unsigned k0 = ea.x >> 7, k1 = eb.x >> 7;
    LDS_WAIT();
    hist[lane] = 0u; hist[64 + lane] = 0u;
    LDS_WAIT();
    const unsigned r0 = __hip_atomic_fetch_add(hist + k0, 1u, __ATOMIC_RELAXED, __HIP_MEMORY_SCOPE_WORKGROUP);
    const unsigned r1 = __hip_atomic_fetch_add(hist + k1, 1u, __ATOMIC_RELAXED, __HIP_MEMORY_SCOPE_WORKGROUP);
    LDS_WAIT();
    const unsigned c0 = hist[2 * lane], c1 = hist[2 * lane + 1], tot = c0 + c1;
    unsigned incl = tot;
#pragma unroll
    for (int d = 1; d < 64; d <<= 1) { const unsigned o = (unsigned)__shfl_up((int)incl, d); if (lane >= d) incl += o; }
    LDS_WAIT();
    hist[2 * lane] = incl - tot; hist[2 * lane + 1] = incl - tot + c0;
    LDS_WAIT();
    const unsigned p0 = hist[k0] + r0, p1 = hist[k1] + r1;
    LDS_WAIT();
    { LAS u32x4* rc = (LAS u32x4*)(wl + 32 * p0); rc[0] = (u32x4){ea.x | ((unsigned)(q0 >> 5) << 14) | (ea.y << 16), ea.z | (ea.w << 16), 0u, 0u}; rc[1] = wa; }
    { LAS u32x4* rc = (LAS u32x4*)(wl + 32 * p1); rc[0] = (u32x4){eb.x | ((unsigned)(q1 >> 5) << 14) | (eb.y << 16), eb.z | (eb.w << 16), 0u, 0u}; rc[1] = wb; }
}
__device__ __forceinline__ long pk64(unsigned lo, unsigned hi) { return (long)(((unsigned long long)hi << 32) | (unsigned long long)lo); }
#define MFMA_FP8(a, b, c) __builtin_amdgcn_mfma_f32_16x16x32_fp8_fp8(a, b, c, 0, 0, 0)
__device__ __forceinline__ void sweep_compute(const u32x4 u0, const u32x4 u1, const u32x4 u2, const u32x4 u3, const u32x4 v0, const u32x4 v1, const u32x4 v2, const u32x4 v3,
                                              const float g, const int tok, const u32x4 xh, const u32x4 xo, float (&f0)[16], float (&f1)[16], float (&f2)[16], float (&f3)[16], int lane, const f32x4 wsel) {
    const long xa = pk64(xh.x, xh.y), xb = pk64(xh.z, xh.w), xc = pk64(xo.x, xo.y), xd = pk64(xo.z, xo.w);
    f32x4 c0 = {0.f, 0.f, 0.f, 0.f}, c1 = c0, c2 = c0, c3 = c0;
    c0 = MFMA_FP8(pk64(u0.x, u0.y), xa, c0); c1 = MFMA_FP8(pk64(u1.x, u1.y), xa, c1); c2 = MFMA_FP8(pk64(u2.x, u2.y), xa, c2); c3 = MFMA_FP8(pk64(u3.x, u3.y), xa, c3);
    c0 = MFMA_FP8(pk64(u0.z, u0.w), xb, c0); c1 = MFMA_FP8(pk64(u1.z, u1.w), xb, c1); c2 = MFMA_FP8(pk64(u2.z, u2.w), xb, c2); c3 = MFMA_FP8(pk64(u3.z, u3.w), xb, c3);
    c0 = MFMA_FP8(pk64(u0.x, u0.y), xc, c0); c1 = MFMA_FP8(pk64(u1.x, u1.y), xc, c1); c2 = MFMA_FP8(pk64(u2.x, u2.y), xc, c2); c3 = MFMA_FP8(pk64(u3.x, u3.y), xc, c3);
    c0 = MFMA_FP8(pk64(u0.z, u0.w), xd, c0); c1 = MFMA_FP8(pk64(u1.z, u1.w), xd, c1); c2 = MFMA_FP8(pk64(u2.z, u2.w), xd, c2); c3 = MFMA_FP8(pk64(u3.z, u3.w), xd, c3);
    __builtin_amdgcn_sched_barrier(0); asm volatile("s_nop 7" ::: "memory"); __builtin_amdgcn_sched_barrier(0);
    const float p0 = fmaf(c0[3], wsel[3], fmaf(c0[2], wsel[2], fmaf(c0[1], wsel[1], c0[0] * wsel[0]))), p1 = fmaf(c1[3], wsel[3], fmaf(c1[2], wsel[2], fmaf(c1[1], wsel[1], c1[0] * wsel[0])));
    const float p2 = fmaf(c2[3], wsel[3], fmaf(c2[2], wsel[2], fmaf(c2[1], wsel[1], c2[0] * wsel[0]))), p3 = fmaf(c3[3], wsel[3], fmaf(c3[2], wsel[2], fmaf(c3[1], wsel[1], c3[0] * wsel[0])));
    const bool up32 = lane >= 32;
    float k0 = up32 ? p2 : p0, k1 = up32 ? p3 : p1, s0 = up32 ? p0 : p2, s1 = up32 ? p1 : p3;
    { auto r0 = __builtin_amdgcn_permlane32_swap(__builtin_bit_cast(unsigned, s0), __builtin_bit_cast(unsigned, s0), false, false);
      auto r1_ = __builtin_amdgcn_permlane32_swap(__builtin_bit_cast(unsigned, s1), __builtin_bit_cast(unsigned, s1), false, false);
      k0 += __builtin_bit_cast(float, up32 ? r0[0] : r0[1]); k1 += __builtin_bit_cast(float, up32 ? r1_[0] : r1_[1]); }
    const bool odd16 = (lane & 16) != 0;
    float kk = odd16 ? k1 : k0, ss = odd16 ? k0 : k1;
    { auto rr = __builtin_amdgcn_permlane16_swap(__builtin_bit_cast(unsigned, ss), __builtin_bit_cast(unsigned, ss), false, false); kk += __builtin_bit_cast(float, odd16 ? rr[0] : rr[1]); }
    DPP_ADD(kk, 0xB1); DPP_ADD(kk, 0x4E); DPP_ADD(kk, 0x141); DPP_ADD(kk, 0x140);
    const float act = gelu_tanh(kk) * g;
    const float a0 = __builtin_bit_cast(float, __builtin_amdgcn_readlane(__builtin_bit_cast(unsigned, act), 0)), a1 = __builtin_bit_cast(float, __builtin_amdgcn_readlane(__builtin_bit_cast(unsigned, act), 16));
    const float a2 = __builtin_bit_cast(float, __builtin_amdgcn_readlane(__builtin_bit_cast(unsigned, act), 32)), a3 = __builtin_bit_cast(float, __builtin_amdgcn_readlane(__builtin_bit_cast(unsigned, act), 48));
#define SW_ACC(F) { acc16_fp8(v0, a0, F); acc16_fp8(v1, a1, F); acc16_fp8(v2, a2, F); acc16_fp8(v3, a3, F); }
    if (tok == 0) { SW_ACC(f0) asm volatile("; token 0"); } else if (tok == 1) { SW_ACC(f1) asm volatile("; token 1"); } else if (tok == 2) { SW_ACC(f2) asm volatile("; token 2"); } else { SW_ACC(f3) asm volatile("; token 3"); }
#undef SW_ACC
}
#undef DPP_ADD
}


constexpr int NWAVES = 8, RING_BYTES = 131072, LDSCTL_OFF = RING_BYTES, MISC_OFF = LDSCTL_OFF + 320, LDS_BYTES = 147456;
constexpr int NPH = 11;
struct Args { const float* in[29]; float* out; unsigned char* ws; int ph_lo, ph_hi; };
static_assert(sizeof(Args) == 29 * 8 + 8 + 8 + 8, "Args has no padding");
enum { I_X = 0, I_C, I_CTX, I_CCTX, I_WMOD, I_BMOD, I_WIN, I_QNG, I_KVNG, I_WUQ, I_WUKV, I_S5ARE, I_S5AIM, I_S5LDT, I_S5BRE, I_S5BIM, I_S5CRE, I_S5CIM, I_S5D, I_WGLU, I_WOUT,
       I_LN1G, I_LN1B, I_PWQ, I_PKEYS, I_PU, I_PV, I_LN2G, I_LN2B };

__global__ void __launch_bounds__(NWAVES * 64, 2) mk_fwd(Args args) {
    extern __shared__ __attribute__((aligned(16))) unsigned char lds[];
    LAS unsigned char* ldsl = (LAS unsigned char*)lds;
    volatile LAS unsigned* MISC = (volatile LAS unsigned*)(ldsl + MISC_OFF);
    const int wave = __builtin_amdgcn_readfirstlane(threadIdx.x >> 6);
    const int G = gridDim.x; const int bx = blockIdx.x; const int vcu = (G % 8 == 0) ? (bx % 8) * (G / 8) + bx / 8 : bx;
    const int gw = vcu * NWAVES + wave, NGW = G * NWAVES;
    unsigned char* ws = args.ws;
    { const int tid = wave * 64 + lane_id_fresh(); for (int u = tid; u < (LDS_BYTES - LDSCTL_OFF) / 4; u += NWAVES * 64) ((LAS unsigned*)(ldsl + LDSCTL_OFF))[u] = 0u; }
    __syncthreads();
    XcdBarrier bar; bar.bar = (unsigned*)(ws + WS_CTL); bar.x = 0; bar.st = nullptr;
    if (MK_N_LAUNCHES == 1) bar = xcd_barrier_post((unsigned*)(ws + WS_CTL), MISC + 8, wave * 64 + lane_id_fresh());
    const int lo = args.ph_lo, hi = args.ph_hi;
    unsigned long long t_a = 0ull, t_b = 0ull; if (MK_TSEL == 0) t_a = __builtin_amdgcn_s_memrealtime();
#define TSTAMP(k) do { if (MK_TSEL >= 0) { if ((k) + 1 == MK_TSEL) t_a = __builtin_amdgcn_s_memrealtime(); if ((k) == MK_TSEL) t_b = __builtin_amdgcn_s_memrealtime(); } } while (0)
#ifndef MK_ONLY
#define MK_ONLY -1
#endif
#define IN(k) ((MK_ONLY < 0 || MK_ONLY == (k)) && lo <= (k) && (k) < hi)
#define SEAM(k) do { if (IN(k) && IN((k) + 1)) { xcd_barrier(bar, wave * 64 + lane_id_fresh()); } } while (0)
#define MOD ((float*)(ws + WS_MOD))
#define ABAR ((float*)(ws + WS_S5ABAR))
#define POW ((float*)(ws + WS_S5POW))
#define BB ((bf16_t*)(ws + WS_S5BB))
#define CM ((bf16_t*)(ws + WS_S5CM))
#define ROPE ((float*)(ws + WS_ROPE))
#define PART ((float*)(ws + WS_PART))
#define S5E ((float*)(ws + WS_S5E))
#define WIN ((bf16_t*)(ws + WS_WIN))
#define WUQ ((bf16_t*)(ws + WS_WUQ))
#define WUKV ((bf16_t*)(ws + WS_WUKV))
#define WGLU ((bf16_t*)(ws + WS_WGLU))
#define WOUT ((bf16_t*)(ws + WS_WOUT))
#define WQ ((bf16_t*)(ws + WS_WQ))
#define KEYS ((bf16_t*)(ws + WS_KEYS))
#define ZQ ((bf16_t*)(ws + WS_ZQ))
#define YB ((bf16_t*)(ws + WS_Y))
#define SU ((bf16_t*)(ws + WS_SU))
#define GATES ((bf16_t*)(ws + WS_GATES))
#define XM ((bf16_t*)(ws + WS_XM))
#define VB ((bf16_t*)(ws + WS_V))
#define MERGED ((bf16_t*)(ws + WS_MERGED))
#define QB ((bf16_t*)(ws + WS_Q))
#define KN ((bf16_t*)(ws + WS_KN))
#define KPE ((bf16_t*)(ws + WS_KPE))
#define TB ((bf16_t*)(ws + WS_T))
#define XM2 ((bf16_t*)(ws + WS_XM2))
#define PQ ((bf16_t*)(ws + WS_PQ))
#define PUB ((bf16_t*)(ws + WS_PU))
#define PVB ((bf16_t*)(ws + WS_PV))
    if (IN(0)) { const int lane = lane_id_fresh(), tid = wave * 64 + lane; (void)tid;
        if (bx < 96) {
            LAS float* sl = (LAS float*)ldsl;
            for (int idx = tid; idx < 17 * 1024; idx += 512) { const int b = idx >> 10, k = idx & 1023; const float cv = (b < 16) ? args.in[I_C][b * 1024 + k] : args.in[I_CCTX][k];
                sl[k * 20 + b] = cv * __builtin_amdgcn_rcpf(1.f + __expf(-cv)); }
            __syncthreads();
            LAS float* red = (LAS float*)(ldsl + 81920);
            for (int item = bx; item < 96; item += G) { const int n0 = item * 64;
                float acc[17];
#pragma unroll
                for (int b = 0; b < 17; ++b) acc[b] = 0.f;
                const float* wp = args.in[I_WMOD] + (size_t)(wave * 128) * 6144 + n0 + lane;
#pragma unroll 16
                for (int kk = 0; kk < 128; ++kk) { const float w = wp[(size_t)kk * 6144]; const LAS float* s = sl + (wave * 128 + kk) * 20;
                    const f32x4 s0 = *(const LAS f32x4*)s, s1 = *(const LAS f32x4*)(s + 4), s2 = *(const LAS f32x4*)(s + 8), s3 = *(const LAS f32x4*)(s + 12); const float s4 = s[16];
                    acc[0] += w * s0[0]; acc[1] += w * s0[1]; acc[2] += w * s0[2]; acc[3] += w * s0[3]; acc[4] += w * s1[0]; acc[5] += w * s1[1]; acc[6] += w * s1[2]; acc[7] += w * s1[3];
                    acc[8] += w * s2[0]; acc[9] += w * s2[1]; acc[10] += w * s2[2]; acc[11] += w * s2[3]; acc[12] += w * s3[0]; acc[13] += w * s3[1]; acc[14] += w * s3[2]; acc[15] += w * s3[3]; acc[16] += w * s4; }
#pragma unroll
                for (int b = 0; b < 17; ++b) red[(wave * 17 + b) * 64 + lane] = acc[b];
                __syncthreads();
                for (int idx = tid; idx < 17 * 64; idx += 512) { const int b = idx >> 6, ln = idx & 63; float s = args.in[I_BMOD][n0 + ln];
#pragma unroll
                    for (int w = 0; w < 8; ++w) s += red[(w * 17 + b) * 64 + ln];
                    MOD[(size_t)b * 6144 + n0 + ln] = s; }
                __syncthreads();
            }
        }
        {
            LAS float* scr = (LAS float*)(ldsl + wave * 16384);
            constexpr int I_1 = 16 * 104, I_2 = 6 * 48, I_3 = 4 * 64, I_4 = 8 * 64, I_5 = 16 * 32, I_6 = 16 * 64, NITEMS = I_1 + I_2 + I_3 + I_4 + I_5 + I_6;
            const bool split = (G == 256);
            for (int it = split ? (bx - 96) * NWAVES + wave : gw; it >= 0 && it < NITEMS; it += split ? (G - 96) * NWAVES : NGW) { int r = it;
                if (r < I_1) { const int kb = r / 104, nb = r % 104, nd = nb * 32;
                    const int ns = nd < 704 ? nd : (nd < 768 ? -1 : nd - 64);
                    transpose_item(args.in[I_WIN], INW, kb * 64, ns, WIN, 1024, nd, nullptr, scr, lane); continue; } r -= I_1;
                if (r < I_2) { const int kb = r / 48, nb = r % 48; transpose_item(args.in[I_WUQ], 1536, kb * 64, nb * 32, WUQ, 384, nb * 32, args.in[I_QNG], scr, lane); continue; } r -= I_2;
                if (r < I_3) { const int kb = r / 64, nb = r % 64; transpose_item(args.in[I_WUKV], 2048, kb * 64, nb * 32, WUKV, 256, nb * 32, args.in[I_KVNG], scr, lane); continue; } r -= I_3;
                if (r < I_4) { const int kb = r / 64, nb = r % 64, nd = nb * 32, tile = nd >> 8, wi = nd & 255;
                    const int ns = wi < 128 ? tile * 128 + wi : 1024 + tile * 128 + (wi - 128);
                    transpose_item(args.in[I_WGLU], 2048, kb * 64, ns, WGLU, 512, nd, nullptr, scr, lane); continue; } r -= I_4;
                if (r < I_5) { const int kb = r / 32, nb = r % 32; transpose_item(args.in[I_WOUT], 1024, kb * 64, nb * 32, WOUT, 1024, nb * 32, nullptr, scr, lane); continue; } r -= I_5;
                { const int kb = r / 64, nb = r % 64; transpose_item(args.in[I_PWQ], 2048, kb * 64, nb * 32, WQ, 1024, nb * 32, nullptr, scr, lane); }
            }
        }
        const int gt = (G - 1 - bx) * 512 + tid, NGT = G * 512;
        for (int i = gt; i < 16 * 128 * 128 / 8; i += NGT) {
            const f32x4 a = ((const f32x4*)args.in[I_PKEYS])[2 * i], b = ((const f32x4*)args.in[I_PKEYS])[2 * i + 1]; ((u32x4*)KEYS)[i] = pack8(a, b); }
        for (int i = gt; i < 4096; i += NGT) {
            const int p = i & 63, dg = i >> 6;
            const double dt = exp((double)args.in[I_S5LDT][dg]), ar = args.in[I_S5ARE][i], ai = args.in[I_S5AIM][i];
            const double mag = exp(ar * dt), abr = mag * cos(ai * dt), abi = mag * sin(ai * dt), den = ar * ar + ai * ai;
            const double fr = ((abr - 1.0) * ar + abi * ai) / den, fi = (abi * ar - (abr - 1.0) * ai) / den;
            ABAR[2 * i] = (float)abr; ABAR[2 * i + 1] = (float)abi;
            { const double m1 = exp(ar * dt * 256.0), m2 = exp(ar * dt * 512.0);
              POW[2 * i] = (float)(m1 * cos(ai * dt * 256.0)); POW[2 * i + 1] = (float)(m1 * sin(ai * dt * 256.0));
              POW[8192 + 2 * i] = (float)(m2 * cos(ai * dt * 512.0)); POW[8192 + 2 * i + 1] = (float)(m2 * sin(ai * dt * 512.0)); }
            for (int c = 0; c < 16; ++c) { const double br = args.in[I_S5BRE][(size_t)i * 16 + c], bi = args.in[I_S5BIM][(size_t)i * 16 + c];
                BB[((size_t)(dg * 2 + 0) * 64 + p) * 16 + c] = (bf16_t)(cvt_pk_bf16((float)(fr * br - fi * bi), 0.f) & 0xffffu);
                BB[((size_t)(dg * 2 + 1) * 64 + p) * 16 + c] = (bf16_t)(cvt_pk_bf16((float)(fr * bi + fi * br), 0.f) & 0xffffu);
                CM[((size_t)dg * 16 + c) * 128 + p] = (bf16_t)(cvt_pk_bf16(args.in[I_S5CRE][((size_t)dg * 16 + c) * 64 + p], 0.f) & 0xffffu);
                CM[((size_t)dg * 16 + c) * 128 + 64 + p] = (bf16_t)(cvt_pk_bf16(-args.in[I_S5CIM][((size_t)dg * 16 + c) * 64 + p], 0.f) & 0xffffu); }
        }
        for (int i = gt; i < 1024; i += NGT) { const int pos = i >> 4, idx = i & 15;
            const double ang = (double)pos * exp(-9.210340371976184 * (double)idx / 16.0); ROPE[2 * i] = (float)cos(ang); ROPE[2 * i + 1] = (float)sin(ang); }
    }
    SEAM(0); TSTAMP(0);
    if (IN(1)) { const int lane = lane_id_fresh(), tid = wave * 64 + lane; (void)tid;
#define P1A_ROW(m_) ((m_) < MLAT ? args.in[I_X] + (size_t)(m_) * DM : args.in[I_CTX] + (size_t)((m_) - MLAT) * DM)
#define P1A_LOAD(V, m_) do { const f32x4* p_ = (const f32x4*)P1A_ROW(m_) + lane; V[0] = p_[0]; V[1] = p_[64]; V[2] = p_[128]; V[3] = p_[192]; } while (0)
#define P1A_MOD(m_, A1, BS) do { const int b_ = ((m_) < MLAT) ? ((m_) >> 11) : 16; const f32x4* sh_ = (const f32x4*)(MOD + (size_t)b_ * 6144) + lane; const f32x4* sc_ = (const f32x4*)(MOD + (size_t)b_ * 6144 + 1024) + lane; \
    _Pragma("unroll") for (int j_ = 0; j_ < 4; ++j_) { A1[j_] = sc_[64 * j_]; BS[j_] = sh_[64 * j_]; } } while (0)
        { f32x4 va[4], vb[4], a1[4], bs[4], a1b[4], bsb[4];
          int m = gw; P1A_LOAD(va, m); P1A_MOD(m, a1, bs);
#pragma unroll 1
          for (; m < MTOT; m += 2 * NGW) {
              const int m2 = m + NGW, m3 = m + 2 * NGW;
              if (m2 < MTOT) { P1A_LOAD(vb, m2); P1A_MOD(m2, a1b, bsb); }
              modulate_row_r(va, a1, bs, XM + (size_t)m * DM, lane);
              if (m2 < MTOT) { if (m3 < MTOT) { P1A_LOAD(va, m3); P1A_MOD(m3, a1, bs); } modulate_row_r(vb, a1b, bsb, XM + (size_t)m2 * DM, lane); }
          } }
#undef P1A_ROW
#undef P1A_LOAD
#undef P1A_MOD
    }
    SEAM(1); TSTAMP(1);
    if (IN(2)) {
        pg8::Gemm g{XM, WIN, 1024, 1024, 1024}; pg8::StaticOrder S; S.init(MLAT / 256, 13, G, bx, MCTX / 256, 5);
        EpiInProj E{ZQ, SU, GATES, PART};
        pg8::gemm_phase(ldsl, g, S, E, wave * 64 + lane_id_fresh());
    }
    SEAM(2); TSTAMP(2);
    if (IN(3)) { const int lane = lane_id_fresh(), tid = wave * 64 + lane; (void)tid;
        { pg8::Gemm g{ZQ, WUQ, 768, 384, 384}; pg8::StaticOrder S; S.init(MLAT / 256, 6, G, bx); EpiUQ E{QB, PART}; pg8::gemm_phase(ldsl, g, S, E, wave * 64 + lane_id_fresh()); }
        { pg8::Gemm g{ZQ + 384, WUKV, 768, 256, 256}; pg8::StaticOrder S; S.init(MTOT / 256, 8, G, bx); EpiUKV E{KN, VB, PART}; pg8::gemm_phase(ldsl, g, S, E, wave * 64 + lane_id_fresh()); }
        const int gt = bx * 512 + tid, NGT = G * 512;
        for (int i = gt; i < MTOT * 32; i += NGT) {
            const int row = i >> 5, pp = i & 31, part = pp >> 4, idx = pp & 15;
            const bf16_t* z = ZQ + (size_t)row * 768 + 640 + part * 32 + idx; const float x1 = bf_lo((unsigned)z[0]), x2 = bf_lo((unsigned)z[16]);
            float o1 = x1, o2 = x2; int b, key;
            if (row < MLAT) { b = row >> 11; const int l = row & 2047; key = CTXL + l; const int pos = part == 0 ? (l >> 6) : (l & 63); const float cs = ROPE[(pos * 16 + idx) * 2], sn = ROPE[(pos * 16 + idx) * 2 + 1];
                o1 = x1 * cs - x2 * sn; o2 = x2 * cs + x1 * sn; }
            else { const int r2 = row - MLAT; b = r2 >> 8; key = r2 & 255; }
            bf16_t* kp = KPE + ((size_t)b * NKEY + key) * 64 + part * 32 + idx;
            kp[0] = (bf16_t)(cvt_pk_bf16(o1, 0.f) & 0xffffu); kp[16] = (bf16_t)(cvt_pk_bf16(o2, 0.f) & 0xffffu); }
        for (int u = gw; u < 2 * 32 * 8 * 8; u += NGW) s5_passA(SU, ABAR, BB, S5E, u, lane);
    }
    SEAM(3); TSTAMP(3);
    if (IN(4)) { const int lane = lane_id_fresh(), tid = wave * 64 + lane; (void)tid;
#pragma unroll 1
        for (int U = vcu; U < 1024; U += G) { const int bh = U >> 3, qb = U & 7, b = bh >> 3, h = bh & 7;
            att::attn_unit(QB + ((size_t)bh * SEQ + qb * 256) * DK, KN + (size_t)bh * NKEY * 128, KPE + (size_t)b * NKEY * 64, VB + (size_t)bh * NKEY * 128,
                           GATES + ((size_t)(b * SEQ + qb * 256)) * 2048 + h * 128, ROPE, qb * 256, (char*)lds, wave * 64 + lane_id_fresh()); }
        for (int u = gw; u < 2048; u += NGW) s5_passB(SU, ABAR, POW, BB, CM, S5E, args.in[I_S5D], YB, u, lane, ldsl + wave * S5_LDS_WAVE);
    }
    SEAM(4); TSTAMP(4);
    if (IN(5)) {
        pg8::Gemm g{YB, WGLU, 512, 512, 512}; pg8::StaticOrder S; S.init(MLAT / 256, 8, G, bx); EpiGLU E{QB, GATES, MERGED}; pg8::gemm_phase(ldsl, g, S, E, wave * 64 + lane_id_fresh());
    }
    SEAM(5); TSTAMP(5);
    if (IN(6)) {
        pg8::Gemm g{MERGED, WOUT, 1024, 1024, 1024}; pg8::StaticOrder S; S.init(MLAT / 256, 4, G, bx); EpiOut E{args.in[I_X], MOD, TB}; pg8::gemm_phase(ldsl, g, S, E, wave * 64 + lane_id_fresh());
    }
    SEAM(6); TSTAMP(6);
    if (IN(7)) { const int lane = lane_id_fresh(), tid = wave * 64 + lane; (void)tid;
#define P5B_LOAD(V, m_) do { const u32x2* p_ = (const u32x2*)(TB + (size_t)(m_) * DM) + lane; _Pragma("unroll") for (int j_ = 0; j_ < 4; ++j_) { const u32x2 q_ = p_[64 * j_]; V[j_] = (f32x4){bf_lo(q_.x), bf_hi(q_.x), bf_lo(q_.y), bf_hi(q_.y)}; } } while (0)
#define P5B_MOD(m_, A1, BS) do { const int b_ = (m_) >> 11; const f32x4* sh_ = (const f32x4*)(MOD + (size_t)b_ * 6144 + 3072) + lane; const f32x4* sc_ = (const f32x4*)(MOD + (size_t)b_ * 6144 + 4096) + lane; \
    _Pragma("unroll") for (int j_ = 0; j_ < 4; ++j_) { A1[j_] = sc_[64 * j_]; BS[j_] = sh_[64 * j_]; } } while (0)
        { f32x4 va[4], vb[4], g1v[4], b1v[4], a1[4], bs[4], a1b[4], bsb[4];
#pragma unroll
          for (int j = 0; j < 4; ++j) { g1v[j] = ((const f32x4*)args.in[I_LN1G] + lane)[64 * j]; b1v[j] = ((const f32x4*)args.in[I_LN1B] + lane)[64 * j]; }
          int m = gw; P5B_LOAD(va, m); P5B_MOD(m, a1, bs);
#pragma unroll 1
          for (; m < MLAT; m += 2 * NGW) {
              P5B_LOAD(vb, m + NGW); P5B_MOD(m + NGW, a1b, bsb);
              ln1_row(va, PART + 2 * (size_t)m, g1v, b1v, a1, bs, XM2 + (size_t)m * DM, lane);
              if (m + 2 * NGW < MLAT) { P5B_LOAD(va, m + 2 * NGW); P5B_MOD(m + 2 * NGW, a1, bs); }
              ln1_row(vb, PART + 2 * (size_t)(m + NGW), g1v, b1v, a1b, bsb, XM2 + (size_t)(m + NGW) * DM, lane);
          } }
#undef P5B_LOAD
#undef P5B_MOD
#pragma unroll 1
        for (int r0 = gw * 4; r0 < 2 * PEXP; r0 += NGW * 4) {
            f32x4 t[4][4];
#pragma unroll
            for (int q = 0; q < 4; ++q) { const int r = r0 + q; const bool isU = r < PEXP; const f32x4* src = (const f32x4*)(isU ? args.in[I_PU] : args.in[I_PV]) + (size_t)(isU ? r : r - PEXP) * (DM / 4) + lane;
#pragma unroll
                for (int d = 0; d < 4; ++d) t[q][d] = src[64 * d]; }
#pragma unroll
            for (int q = 0; q < 4; ++q) { const int r = r0 + q; const bool isU = r < PEXP; const float sc_ = isU ? peer::PU_SCALE : peer::PV_SCALE;
                unsigned* dst = (unsigned*)(ws + WS_PU + (isU ? (size_t)0 : (size_t)(16 * MiB)) + (size_t)(isU ? r : r - PEXP) * DM) + lane;
#pragma unroll
                for (int d = 0; d < 4; ++d) { const f32x4 v = t[q][d] * sc_; int p = __builtin_amdgcn_cvt_pk_fp8_f32(peer::sat8(v[0]), peer::sat8(v[1]), 0, false); p = __builtin_amdgcn_cvt_pk_fp8_f32(peer::sat8(v[2]), peer::sat8(v[3]), p, true); dst[64 * d] = (unsigned)p; } }
        }
    }
    SEAM(7); TSTAMP(7);
    if (IN(8)) {
        pg8::Gemm g{XM2, WQ, 1024, 1024, 1024}; pg8::StaticOrder S; S.init(MLAT / 256, 8, G, bx); EpiPQ E{PQ}; pg8::gemm_phase(ldsl, g, S, E, wave * 64 + lane_id_fresh());
    }
    SEAM(8); TSTAMP(8);
    if (IN(9)) { const int lane = lane_id_fresh(), tid = wave * 64 + lane; const int h = bx & 7;
        for (int c = tid; c < 4096; c += 512) { const int z = c >> 11, key = (c >> 4) & 127, c16 = c & 15;
            *(LAS u32x4*)(ldsl + peer::ksw(z, key, c16 * 16)) = *(const u32x4*)(KEYS + ((size_t)(h * 2 + z) * 128 + key) * 128 + c16 * 8); }
        __syncthreads();
#pragma unroll 1
        for (int j = wave; j < 32; j += 8) { int l2 = lane; asm volatile("" : "+v"(l2));
            peer::route_unit(PQ, (const char*)lds,
                (unsigned*)(ws + WS_ROUTE), (float*)(ws + WS_ROUTE + 16 * MiB), ((bx >> 3) * 32 + j) * 32, h, l2); }
    }
    SEAM(9); TSTAMP(9);
    if (IN(10)) { const int lane = lane_id_fresh();
        LAS unsigned char* wl = ldsl + wave * peer::WAVE_LDS;
        LAS unsigned char* xl = wl + peer::TOK_PER_WAVE * peer::TOKLDS_BYTES;
        const unsigned char* PU8 = ws + WS_PU; const unsigned char* PV8 = ws + WS_PU + 16 * MiB;
        f32x4 wsel; { const bool dsel = (lane >> 4) == ((lane & 15) >> 2); const float sc_ = 1.f / (peer::PU_SCALE * peer::X_SCALE);
#pragma unroll
          for (int r = 0; r < 4; ++r) wsel[r] = (dsel && (lane & 3) == r) ? sc_ : 0.f; }
#pragma unroll 1
        for (int m0 = gw * peer::TOK_PER_WAVE; m0 < MLAT; m0 += NGW * peer::TOK_PER_WAVE) {
            float f0[16], f1[16], f2[16], f3[16];
            { unsigned ia[4], ib[4]; float wa[4], wb[4]; u32x4 xa[4], xb[4];
#pragma unroll
              for (int i = 0; i < 4; ++i) { const size_t m = (size_t)(m0 + i); const unsigned* ridx = (const unsigned*)(ws + WS_ROUTE) + m * 128; const float* rw = (const float*)(ws + WS_ROUTE + 16 * MiB) + m * 128;
                  ia[i] = ridx[lane]; ib[i] = ridx[64 + lane]; wa[i] = rw[lane]; wb[i] = rw[64 + lane];
                  const bf16_t* xrow = XM2 + m * DM; xa[i] = *(const u32x4*)(xrow + 16 * lane); xb[i] = *(const u32x4*)(xrow + 16 * lane + 8); }
#pragma unroll
              for (int i = 0; i < 4; ++i) { peer::bucket_token(ia[i], ib[i], wa[i], wb[i], wl + i * peer::TOKLDS_BYTES, lane); peer::xop_store(xa[i], xb[i], xl + i * peer::XOP_BYTES, lane); } }
#pragma unroll
            for (int e = 0; e < 16; ++e) { f0[e] = 0.f; f1[e] = 0.f; f2[e] = 0.f; f3[e] = 0.f; }
            LDS_WAIT();
            peer::build_recs(wl, lane); constexpr int nd = 128;
            LDS_WAIT();
            u32x4 au0, au1, au2, au3, av0, av1, av2, av3, bu0, bu1, bu2, bu3, bv0, bv1, bv2, bv3, axh, axo, bxh, bxo; float ag, bg; int at, bt;
            u32x2 ra, rb;
#define SW_REC(k_, R) do { const int kk_ = (k_) < nd ? (k_) : nd - 1; R = *(const LAS u32x2*)(wl + 32 * kk_); } while (0)
#define SW_LOAD(k_, R, U0, U1, U2, U3, V0, V1, V2, V3, XH, XO, G, T) do { \
    const unsigned p0_ = (unsigned)__builtin_amdgcn_readfirstlane((int)R.x), p1_ = (unsigned)__builtin_amdgcn_readfirstlane((int)R.y); T = (int)((p0_ >> 14) & 3u); \
    const unsigned e0_ = p0_ & 0x3fffu, e1_ = p0_ >> 16, e2_ = p1_ & 0xffffu, e3_ = p1_ >> 16; \
    { const int kk_ = (k_) < nd ? (k_) : nd - 1; G = ((const LAS float*)(wl + 32 * kk_))[4 + (lane >> 4)] * (1.f / peer::PV_SCALE); } \
    XH = *(const LAS u32x4*)(xl + T * peer::XOP_BYTES + 16 * lane); XO = *(const LAS u32x4*)(xl + T * peer::XOP_BYTES + 1024 + 16 * lane); \
    U0 = *(const u32x4*)(PU8 + (size_t)e0_ * 1024 + 16 * lane); U1 = *(const u32x4*)(PU8 + (size_t)e1_ * 1024 + 16 * lane); \
    U2 = *(const u32x4*)(PU8 + (size_t)e2_ * 1024 + 16 * lane); U3 = *(const u32x4*)(PU8 + (size_t)e3_ * 1024 + 16 * lane); \
    V0 = *(const u32x4*)(PV8 + (size_t)e0_ * 1024 + 16 * lane); V1 = *(const u32x4*)(PV8 + (size_t)e1_ * 1024 + 16 * lane); \
    V2 = *(const u32x4*)(PV8 + (size_t)e2_ * 1024 + 16 * lane); V3 = *(const u32x4*)(PV8 + (size_t)e3_ * 1024 + 16 * lane); } while (0)
            SW_REC(0, ra); SW_REC(1, rb);
            SW_LOAD(0, ra, au0, au1, au2, au3, av0, av1, av2, av3, axh, axo, ag, at);
#pragma unroll 1
            for (int k = 0; k < nd; k += 2) {
                SW_LOAD(k + 1, rb, bu0, bu1, bu2, bu3, bv0, bv1, bv2, bv3, bxh, bxo, bg, bt);
                SW_REC(k + 2, ra);
                peer::sweep_compute(au0, au1, au2, au3, av0, av1, av2, av3, ag, at, axh, axo, f0, f1, f2, f3, lane, wsel);
                SW_LOAD(k + 2, ra, au0, au1, au2, au3, av0, av1, av2, av3, axh, axo, ag, at);
                SW_REC(k + 3, rb);
                peer::sweep_compute(bu0, bu1, bu2, bu3, bv0, bv1, bv2, bv3, bg, bt, bxh, bxo, f0, f1, f2, f3, lane, wsel);
            }
#undef SW_REC
#undef SW_LOAD
            { const int b = m0 >> 11;
              f32x4 gf[4], g1v[4], b1v[4], g2v[4], b2v[4]; u32x4 ta[4], tb[4]; float mean1[4], rstd1[4];
#pragma unroll
              for (int i = 0; i < 4; ++i) { const u32x4* hp = (const u32x4*)(TB + (size_t)(m0 + i) * DM + 16 * lane); ta[i] = hp[0]; tb[i] = hp[1]; mean1[i] = PART[2 * (size_t)(m0 + i)]; rstd1[i] = PART[2 * (size_t)(m0 + i) + 1]; }
#pragma unroll
              for (int d = 0; d < 4; ++d) { gf[d] = ((const f32x4*)(MOD + (size_t)b * 6144 + 5120 + 16 * lane))[d]; g1v[d] = ((const f32x4*)(args.in[I_LN1G] + 16 * lane))[d]; b1v[d] = ((const f32x4*)(args.in[I_LN1B] + 16 * lane))[d];
                  g2v[d] = ((const f32x4*)(args.in[I_LN2G] + 16 * lane))[d]; b2v[d] = ((const f32x4*)(args.in[I_LN2B] + 16 * lane))[d]; }
#pragma unroll
              for (int i = 0; i < 4; ++i) { const int m = m0 + i; float v[16];
#pragma unroll
                  for (int d = 0; d < 4; ++d) {
                      const unsigned qa = d < 2 ? (d == 0 ? ta[i].x : ta[i].z) : (d == 2 ? tb[i].x : tb[i].z), qb = d < 2 ? (d == 0 ? ta[i].y : ta[i].w) : (d == 2 ? tb[i].y : tb[i].w);
                      const f32x4 t = {bf_lo(qa), bf_hi(qa), bf_lo(qb), bf_hi(qb)};
#pragma unroll
                      for (int e = 0; e < 4; ++e) { const float fv = (i == 0 ? f0[4 * d + e] : i == 1 ? f1[4 * d + e] : i == 2 ? f2[4 * d + e] : f3[4 * d + e]);
                          v[4 * d + e] = gf[d][e] * fv + ALPHA * ((t[e] - mean1[i]) * rstd1[i] * g1v[d][e] + b1v[d][e]); } }
                  float s = 0.f;
#pragma unroll
                  for (int e = 0; e < 16; ++e) s += v[e];
                  const float mean = wave_sum(s) * (1.f / DM); float s2 = 0.f;
#pragma unroll
                  for (int e = 0; e < 16; ++e) { v[e] -= mean; s2 += v[e] * v[e]; }
                  const float rstd = rsqrtf(wave_sum(s2) * (1.f / DM) + LN_EPS);
                  f32x4* op = (f32x4*)(args.out + (size_t)m * DM + 16 * lane);
#pragma unroll
                  for (int d = 0; d < 4; ++d) { f32x4 o;
#pragma unroll
                      for (int e = 0; e < 4; ++e) o[e] = v[4 * d + e] * rstd * g2v[d][e] + b2v[d][e];
                      op[d] = o; } } }
        }
    }
    if (MK_TSEL >= 0) { if (MK_TSEL == 10) t_b = __builtin_amdgcn_s_memrealtime(); if (bx == 0) { const unsigned long long span = t_b - t_a, t0 = __builtin_amdgcn_s_memrealtime(); while (__builtin_amdgcn_s_memrealtime() - t0 < 4ull * span) __builtin_amdgcn_s_sleep(8); } }
#undef IN
#undef SEAM
}

extern "C" void kernel_launch(void* const* d_in, const int* in_sizes, int n_in, void* d_out, int out_size, void* d_ws, size_t ws_size, hipStream_t stream) {
    static int grid = 0;
    if (grid == 0) {
        if (n_in != 29 || in_sizes[0] != MLAT * DM || out_size != MLAT * DM || ws_size < WS_END) {
            fprintf(stderr, "kernel_launch: unexpected problem: n_in %d in0 %d out %d ws %zu (need %zu)\n", n_in, n_in > 0 ? in_sizes[0] : -1, out_size, ws_size, (size_t)WS_END); grid = -1; return; }
        int dev = 0, cus = 0;
        if (hipGetDevice(&dev) != hipSuccess || hipDeviceGetAttribute(&cus, hipDeviceAttributeMultiprocessorCount, dev) != hipSuccess) { grid = -1; return; }
        if (hipFuncSetAttribute((const void*)mk_fwd, hipFuncAttributeMaxDynamicSharedMemorySize, LDS_BYTES) != hipSuccess) { fprintf(stderr, "kernel_launch: hipFuncSetAttribute failed\n"); grid = -1; return; }
        int per_cu = 0;
        if (hipOccupancyMaxActiveBlocksPerMultiprocessor(&per_cu, (const void*)mk_fwd, NWAVES * 64, LDS_BYTES) != hipSuccess || per_cu < 1)
            fprintf(stderr, "kernel_launch: occupancy query reports %d blocks per CU\n", per_cu);
        (void)hipGetLastError();
        grid = cus >= 256 ? 256 : (cus >= 128 ? 128 : (cus >= 64 ? 64 : -1));
    }
    if (grid < 0) return;
    if (hipMemsetAsync((char*)d_ws + WS_CTL, 0, CTL_ZERO_BYTES, stream) != hipSuccess) return;
    Args a{};
    for (int i = 0; i < 29; ++i) a.in[i] = (const float*)d_in[i];
    a.out = (float*)d_out; a.ws = (unsigned char*)d_ws;
#if MK_N_LAUNCHES == 1
    a.ph_lo = 0; a.ph_hi = NPH;
    hipLaunchKernelGGL(mk_fwd, dim3(grid), dim3(NWAVES * 64), LDS_BYTES, stream, a);
#else
    for (int p = 0; p < NPH; ++p) { a.ph_lo = p; a.ph_hi = p + 1; hipLaunchKernelGGL(mk_fwd, dim3(grid), dim3(NWAVES * 64), LDS_BYTES, stream, a); }
#endif
    const hipError_t le = hipPeekAtLastError();
    if (le != hipSuccess) fprintf(stderr, "kernel_launch: launch failed: %s\n", hipGetErrorName(le));
}
```

```cpp
#include <hip/hip_runtime.h>
#include <cstdio>
#include <cstdint>

#define GAS __attribute__((address_space(1)))
#define LAS __attribute__((address_space(3)))
typedef unsigned short bf16_t;
typedef short bf16x8 __attribute__((ext_vector_type(8)));
typedef short s16x4 __attribute__((ext_vector_type(4)));
typedef short v4i16_t __attribute__((ext_vector_type(4)));
typedef float f32x2 __attribute__((ext_vector_type(2)));
typedef float f32x4 __attribute__((ext_vector_type(4)));
typedef float f32x16 __attribute__((ext_vector_type(16)));
typedef unsigned u32x2 __attribute__((ext_vector_type(2)));
typedef unsigned u32x4 __attribute__((ext_vector_type(4)));


#ifndef MK_TSEL
#define MK_TSEL -1
#endif
#ifndef MK_N_LAUNCHES
#define MK_N_LAUNCHES 1
#endif

constexpr int DM = 1024, NB = 16, SEQ = 2048, CTXL = 256, MLAT = NB * SEQ, MCTX = NB * CTXL, MTOT = MLAT + MCTX;
constexpr int NH = 8, DK = 192, DV = 128, QRANK = 384, KVRANK = 256, NKEY = CTXL + SEQ;
constexpr int INW = 3264;
constexpr int S5W = 512, S5G = 32, S5C = 16, S5P = 64;
constexpr int PEH = 8, PEK = 128, PEXP = 16384, PETOP = 16;
constexpr float LN_EPS = 1e-6f;
constexpr float ALPHA = 1.189207115002721f;
constexpr float QSCALE = 0.07216878364870322f * 1.4426950408889634f;

constexpr size_t MiB = 1u << 20;
constexpr size_t WS_CTL = 0, CTL_ZERO_BYTES = 64 * 1024;
constexpr size_t WS_MOD = 1 * MiB;
constexpr size_t WS_S5ABAR = 1 * MiB + 512 * 1024;
constexpr size_t WS_S5POW = WS_S5ABAR + 32768;
constexpr size_t WS_S5BB = WS_S5POW + 65536;
constexpr size_t WS_S5CM = WS_S5BB + 262144;
constexpr size_t WS_ROPE = WS_S5CM + 262144;
constexpr size_t WS_PART = 3 * MiB;
constexpr size_t WS_S5E = 6 * MiB;
constexpr size_t WS_WIN = 10 * MiB;
constexpr size_t WS_WUQ = WS_WIN + 3328 * 1024 * 2;
constexpr size_t WS_WUKV = WS_WUQ + 1536 * 384 * 2;
constexpr size_t WS_WGLU = WS_WUKV + 2048 * 256 * 2;
constexpr size_t WS_WOUT = WS_WGLU + 2048 * 512 * 2;
constexpr size_t WS_WQ = WS_WOUT + 1024 * 1024 * 2;
constexpr size_t WS_KEYS = WS_WQ + 2048 * 1024 * 2;
static_assert(WS_KEYS + 16 * 128 * 128 * 2 <= 28 * MiB, "weights region");
constexpr size_t WS_ZQ = 28 * MiB;
constexpr size_t WS_Y = 28 * MiB;
constexpr size_t WS_PU = 28 * MiB, WS_PV = 60 * MiB;
constexpr size_t WS_SU = 82 * MiB;
constexpr size_t WS_GATES = 118 * MiB;
constexpr size_t WS_XM2 = 118 * MiB;
constexpr size_t WS_PQ = 182 * MiB;
constexpr size_t WS_XM = 246 * MiB;
constexpr size_t WS_V = 246 * MiB;
constexpr size_t WS_MERGED = 246 * MiB;
constexpr size_t WS_Q = 318 * MiB;
constexpr size_t WS_T = 318 * MiB;
constexpr size_t WS_KN = 414 * MiB;
constexpr size_t WS_KPE = 486 * MiB;
constexpr size_t WS_ROUTE = 448 * MiB;
constexpr size_t WS_END = 492 * MiB;

#define RLX_AGENT __ATOMIC_RELAXED, __HIP_MEMORY_SCOPE_AGENT
#define LDS_WAIT() asm volatile("s_waitcnt lgkmcnt(0)" ::: "memory")
#define VM_WAIT() asm volatile("s_waitcnt vmcnt(0)" ::: "memory")
typedef __bf16 bf16x2_t __attribute__((ext_vector_type(2)));
__device__ __forceinline__ unsigned cvt_pk_bf16(float lo, float hi) { const f32x2 v = {lo, hi}; const bf16x2_t b = __builtin_convertvector(v, bf16x2_t); return __builtin_bit_cast(unsigned, b); }
__device__ __forceinline__ float bf_lo(unsigned u) { return __builtin_bit_cast(float, u << 16); }
__device__ __forceinline__ float bf_hi(unsigned u) { return __builtin_bit_cast(float, u & 0xffff0000u); }
__device__ __forceinline__ float wave_sum(float v) {
#pragma unroll
    for (int o = 1; o < 64; o <<= 1) v += __shfl_xor(v, o);
    return v;
}
__device__ __forceinline__ int lane_id_fresh() { unsigned z; asm volatile("s_mov_b32 %0, 0" : "=s"(z)); return (int)__builtin_amdgcn_mbcnt_hi(~0u, __builtin_amdgcn_mbcnt_lo(~0u, z)); }
__device__ __forceinline__ float sigmoidf_(float x) { return __builtin_amdgcn_rcpf(1.f + __expf(-x)); }
__device__ __forceinline__ float gelu_tanh(float x) {
    const float u = 0.7978845608028654f * (x + 0.044715f * x * x * x);
    return x * __builtin_amdgcn_rcpf(1.f + __expf(-2.f * u));
}

#define MFMA32(a, b, c) __builtin_amdgcn_mfma_f32_32x32x16_bf16(a, b, c, 0, 0, 0)
#define MFMA_PAD() do { __builtin_amdgcn_sched_barrier(0); asm volatile("s_nop 15\n\ts_nop 15\n\ts_nop 15\n\ts_nop 15\n\ts_nop 15\n\ts_nop 15" ::: "memory"); __builtin_amdgcn_sched_barrier(0); } while (0)

namespace pg8 {
constexpr int BM = 256, BK = 64, HALF = 128, HTB = HALF * BK * 2, STAGE_BYTES = 8 * HTB, NXCD = 8, WGM = 8;
__host__ __device__ __forceinline__ int lds_byte(int r, int c) { const int st = (r >> 4) * 2 + (c >> 5), rr = r & 15, cc = c & 31, ob = rr * 64 + cc * 2; return st * 1024 + (ob ^ (((ob >> 9) & 1) << 5)); }
__host__ __device__ __forceinline__ void stage_rc(int b, int& R, int& C) { const int st = b / 1024, sb = b % 1024, swz = sb ^ (((sb >> 9) & 1) << 5); R = (st >> 1) * 16 + swz / 64; C = (st & 1) * 32 + (swz % 64) / 2; }
__host__ __device__ __forceinline__ int perm32(int rho) { const int n = rho >> 4, i = rho & 15; return 8 * (i >> 2) + 4 * n + (i & 3); }
struct Unit { int pm, pn; };
struct Gemm { const bf16_t* A; const bf16_t* Bt; int lda, ldb, K; };
struct StaticOrder {
    int nM, nN, nwg, G, c, nM2, nN2, pm0;
    __device__ void init(int nM_, int nN_, int G_, int c_, int nM2_ = 0, int nN2_ = 0) { nM = nM_; nN = nN_; nwg = nM * nN; G = G_; c = c_; nM2 = nM2_; nN2 = nN2_; pm0 = nM_; }
    __device__ bool next(int i, Unit& u) const {
        const long L = (long)i * G + c;
        if (L >= nwg) { const int e = (int)(L - nwg); if (e >= nM2 * nN2) return false; u.pm = pm0 + e % nM2; u.pn = e / nM2; return true; }
        int wgid = (int)L; { const int q = nwg / NXCD, r = nwg % NXCD, xcd = wgid % NXCD, off = wgid / NXCD; wgid = (xcd < r ? xcd * (q + 1) : r * (q + 1) + (xcd - r) * q) + off; }
        const int nig = WGM * nN, gid = wgid / nig, fm = gid * WGM, gsz = (nM - fm) < WGM ? (nM - fm) : WGM;
        u.pm = fm + ((wgid % nig) % gsz); u.pn = (wgid % nig) / gsz; return true;
    }
};

template <class Epi, class Sched>
__device__ __forceinline__ void gemm_phase(LAS unsigned char* lds, const Gemm g, const Sched& S, const Epi& E, int tid_) {
    asm volatile("" : "+v"(tid_));
    const int tid = tid_, wid = __builtin_amdgcn_readfirstlane(tid >> 6), lane = tid & 63, wr = wid >> 2, wc = wid & 3, fr = lane & 15, fq = lane >> 4;
    const int K = g.K, nt = K / BK;
    unsigned voffA[2], voffB[2];
#pragma unroll
    for (int i = 0; i < 2; ++i) { int R, C; stage_rc(tid * 16 + i * 8192, R, C); const int Rb = Epi::PERM ? ((R & ~31) + perm32(R & 31)) : R;
        voffA[i] = (unsigned)(R * g.lda + C) * 2u; voffB[i] = (unsigned)(Rb * g.ldb + C) * 2u; }
    const size_t kstep = (size_t)(BK * 2);
    const size_t hstepA = (size_t)HALF * g.lda * 2, hstepB = (size_t)HALF * g.ldb * 2;
    const size_t tstepA = 2 * hstepA, tstepB = 2 * hstepB;
    const unsigned ldsw = (unsigned)wid * 1024u;
    const int aoff = lds_byte(wr * 64 + fr, fq * 8), boff = lds_byte(wc * 32 + fr, fq * 8);
#define PG8_SA(b, h) (((b) * 2 + (h)) * HTB)
#define PG8_SB(b, h) ((4 + (b) * 2 + (h)) * HTB)
#define PG8_STAGE(bufoff, gbase, voff) do { _Pragma("unroll") for (int _i = 0; _i < 2; ++_i) \
        __builtin_amdgcn_global_load_lds((const unsigned*)((const char*)(gbase) + (voff)[_i]), (LAS unsigned*)(lds + (bufoff) + ldsw + _i * 8192), 16, 0, 0); } while (0)
#define PG8_LDA(dst, b, h) do { _Pragma("unroll") for (int m = 0; m < 4; ++m) _Pragma("unroll") for (int k = 0; k < 2; ++k) dst[m][k] = *(const LAS bf16x8*)(lds + PG8_SA(b, h) + aoff + m * 2048 + k * 1024); } while (0)
#define PG8_LDB(dst, b, h) do { _Pragma("unroll") for (int n = 0; n < 2; ++n) _Pragma("unroll") for (int k = 0; k < 2; ++k) dst[n][k] = *(const LAS bf16x8*)(lds + PG8_SB(b, h) + boff + n * 2048 + k * 1024); } while (0)
#define PG8_MMA(ai, bj, At, Bt) do { __builtin_amdgcn_s_setprio(1); _Pragma("unroll") for (int m = 0; m < 4; ++m) _Pragma("unroll") for (int n = 0; n < 2; ++n) _Pragma("unroll") for (int k = 0; k < 2; ++k) \
        acc[ai][bj][m][n] = __builtin_amdgcn_mfma_f32_16x16x32_bf16(Bt[n][k], At[m][k], acc[ai][bj][m][n], 0, 0, 0); __builtin_amdgcn_s_setprio(0); } while (0)
#define PG8_WAIT_V(n) asm volatile("s_waitcnt vmcnt(" #n ")" ::: "memory")
#define PG8_WAIT_L(n) asm volatile("s_waitcnt lgkmcnt(" #n ")" ::: "memory")
#define PG8_BAR __builtin_amdgcn_s_barrier()
#define PG8_SCHED __builtin_amdgcn_sched_barrier(0)
    Unit cur, nxt; int ui = 0;
    if (!S.next(0, cur)) return;
    f32x4 acc[2][2][4][2];
#pragma unroll
    for (int a = 0; a < 2; ++a)
#pragma unroll
        for (int b = 0; b < 2; ++b)
#pragma unroll
            for (int m = 0; m < 4; ++m)
#pragma unroll
                for (int n = 0; n < 2; ++n) acc[a][b][m][n] = (f32x4){0.f, 0.f, 0.f, 0.f};
    bf16x8 At[4][2], B0[2][2], B1[2][2];
    const char* cA = (const char*)g.A + (size_t)cur.pm * tstepA; const char* cB = (const char*)g.Bt + (size_t)cur.pn * tstepB;
    PG8_STAGE(PG8_SB(0, 0), cB, voffB); PG8_STAGE(PG8_SB(0, 1), cB + hstepB, voffB); PG8_STAGE(PG8_SA(0, 0), cA, voffA); PG8_STAGE(PG8_SA(0, 1), cA + hstepA, voffA);
    if (wr == 1) PG8_BAR;
    PG8_WAIT_V(2); PG8_BAR;
    PG8_STAGE(PG8_SB(1, 0), cB + kstep, voffB); PG8_STAGE(PG8_SA(1, 0), cA + kstep, voffA); PG8_STAGE(PG8_SB(1, 1), cB + hstepB + kstep, voffB);
    PG8_WAIT_V(6); PG8_BAR;
    for (;;) {
        const bool has_next = S.next(ui + 1, nxt);
        const char* nA = has_next ? (const char*)g.A + (size_t)nxt.pm * tstepA : cA; const char* nB = has_next ? (const char*)g.Bt + (size_t)nxt.pn * tstepB : cB;
        for (int t = 0; t < nt; t += 2) {
            const bool last = (t == nt - 2);
            const char* a1 = cA + (size_t)(t + 1) * kstep;
            const char* a2 = last ? nA : cA + (size_t)(t + 2) * kstep; const char* b2 = last ? nB : cB + (size_t)(t + 2) * kstep;
            const char* a3 = a2 + kstep; const char* b3 = b2 + kstep;
            PG8_LDB(B0, 0, 0); PG8_LDB(B1, 0, 1); PG8_SCHED; PG8_LDA(At, 0, 0); PG8_STAGE(PG8_SA(1, 1), a1 + hstepA, voffA);
            PG8_WAIT_V(8); PG8_WAIT_L(0); PG8_BAR; PG8_MMA(0, 0, At, B0); PG8_MMA(0, 1, At, B1); PG8_BAR; PG8_SCHED;
            PG8_LDA(At, 0, 1); PG8_STAGE(PG8_SB(0, 0), b2, voffB); PG8_STAGE(PG8_SB(0, 1), b2 + hstepB, voffB); PG8_STAGE(PG8_SA(0, 0), a2, voffA);
            PG8_WAIT_V(8); PG8_WAIT_L(0); PG8_BAR; PG8_MMA(1, 0, At, B0); PG8_MMA(1, 1, At, B1); PG8_BAR; PG8_SCHED;
            PG8_LDB(B0, 1, 0); PG8_LDB(B1, 1, 1); PG8_SCHED; PG8_LDA(At, 1, 0); PG8_STAGE(PG8_SA(0, 1), a2 + hstepA, voffA);
            PG8_WAIT_V(8); PG8_WAIT_L(0); PG8_BAR; PG8_MMA(0, 0, At, B0); PG8_MMA(0, 1, At, B1); PG8_BAR; PG8_SCHED;
            PG8_LDA(At, 1, 1); PG8_STAGE(PG8_SB(1, 0), b3, voffB); PG8_STAGE(PG8_SB(1, 1), b3 + hstepB, voffB); PG8_STAGE(PG8_SA(1, 0), a3, voffA);
            PG8_WAIT_V(8); PG8_WAIT_L(0); PG8_BAR; PG8_MMA(1, 0, At, B0); PG8_MMA(1, 1, At, B1); PG8_BAR; PG8_SCHED;
        }
        if (wr == 0) PG8_BAR;
        MFMA_PAD();
        { const int l2 = lane_id_fresh(); E(acc, cur, wr, wc, l2 & 15, l2 >> 4); }
        if (!has_next) break;
#pragma unroll
        for (int a = 0; a < 2; ++a)
#pragma unroll
            for (int b = 0; b < 2; ++b)
#pragma unroll
                for (int m = 0; m < 4; ++m)
#pragma unroll
                    for (int n = 0; n < 2; ++n) acc[a][b][m][n] = (f32x4){0.f, 0.f, 0.f, 0.f};
        cur = nxt; cA = nA; cB = nB; ++ui;
        if (wr == 1) PG8_BAR;
    }
    PG8_WAIT_V(0);
    PG8_BAR;
#undef PG8_SA
#undef PG8_SB
#undef PG8_STAGE
#undef PG8_LDA
#undef PG8_LDB
#undef PG8_MMA
#undef PG8_WAIT_V
#undef PG8_WAIT_L
#undef PG8_BAR
#undef PG8_SCHED
}
}

typedef f32x4 acc_t[2][2][4][2];
__device__ __forceinline__ u32x4 pack8(const f32x4 a, const f32x4 b) { u32x4 w; w.x = cvt_pk_bf16(a[0], a[1]); w.y = cvt_pk_bf16(a[2], a[3]); w.z = cvt_pk_bf16(b[0], b[1]); w.w = cvt_pk_bf16(b[2], b[3]); return w; }

struct EpiInProj { static constexpr bool PERM = true;
    bf16_t* ZQ; bf16_t* SU; bf16_t* GATES; float* PART;
    __device__ __forceinline__ void operator()(const acc_t& acc, const pg8::Unit& u, int wr, int wc, int fr, int fq) const {
        const int row0 = u.pm * 256 + wr * 64 + fr, pn = u.pn;
#pragma unroll
        for (int ai = 0; ai < 2; ++ai)
#pragma unroll
            for (int m = 0; m < 4; ++m) { const int row = row0 + ai * 128 + m * 16;
#pragma unroll
                for (int bj = 0; bj < 2; ++bj) { f32x4 v0 = acc[ai][bj][m][0], v1 = acc[ai][bj][m][1]; const int c0 = bj * 128 + wc * 32 + 8 * fq;
                    if (pn < 3) {
                        *(u32x4*)(ZQ + (size_t)row * 768 + pn * 256 + c0) = pack8(v0, v1);
                        float ss = (v0[0] * v0[0] + v0[1] * v0[1]) + (v0[2] * v0[2] + v0[3] * v0[3]) + (v1[0] * v1[0] + v1[1] * v1[1]) + (v1[2] * v1[2] + v1[3] * v1[3]);
                        ss += __shfl_xor(ss, 16); ss += __shfl_xor(ss, 32);
                        const int slot = pn * 2 + bj;
                        if (fq == 0 && slot < 5) PART[(size_t)row * 20 + slot * 4 + wc] = ss;
                    } else if (pn < 5) {
                        *(u32x4*)(SU + (size_t)row * 512 + (pn - 3) * 256 + c0) = pack8(v0, v1);
                    } else {
#pragma unroll
                        for (int e = 0; e < 4; ++e) { v0[e] = sigmoidf_(v0[e]); v1[e] = sigmoidf_(v1[e]); }
                        *(u32x4*)(GATES + (size_t)row * 2048 + (pn - 5) * 256 + c0) = pack8(v0, v1);
                    } } }
    }
};
struct EpiUQ { static constexpr bool PERM = true;
    bf16_t* Q; const float* PART;
    __device__ __forceinline__ void operator()(const acc_t& acc, const pg8::Unit& u, int wr, int wc, int fr, int fq) const {
        asm volatile("" : "+v"(fr), "+v"(fq));
        const int row0 = u.pm * 256 + wr * 64 + fr;
#pragma unroll
        for (int ai = 0; ai < 2; ++ai)
#pragma unroll
            for (int m = 0; m < 4; ++m) { asm volatile("" ::: "memory"); const int row = row0 + ai * 128 + m * 16; const int b = row >> 11, l = row & 2047;
                const f32x4* pp = (const f32x4*)(PART + (size_t)row * 20); const f32x4 p0 = pp[0], p1 = pp[1], p2 = pp[2];
                const float ssq = ((p0[0] + p0[1]) + (p0[2] + p0[3])) + ((p1[0] + p1[1]) + (p1[2] + p1[3])) + ((p2[0] + p2[1]) + (p2[2] + p2[3]));
                const float sc = rsqrtf(ssq * (1.f / 384.f) + LN_EPS) * QSCALE;
#pragma unroll
                for (int bj = 0; bj < 2; ++bj) { const f32x4 v0 = acc[ai][bj][m][0] * sc, v1 = acc[ai][bj][m][1] * sc;
                    const int g0 = u.pn * 256 + bj * 128 + wc * 32;
                    const int head = g0 / 192, w0 = g0 - head * 192;
                    *(u32x4*)(Q + ((size_t)(b * NH + head) * SEQ + l) * DK + w0 + 8 * fq) = pack8(v0, v1);
                } }
    }
};
struct EpiUKV { static constexpr bool PERM = true;
    bf16_t* KN; bf16_t* V; const float* PART;
    __device__ __forceinline__ void operator()(const acc_t& acc, const pg8::Unit& u, int wr, int wc, int fr, int fq) const {
        asm volatile("" : "+v"(fr), "+v"(fq));
        const int row0 = u.pm * 256 + wr * 64 + fr;
#pragma unroll
        for (int ai = 0; ai < 2; ++ai)
#pragma unroll
            for (int m = 0; m < 4; ++m) { asm volatile("" ::: "memory"); const int row = row0 + ai * 128 + m * 16;
                int b, key; if (row < MLAT) { b = row >> 11; key = CTXL + (row & 2047); } else { const int r2 = row - MLAT; b = r2 >> 8; key = r2 & 255; }
                const f32x4* pp = (const f32x4*)(PART + (size_t)row * 20 + 12); const f32x4 p0 = pp[0], p1 = pp[1];
                const float ssq = ((p0[0] + p0[1]) + (p0[2] + p0[3])) + ((p1[0] + p1[1]) + (p1[2] + p1[3]));
                const float sc = rsqrtf(ssq * (1.f / 256.f) + LN_EPS);
#pragma unroll
                for (int bj = 0; bj < 2; ++bj) { const f32x4 v0 = acc[ai][bj][m][0] * sc, v1 = acc[ai][bj][m][1] * sc;
                    const int head = u.pn; bf16_t* dst = (bj == 0) ? KN : V;
                    *(u32x4*)(dst + ((size_t)(b * NH + head) * NKEY + key) * 128 + wc * 32 + 8 * fq) = pack8(v0, v1);
                } }
    }
};
struct EpiGLU { static constexpr bool PERM = true;
    const bf16_t* ATT; const bf16_t* GATES; bf16_t* MERGED;
    __device__ __forceinline__ void operator()(const acc_t& acc, const pg8::Unit& u, int wr, int wc, int fr, int fq) const {
        asm volatile("" : "+v"(fr), "+v"(fq));
        const int row0 = u.pm * 256 + wr * 64 + fr; const int head = u.pn, d0 = wc * 32 + 8 * fq, j0 = head * 128 + d0;
#define GLU_LD(it_, AT, GS) do { const int row_ = row0 + ((it_) >> 2) * 128 + ((it_) & 3) * 16; const int b_ = row_ >> 11, l_ = row_ & 2047; \
        AT = *(const u32x4*)(ATT + ((size_t)(b_ * NH + head) * SEQ + (l_ & ~255)) * DK + (l_ & 255) * 128 + d0); GS = *(const u32x4*)(GATES + (size_t)row_ * 2048 + 1024 + j0); } while (0)
        u32x4 atn, gsn; GLU_LD(0, atn, gsn);
#pragma unroll
        for (int it = 0; it < 8; ++it) { const int ai = it >> 2, m = it & 3, row = row0 + ai * 128 + m * 16;
            const u32x4 at = atn, gs = gsn;
            if (it + 1 < 8) GLU_LD(it + 1, atn, gsn);
            asm volatile("" ::: "memory");
            const f32x4 a0 = acc[ai][0][m][0], a1 = acc[ai][0][m][1], b0 = acc[ai][1][m][0], b1 = acc[ai][1][m][1];
            f32x4 o0, o1;
#define GLU1(o, a, bb, atw, gsw, e0) o[e0] = bf_lo(atw) + bf_lo(gsw) * a[e0] * sigmoidf_(bb[e0]); o[e0 + 1] = bf_hi(atw) + bf_hi(gsw) * a[e0 + 1] * sigmoidf_(bb[e0 + 1]);
            GLU1(o0, a0, b0, at.x, gs.x, 0) GLU1(o0, a0, b0, at.y, gs.y, 2) GLU1(o1, a1, b1, at.z, gs.z, 0) GLU1(o1, a1, b1, at.w, gs.w, 2)
#undef GLU1
            *(u32x4*)(MERGED + (size_t)row * 1024 + j0) = pack8(o0, o1);
        }
#undef GLU_LD
    }
};
struct EpiOut { static constexpr bool PERM = true;
    const float* X; const float* MOD; bf16_t* T;
    __device__ __forceinline__ void operator()(const acc_t& acc, const pg8::Unit& u, int wr, int wc, int fr, int fq) const {
        asm volatile("" : "+v"(fr), "+v"(fq));
        const int row0 = u.pm * 256 + wr * 64 + fr, c0 = u.pn * 256 + wc * 32 + 8 * fq;
        const float* gpb = MOD + (size_t)(row0 >> 11) * 6144 + 2048 + c0;
        const f32x4 g00 = *(const f32x4*)gpb, g01 = *(const f32x4*)(gpb + 4), g10 = *(const f32x4*)(gpb + 128), g11 = *(const f32x4*)(gpb + 132);
#define OUT_LD(it_, X00, X01, X10, X11) do { const float* xp_ = X + (size_t)(row0 + ((it_) >> 2) * 128 + ((it_) & 3) * 16) * DM + c0; \
        X00 = *(const f32x4*)xp_; X01 = *(const f32x4*)(xp_ + 4); X10 = *(const f32x4*)(xp_ + 128); X11 = *(const f32x4*)(xp_ + 132); } while (0)
        f32x4 n00, n01, n10, n11; OUT_LD(0, n00, n01, n10, n11);
#pragma unroll
        for (int it = 0; it < 8; ++it) { const int ai = it >> 2, m = it & 3, row = row0 + ai * 128 + m * 16;
            const f32x4 x00 = n00, x01 = n01, x10 = n10, x11 = n11;
            if (it + 1 < 8) OUT_LD(it + 1, n00, n01, n10, n11);
            asm volatile("" ::: "memory");
            { const f32x4 t0 = x00 * ALPHA + g00 * acc[ai][0][m][0], t1 = x01 * ALPHA + g01 * acc[ai][0][m][1];
              u32x4 w; w.x = cvt_pk_bf16(t0[0], t0[1]); w.y = cvt_pk_bf16(t0[2], t0[3]); w.z = cvt_pk_bf16(t1[0], t1[1]); w.w = cvt_pk_bf16(t1[2], t1[3]);
              *(u32x4*)(T + (size_t)row * DM + c0) = w; }
            { const f32x4 t0 = x10 * ALPHA + g10 * acc[ai][1][m][0], t1 = x11 * ALPHA + g11 * acc[ai][1][m][1];
              u32x4 w; w.x = cvt_pk_bf16(t0[0], t0[1]); w.y = cvt_pk_bf16(t0[2], t0[3]); w.z = cvt_pk_bf16(t1[0], t1[1]); w.w = cvt_pk_bf16(t1[2], t1[3]);
              *(u32x4*)(T + (size_t)row * DM + c0 + 128) = w; }
        }
#undef OUT_LD
    }
};
struct EpiPQ { static constexpr bool PERM = true;
    bf16_t* PQ;
    __device__ __forceinline__ void operator()(const acc_t& acc, const pg8::Unit& u, int wr, int wc, int fr, int fq) const {
        asm volatile("" : "+v"(fr), "+v"(fq));
        const int row0 = u.pm * 256 + wr * 64 + fr;
#pragma unroll
        for (int ai = 0; ai < 2; ++ai)
#pragma unroll
            for (int m = 0; m < 4; ++m) { const int row = row0 + ai * 128 + m * 16;
#pragma unroll
                for (int bj = 0; bj < 2; ++bj) *(u32x4*)(PQ + (size_t)row * 2048 + u.pn * 256 + bj * 128 + wc * 32 + 8 * fq) = pack8(acc[ai][bj][m][0], acc[ai][bj][m][1]); }
    }
};

#define XB_TMO      128
#define XB_XCNT(j)  (256  + 64 * (j))
#define XB_XSUB(j)  (1280 + 64 * (j))
#define XB_XGEN(j)  (2304 + 64 * (j))
#define XB_TOP      3328
#define XB_TOPGEN   3392
#define XCD_BAR_WORDS 3456
#define XB_SPIN_CAP (1u << 22)
__device__ __forceinline__ unsigned xb_ld(unsigned* p)              { return __hip_atomic_load(p, __ATOMIC_RELAXED, __HIP_MEMORY_SCOPE_AGENT); }
__device__ __forceinline__ unsigned xb_add(unsigned* p, unsigned v) { return __hip_atomic_fetch_add(p, v, __ATOMIC_RELAXED, __HIP_MEMORY_SCOPE_AGENT); }
__device__ __forceinline__ unsigned xb_xcc_id() { return (unsigned)__builtin_amdgcn_s_getreg((3 << 11) | 20) & 0xFu; }
#define XB_SPIN(cond, bar) do { unsigned _sp = 0; while (cond) { __builtin_amdgcn_s_sleep(1); \
    if ((++_sp & 255u) == 0u) { if (xb_ld(&(bar)[XB_TMO])) break; if (_sp > XB_SPIN_CAP) { atomicAdd(&(bar)[XB_TMO], 1u); break; } } } } while (0)
struct XcdBarrier { unsigned* bar; unsigned x; volatile LAS unsigned* st; };
__device__ __forceinline__ XcdBarrier xcd_barrier_post(unsigned* bar, volatile LAS unsigned* st, int tid) {
    XcdBarrier b; b.bar = bar; b.x = xb_xcc_id(); b.st = st;
    if (tid == 0) (void)xb_add(&bar[XB_XCNT(b.x)], 1u);
    return b;
}
__device__ __forceinline__ void xcd_barrier_complete(unsigned* bar, unsigned x, unsigned& nloc, unsigned& nx) {
    const unsigned G = gridDim.x * gridDim.y * gridDim.z;
    unsigned sum, cnt, mine, sp = 0u;
    for (;;) {
        sum = 0u; cnt = 0u; mine = 0u;
#pragma unroll
        for (unsigned j = 0; j < 16; ++j) { const unsigned c = xb_ld(&bar[XB_XCNT(j)]); sum += c; cnt += (c > 0u) ? 1u : 0u; mine = (j == x) ? c : mine; }
        if (sum == G) break;
        __builtin_amdgcn_s_sleep(1);
        if ((++sp & 255u) == 0u) { if (xb_ld(&bar[XB_TMO])) break; if (sp > XB_SPIN_CAP) { atomicAdd(&bar[XB_TMO], 1u); break; } }
    }
    nloc = mine > 0u ? mine : 1u; nx = cnt > 0u ? cnt : 1u;
}
__device__ __forceinline__ void xcd_barrier(const XcdBarrier& b, int tid) {
    asm volatile("s_waitcnt vmcnt(0)" ::: "memory");
    __syncthreads();
    if (tid == 0) {
        unsigned* bar = b.bar;
        __builtin_amdgcn_s_waitcnt(0);
        unsigned nloc = b.st[0], nx = b.st[1];
        if (nloc == 0u) { xcd_barrier_complete(bar, b.x, nloc, nx); b.st[0] = nloc; b.st[1] = nx; }
        const unsigned old = xb_add(&bar[XB_XSUB(b.x)], 1u);
        const unsigned gen = old / nloc;
        if (old + 1u == (gen + 1u) * nloc) {
            __builtin_amdgcn_fence(__ATOMIC_RELEASE, "agent");
            asm volatile("s_waitcnt vmcnt(0)" ::: "memory");
            const unsigned og = xb_add(&bar[XB_TOP], 1u);
            const unsigned tg = og / nx;
            if (og + 1u == (tg + 1u) * nx) xb_add(&bar[XB_TOPGEN], 1u);
            else XB_SPIN(xb_ld(&bar[XB_TOPGEN]) == tg, bar);
            __builtin_amdgcn_fence(__ATOMIC_ACQUIRE, "agent");
            xb_add(&bar[XB_XGEN(b.x)], 1u);
            asm volatile("s_waitcnt vmcnt(0)" ::: "memory");
        } else {
            XB_SPIN(xb_ld(&bar[XB_XGEN(b.x)]) == gen, bar);
            __builtin_amdgcn_fence(__ATOMIC_ACQUIRE, "agent");
            asm volatile("s_waitcnt vmcnt(0)" ::: "memory");
        }
    }
    __syncthreads();
}

__device__ __forceinline__ void transpose_item(const float* W, int ldw, int k0, int nsrc0, bf16_t* WT, int ldt, int ndst0, const float* gk, LAS float* scr, int lane) {
    if (nsrc0 >= 0) {
#pragma unroll 8
        for (int i = 0; i < 32; ++i) { const int kk = 2 * i + (lane >> 5); float v = W[(size_t)(k0 + kk) * ldw + nsrc0 + (lane & 31)]; if (gk) v *= gk[k0 + kk]; scr[kk * 33 + (lane & 31)] = v; }
    } else {
#pragma unroll 8
        for (int i = 0; i < 32; ++i) { const int kk = 2 * i + (lane >> 5); scr[kk * 33 + (lane & 31)] = 0.f; }
    }
    LDS_WAIT(); asm volatile("" ::: "memory");
    const int c = lane & 7;
#pragma unroll
    for (int j = 0; j < 4; ++j) { const int n = (lane >> 3) + 8 * j; const LAS float* s = scr + (8 * c) * 33 + n;
        u32x4 o; o.x = cvt_pk_bf16(s[0 * 33], s[1 * 33]); o.y = cvt_pk_bf16(s[2 * 33], s[3 * 33]); o.z = cvt_pk_bf16(s[4 * 33], s[5 * 33]); o.w = cvt_pk_bf16(s[6 * 33], s[7 * 33]);
        *(u32x4*)(WT + (size_t)(ndst0 + n) * ldt + k0 + 8 * c) = o; }
    LDS_WAIT(); asm volatile("" ::: "memory");
}
__device__ __forceinline__ void modulate_row(const float* xrow, const float* sh, const float* sc, bf16_t* orow, int lane) {
    const f32x4* xr = (const f32x4*)xrow + lane; f32x4 v[4]; float s = 0.f;
#pragma unroll
    for (int j = 0; j < 4; ++j) { v[j] = xr[64 * j]; s += (v[j][0] + v[j][1]) + (v[j][2] + v[j][3]); }
    const float mean = wave_sum(s) * (1.f / DM); float s2 = 0.f;
#pragma unroll
    for (int j = 0; j < 4; ++j) { v[j] = v[j] - mean; s2 += (v[j][0] * v[j][0] + v[j][1] * v[j][1]) + (v[j][2] * v[j][2] + v[j][3] * v[j][3]); }
    const float rstd = rsqrtf(wave_sum(s2) * (1.f / DM) + LN_EPS);
    u32x2* o8 = (u32x2*)orow + lane;
#pragma unroll
    for (int j = 0; j < 4; ++j) { const f32x4 a = ((const f32x4*)sc)[64 * j + lane], b = ((const f32x4*)sh)[64 * j + lane]; const f32x4 y = v[j] * rstd * (a + 1.f) + b;
        u32x2 w; w.x = cvt_pk_bf16(y[0], y[1]); w.y = cvt_pk_bf16(y[2], y[3]); o8[64 * j] = w; }
}
__device__ __forceinline__ void modulate_row_r(f32x4 (&v)[4], const f32x4 (&a1)[4], const f32x4 (&bs)[4], bf16_t* orow, int lane) {
    float s = 0.f;
#pragma unroll
    for (int j = 0; j < 4; ++j) s += (v[j][0] + v[j][1]) + (v[j][2] + v[j][3]);
    const float mean = wave_sum(s) * (1.f / DM); float s2 = 0.f;
#pragma unroll
    for (int j = 0; j < 4; ++j) { v[j] = v[j] - mean; s2 += (v[j][0] * v[j][0] + v[j][1] * v[j][1]) + (v[j][2] * v[j][2] + v[j][3] * v[j][3]); }
    const float rstd = rsqrtf(wave_sum(s2) * (1.f / DM) + LN_EPS);
    u32x2* o8 = (u32x2*)orow + lane;
#pragma unroll
    for (int j = 0; j < 4; ++j) { const f32x4 y = v[j] * rstd * (a1[j] + 1.f) + bs[j]; u32x2 w; w.x = cvt_pk_bf16(y[0], y[1]); w.y = cvt_pk_bf16(y[2], y[3]); o8[64 * j] = w; }
}
__device__ __forceinline__ void modulate_row_v(f32x4 (&v)[4], const float* sh, const float* sc, bf16_t* orow, int lane) {
    float s = 0.f;
#pragma unroll
    for (int j = 0; j < 4; ++j) s += (v[j][0] + v[j][1]) + (v[j][2] + v[j][3]);
    const float mean = wave_sum(s) * (1.f / DM); float s2 = 0.f;
#pragma unroll
    for (int j = 0; j < 4; ++j) { v[j] = v[j] - mean; s2 += (v[j][0] * v[j][0] + v[j][1] * v[j][1]) + (v[j][2] * v[j][2] + v[j][3] * v[j][3]); }
    const float rstd = rsqrtf(wave_sum(s2) * (1.f / DM) + LN_EPS);
    u32x2* o8 = (u32x2*)orow + lane;
#pragma unroll
    for (int j = 0; j < 4; ++j) { const f32x4 a = ((const f32x4*)sc)[64 * j + lane], b = ((const f32x4*)sh)[64 * j + lane]; const f32x4 y = v[j] * rstd * (a + 1.f) + b;
        u32x2 w; w.x = cvt_pk_bf16(y[0], y[1]); w.y = cvt_pk_bf16(y[2], y[3]); o8[64 * j] = w; }
}
__device__ __forceinline__ void ln1_row(f32x4 (&v)[4], float* stat, const f32x4 (&g1v)[4], const f32x4 (&b1v)[4], const f32x4 (&a1)[4], const f32x4 (&bs)[4], bf16_t* orow, int lane) {
    float s = 0.f;
#pragma unroll
    for (int j = 0; j < 4; ++j) s += (v[j][0] + v[j][1]) + (v[j][2] + v[j][3]);
    float mean = wave_sum(s) * (1.f / DM); float s2 = 0.f;
#pragma unroll
    for (int j = 0; j < 4; ++j) { v[j] = v[j] - mean; s2 += (v[j][0] * v[j][0] + v[j][1] * v[j][1]) + (v[j][2] * v[j][2] + v[j][3] * v[j][3]); }
    float rstd = rsqrtf(wave_sum(s2) * (1.f / DM) + LN_EPS);
    s = 0.f;
    if (lane == 0) { stat[0] = mean; stat[1] = rstd; }
#pragma unroll
    for (int j = 0; j < 4; ++j) { v[j] = v[j] * rstd * g1v[j] + b1v[j]; s += (v[j][0] + v[j][1]) + (v[j][2] + v[j][3]); }
    mean = wave_sum(s) * (1.f / DM); s2 = 0.f;
#pragma unroll
    for (int j = 0; j < 4; ++j) { v[j] = v[j] - mean; s2 += (v[j][0] * v[j][0] + v[j][1] * v[j][1]) + (v[j][2] * v[j][2] + v[j][3] * v[j][3]); }
    rstd = rsqrtf(wave_sum(s2) * (1.f / DM) + LN_EPS);
    u32x2* o8 = (u32x2*)orow + lane;
#pragma unroll
    for (int j = 0; j < 4; ++j) { const f32x4 y = v[j] * rstd * (a1[j] + 1.f) + bs[j]; u32x2 w; w.x = cvt_pk_bf16(y[0], y[1]); w.y = cvt_pk_bf16(y[2], y[3]); o8[64 * j] = w; }
}

__device__ __forceinline__ int s5_row(int d, int b, int s) {
    if (d == 0) return (s < CTXL) ? (MLAT + b * CTXL + s) : (b * SEQ + (s - CTXL));
    return (s < CTXL) ? (MLAT + b * CTXL + (CTXL - 1 - s)) : (b * SEQ + (SEQ - 1 - (s - CTXL)));
}
typedef const LAS unsigned char* lds_cptr;
__device__ __forceinline__ s16x4 vtr(lds_cptr p) { return __builtin_bit_cast(s16x4, __builtin_amdgcn_ds_read_tr16_b64_v4i16((LAS v4i16_t*)p)); }
__device__ __forceinline__ void s5_passA(const bf16_t* __restrict__ SU, const float* __restrict__ ABAR, const bf16_t* __restrict__ BB, float* __restrict__ E, int unit, int lane) {
    asm volatile("" : "+v"(lane));
    const int rest = unit >> 2, j = rest & 7, bp = (rest >> 3) & 7, g = ((rest >> 6) & 7) * 4 + (unit & 3), d = rest >> 9;
    const int r = lane & 31, hA = lane >> 5;
    const int bA = 2 * bp + ((r >> 2) & 1), ti = (r & 3) + 4 * (r >> 3);
    const int s_begin = 256 * j, s_end = s_begin + 256;
    const bf16_t* bbp = BB + (size_t)((d * 32 + g) * 2) * 64 * 16;
    const bf16x8 bre0 = *(const bf16x8*)(bbp + (r * 16 + 8 * hA)), bre1 = *(const bf16x8*)(bbp + ((32 + r) * 16 + 8 * hA));
    const bf16x8 bim0 = *(const bf16x8*)(bbp + ((64 + r) * 16 + 8 * hA)), bim1 = *(const bf16x8*)(bbp + ((96 + r) * 16 + 8 * hA));
    const float* ab = ABAR + (size_t)(d * 32 + g) * 128;
    const float ar0 = ab[2 * r], ai0 = ab[2 * r + 1], ar1 = ab[2 * (32 + r)], ai1 = ab[2 * (32 + r) + 1];
    float hr0 = 0.f, hi0 = 0.f, hr1 = 0.f, hi1 = 0.f;
    bf16x8 ua = *(const bf16x8*)(SU + (size_t)s5_row(d, bA, s_begin + ti) * 512 + g * 16 + 8 * hA);
    for (int s0 = s_begin; s0 < s_end; s0 += 16) {
        const int sn = (s0 + 16 < s_end) ? s0 + 16 : s0;
        const bf16x8 un = *(const bf16x8*)(SU + (size_t)s5_row(d, bA, sn + ti) * 512 + g * 16 + 8 * hA);
        const f32x16 z = {};
        __builtin_amdgcn_sched_barrier(0);
        const f32x16 ur0 = MFMA32(ua, bre0, z), ur1 = MFMA32(ua, bre1, z), ui0 = MFMA32(ua, bim0, z), ui1 = MFMA32(ua, bim1, z);
        MFMA_PAD();
#pragma unroll
        for (int i = 0; i < 16; ++i) {
            const float nr0 = fmaf(ar0, hr0, fmaf(-ai0, hi0, ur0[i])), ni0 = fmaf(ar0, hi0, fmaf(ai0, hr0, ui0[i])); hr0 = nr0; hi0 = ni0;
            const float nr1 = fmaf(ar1, hr1, fmaf(-ai1, hi1, ur1[i])), ni1 = fmaf(ar1, hi1, fmaf(ai1, hr1, ui1[i])); hr1 = nr1; hi1 = ni1;
        }
        ua = un;
    }
    const int b = 2 * bp + (lane >> 5);
    float* e = E + (size_t)(((d * 32 + g) * 16 + b) * 8 + j) * 128;
    e[r] = hr0; e[32 + r] = hr1; e[64 + r] = hi0; e[96 + r] = hi1;
}
constexpr int S5_HT_PITCH = 80;
constexpr int S5_LDS_WAVE = 128 * S5_HT_PITCH;
__device__ __forceinline__ void s5_passB(const bf16_t* __restrict__ SU, const float* __restrict__ ABAR, const float* __restrict__ POW, const bf16_t* __restrict__ BB, const bf16_t* __restrict__ CM,
                                         const float* __restrict__ E, const float* __restrict__ DSK, bf16_t* Y, int unit, int lane, LAS unsigned char* ht) {
    asm volatile("" : "+v"(lane));
    const int k = (unit >> 2) & 7, bp = (unit >> 5) & 7, g = (unit >> 8) * 4 + (unit & 3);
    const int r = lane & 31, hA = lane >> 5;
    const int bA = 2 * bp + ((r >> 2) & 1), ti = (r & 3) + 4 * (r >> 3);
    const int bS = 2 * bp + hA;
    const int G4 = lane >> 4, q4 = (lane & 15) >> 2, p4 = lane & 3;
    const lds_cptr trb = (lds_cptr)ht + (8 * hA + q4) * S5_HT_PITCH + (16 * (G4 & 1) + 4 * p4) * 2;
    const int bO = 2 * bp + (r >> 4), tO = r & 15;
    const f32x4 d0 = *(const f32x4*)(DSK + g * 16 + 4 * hA), d1 = *(const f32x4*)(DSK + g * 16 + 8 + 4 * hA);
#pragma unroll 1
    for (int d = 0; d < 2; ++d) {
        const int j = d == 0 ? k : 7 - k;
        const int s_begin = CTXL + 256 * j, s_end = s_begin + 256;
        const bf16_t* bbp = BB + (size_t)((d * 32 + g) * 2) * 64 * 16;
        const bf16x8 bre0 = *(const bf16x8*)(bbp + (r * 16 + 8 * hA)), bre1 = *(const bf16x8*)(bbp + ((32 + r) * 16 + 8 * hA));
        const bf16x8 bim0 = *(const bf16x8*)(bbp + ((64 + r) * 16 + 8 * hA)), bim1 = *(const bf16x8*)(bbp + ((96 + r) * 16 + 8 * hA));
        const float* ab = ABAR + (size_t)(d * 32 + g) * 128;
        const float ar0 = ab[2 * r], ai0 = ab[2 * r + 1], ar1 = ab[2 * (32 + r)], ai1 = ab[2 * (32 + r) + 1];
        bf16x8 cm[8];
#pragma unroll
        for (int ks = 0; ks < 8; ++ks) { cm[ks] = (bf16x8){0, 0, 0, 0, 0, 0, 0, 0}; if (r < 16) cm[ks] = *(const bf16x8*)(CM + ((size_t)((d * 32 + g) * 16 + r) * 128 + 16 * ks + 8 * hA)); }
        float hr0 = 0.f, hi0 = 0.f, hr1 = 0.f, hi1 = 0.f;
        { const float* e = E + (size_t)(((d * 32 + g) * 16 + bS) * 8) * 128;
          const float* pw = POW + ((size_t)(d * 32 + g) * 64) * 2;
          const float pr0 = pw[2 * r], pi0 = pw[2 * r + 1], pr1 = pw[2 * (32 + r)], pi1 = pw[2 * (32 + r) + 1];
          float er0[8], er1[8], ei0[8], ei1[8];
#pragma unroll
          for (int jj = 0; jj < 8; ++jj) { er0[jj] = e[jj * 128 + r]; er1[jj] = e[jj * 128 + 32 + r]; ei0[jj] = e[jj * 128 + 64 + r]; ei1[jj] = e[jj * 128 + 96 + r]; }
#pragma unroll
          for (int jj = 0; jj < 8; ++jj) if (jj <= j) {
              const float nr0 = pr0 * hr0 - pi0 * hi0 + er0[jj], ni0 = pr0 * hi0 + pi0 * hr0 + ei0[jj]; hr0 = nr0; hi0 = ni0;
              const float nr1 = pr1 * hr1 - pi1 * hi1 + er1[jj], ni1 = pr1 * hi1 + pi1 * hr1 + ei1[jj]; hr1 = nr1; hi1 = ni1; } }
        bf16x8 ua = *(const bf16x8*)(SU + (size_t)s5_row(d, bA, s_begin + ti) * 512 + g * 16 + 8 * hA);
        for (int s0 = s_begin; s0 < s_end; s0 += 16) {
            const int sn = (s0 + 16 < s_end) ? s0 + 16 : s0;
            const bf16x8 un = *(const bf16x8*)(SU + (size_t)s5_row(d, bA, sn + ti) * 512 + g * 16 + 8 * hA);
            const f32x16 z = {};
            const int row = s5_row(d, bO, (s0 >= CTXL ? s0 : CTXL) + tO);
            const bf16_t* pre = (d == 0 ? SU : (const bf16_t*)Y) + (size_t)row * 512 + g * 16 + 4 * hA;
            const u32x2 pre0 = *(const u32x2*)pre, pre1 = *(const u32x2*)(pre + 8);
            __builtin_amdgcn_sched_barrier(0);
            f32x16 ur0 = MFMA32(ua, bre0, z), ur1 = MFMA32(ua, bre1, z), ui0 = MFMA32(ua, bim0, z), ui1 = MFMA32(ua, bim1, z);
            MFMA_PAD();
#pragma unroll
            for (int i = 0; i < 16; ++i) {
                const float nr0 = fmaf(ar0, hr0, fmaf(-ai0, hi0, ur0[i])), ni0 = fmaf(ar0, hi0, fmaf(ai0, hr0, ui0[i])); hr0 = nr0; hi0 = ni0; ur0[i] = nr0; ui0[i] = ni0;
                const float nr1 = fmaf(ar1, hr1, fmaf(-ai1, hi1, ur1[i])), ni1 = fmaf(ar1, hi1, fmaf(ai1, hr1, ui1[i])); hr1 = nr1; hi1 = ni1; ur1[i] = nr1; ui1[i] = ni1;
            }
            if (s0 >= CTXL) {
#define S5_WR(V, R) do { LAS unsigned char* wp = ht + (R) * S5_HT_PITCH + hA * 32; \
                    u32x4 w0, w1; w0.x = cvt_pk_bf16(V[0], V[1]); w0.y = cvt_pk_bf16(V[2], V[3]); w0.z = cvt_pk_bf16(V[4], V[5]); w0.w = cvt_pk_bf16(V[6], V[7]); \
                    w1.x = cvt_pk_bf16(V[8], V[9]); w1.y = cvt_pk_bf16(V[10], V[11]); w1.z = cvt_pk_bf16(V[12], V[13]); w1.w = cvt_pk_bf16(V[14], V[15]); \
                    *(LAS u32x4*)wp = w0; *(LAS u32x4*)(wp + 16) = w1; } while (0)
                S5_WR(ur0, r); S5_WR(ur1, 32 + r); S5_WR(ui0, 64 + r); S5_WR(ui1, 96 + r);
#undef S5_WR
                LDS_WAIT();
                f32x16 ya = {}, yb = {};
#pragma unroll
                for (int ks = 0; ks < 8; ++ks) {
                    const s16x4 lo = vtr(trb + (16 * ks) * S5_HT_PITCH), hi = vtr(trb + (16 * ks + 4) * S5_HT_PITCH);
                    const bf16x8 bfrag = (bf16x8){lo[0], lo[1], lo[2], lo[3], hi[0], hi[1], hi[2], hi[3]};
                    if (ks & 1) yb = MFMA32(cm[ks], bfrag, yb); else ya = MFMA32(cm[ks], bfrag, ya);
                }
                MFMA_PAD();
#pragma unroll
                for (int i = 0; i < 8; ++i) ya[i] += yb[i];
                bf16_t* yp = Y + (size_t)row * 512 + g * 16 + 4 * hA;
                if (d == 0) {
                    const u32x2 u0 = pre0, u1 = pre1;
                    u32x2 o0, o1;
                    o0.x = cvt_pk_bf16(ya[0] + d0[0] * bf_lo(u0.x), ya[1] + d0[1] * bf_hi(u0.x)); o0.y = cvt_pk_bf16(ya[2] + d0[2] * bf_lo(u0.y), ya[3] + d0[3] * bf_hi(u0.y));
                    o1.x = cvt_pk_bf16(ya[4] + d1[0] * bf_lo(u1.x), ya[5] + d1[1] * bf_hi(u1.x)); o1.y = cvt_pk_bf16(ya[6] + d1[2] * bf_lo(u1.y), ya[7] + d1[3] * bf_hi(u1.y));
                    *(u32x2*)yp = o0; *(u32x2*)(yp + 8) = o1;
                } else {
                    const u32x2 f0 = pre0, f1 = pre1;
                    u32x2 o0, o1;
                    o0.x = cvt_pk_bf16(gelu_tanh(ya[0] + bf_lo(f0.x)), gelu_tanh(ya[1] + bf_hi(f0.x))); o0.y = cvt_pk_bf16(gelu_tanh(ya[2] + bf_lo(f0.y)), gelu_tanh(ya[3] + bf_hi(f0.y)));
                    o1.x = cvt_pk_bf16(gelu_tanh(ya[4] + bf_lo(f1.x)), gelu_tanh(ya[5] + bf_hi(f1.x))); o1.y = cvt_pk_bf16(gelu_tanh(ya[6] + bf_lo(f1.y)), gelu_tanh(ya[7] + bf_hi(f1.y)));
                    *(u32x2*)yp = o0; *(u32x2*)(yp + 8) = o1;
                }
                LDS_WAIT();
            }
            ua = un;
        }
        VM_WAIT();
    }
}

namespace att {
constexpr int NW = 8, QBLK = 32, KVBLK = 64;
constexpr int SHM_V = KVBLK * 128 * 2, SHM_K = KVBLK * DK * 2;
constexpr int OFF_V = 0, OFF_K = 2 * SHM_V, OFF_WS = OFF_K + 2 * SHM_K, OFF_QPE = OFF_WS + NW * 64 * 4, LDS_BYTES = OFF_QPE + NW * 4096;
constexpr float THRL = 8.f * 1.4426950408889634f;
#define KSWZ(row, colB) ((row) * 384 + ((colB) ^ (((row) & 7) << 4)))
#define SBAR() __builtin_amdgcn_sched_barrier(0)
__device__ __forceinline__ int crow(int r, int hi) { return (r & 3) + 8 * (r >> 2) + 4 * hi; }
__device__ __forceinline__ void partialSM(f32x16& p0, f32x16& p1, float& m_reg, float& mn, float& alpha) {
    float pmax = p0[0];
#pragma unroll
    for (int r = 1; r < 16; ++r) pmax = fmaxf(pmax, p0[r]);
#pragma unroll
    for (int r = 0; r < 16; ++r) pmax = fmaxf(pmax, p1[r]);
    { auto rr = __builtin_amdgcn_permlane32_swap(__float_as_uint(pmax), __float_as_uint(pmax), false, false);
      pmax = fmaxf(__uint_as_float(rr[0]), __uint_as_float(rr[1])); }
    if (__builtin_expect(__all(pmax - m_reg <= THRL), 1)) { mn = m_reg; alpha = 1.f; }
    else { mn = fmaxf(m_reg, pmax); alpha = __builtin_amdgcn_exp2f(m_reg - mn); m_reg = mn; }
#pragma unroll
    for (int r = 0; r < 16; ++r) p0[r] = p0[r] - mn;
#pragma unroll
    for (int r = 0; r < 16; ++r) p1[r] = p1[r] - mn;
#pragma unroll
    for (int r = 0; r < 16; ++r) p0[r] = __builtin_amdgcn_exp2f(p0[r]);
}
__device__ __forceinline__ void finishSM(f32x16& p0, f32x16& p1, float alpha, float& l_reg, bf16x8& pa0, bf16x8& pa1, bf16x8& pa2, bf16x8& pa3) {
#pragma unroll
    for (int r = 0; r < 16; ++r) p1[r] = __builtin_amdgcn_exp2f(p1[r]);
    float ps = 0;
#pragma unroll
    for (int r = 0; r < 16; ++r) ps += p0[r];
#pragma unroll
    for (int r = 0; r < 16; ++r) ps += p1[r];
    { auto rr = __builtin_amdgcn_permlane32_swap(__float_as_uint(ps), __float_as_uint(ps), false, false);
      ps = __uint_as_float(rr[0]) + __uint_as_float(rr[1]); }
    l_reg = l_reg * alpha + ps;
#define PK4(P, BASE, OUT) do { unsigned a0 = cvt_pk_bf16(P[BASE + 0], P[BASE + 1]), a1 = cvt_pk_bf16(P[BASE + 2], P[BASE + 3]);   \
    unsigned b0 = cvt_pk_bf16(P[BASE + 4], P[BASE + 5]), b1 = cvt_pk_bf16(P[BASE + 6], P[BASE + 7]);                              \
    auto r0 = __builtin_amdgcn_permlane32_swap(a0, b0, false, false); auto r1 = __builtin_amdgcn_permlane32_swap(a1, b1, false, false); \
    u32x4 w = {r0[0], r1[0], r0[1], r1[1]}; OUT = *reinterpret_cast<bf16x8*>(&w); } while (0)
    PK4(p0, 0, pa0); PK4(p0, 8, pa1); PK4(p1, 0, pa2); PK4(p1, 8, pa3);
#undef PK4
}
__device__ __forceinline__ void qkt(f32x16& p0, f32x16& p1, const char* Ks, const bf16x8* qr, const char* qpe, int r32, int hi) {
    p0 = f32x16{}; p1 = f32x16{};
#pragma unroll
    for (int d0 = 0; d0 < 12; ++d0) { const int cb = (d0 * 16 + hi * 8) * 2;
        const bf16x8 b0 = *reinterpret_cast<const bf16x8*>(Ks + KSWZ(r32, cb));
        const bf16x8 b1 = *reinterpret_cast<const bf16x8*>(Ks + KSWZ(32 + r32, cb));
        const bf16x8 q = d0 < 8 ? qr[d0 < 8 ? d0 : 0] : *reinterpret_cast<const bf16x8*>(qpe + (d0 - 8) * 1024);
        p0 = MFMA32(b0, q, p0);
        p1 = MFMA32(b1, q, p1); }
}
__device__ __forceinline__ int v_st(int k, int c) { const int kk = (k & ~0xC) | ((k & 4) << 1) | ((k & 8) >> 1); return ((kk >> 3) * 4 + (c >> 5)) * 512 + ((kk & 7) * 32 + (c & 31)) * 2; }
__device__ __forceinline__ int v_rd_base(int lane) { return ((lane & 3) << 3) | (((lane >> 2) & 3) << 6) | (((lane >> 4) & 1) << 5) | (((lane >> 5) & 1) << 8); }
constexpr int v_rd_off(int d0, int ks, int half) { return d0 * 512 + ks * 4096 + half * 2048; }
template <int OFF> __device__ __forceinline__ s16x4 tr_read(int vb) {
    s16x4 r; asm volatile("ds_read_b64_tr_b16 %0, %1 offset:%2" : "=&v"(r) : "v"(vb), "i"(OFF) : "memory"); return r;
}
template <int D0> __device__ __forceinline__ void pv_one(f32x16& od, int vb, bf16x8 pa0, bf16x8 pa1, bf16x8 pa2, bf16x8 pa3) {
    const s16x4 l0 = tr_read<v_rd_off(D0, 0, 0)>(vb), h0 = tr_read<v_rd_off(D0, 0, 1)>(vb), l1 = tr_read<v_rd_off(D0, 1, 0)>(vb), h1 = tr_read<v_rd_off(D0, 1, 1)>(vb);
    const s16x4 l2 = tr_read<v_rd_off(D0, 2, 0)>(vb), h2 = tr_read<v_rd_off(D0, 2, 1)>(vb), l3 = tr_read<v_rd_off(D0, 3, 0)>(vb), h3 = tr_read<v_rd_off(D0, 3, 1)>(vb);
    asm volatile("s_waitcnt lgkmcnt(0)" ::: "memory"); SBAR();
#define PK(L, H) (bf16x8){L[0], L[1], L[2], L[3], H[0], H[1], H[2], H[3]}
    od = MFMA32(pa0, PK(l0, h0), od);
    od = MFMA32(pa1, PK(l1, h1), od);
    od = MFMA32(pa2, PK(l2, h2), od);
    od = MFMA32(pa3, PK(l3, h3), od);
#undef PK
}
__device__ __forceinline__ void pv_d0(f32x16* o, int vb, bf16x8 pa0, bf16x8 pa1, bf16x8 pa2, bf16x8 pa3) {
    pv_one<0>(o[0], vb, pa0, pa1, pa2, pa3); pv_one<1>(o[1], vb, pa0, pa1, pa2, pa3); pv_one<2>(o[2], vb, pa0, pa1, pa2, pa3); pv_one<3>(o[3], vb, pa0, pa1, pa2, pa3);
}
__device__ __forceinline__ void attn_unit(bf16_t* Qu, const bf16_t* __restrict__ Kh, const bf16_t* __restrict__ Pb, const bf16_t* __restrict__ Vh, const bf16_t* __restrict__ Gm, const float* __restrict__ ROPEt, int l0, char* lds, int tid_) {
    asm volatile("" : "+v"(tid_));
    const int tid = tid_, wid = __builtin_amdgcn_readfirstlane(tid >> 6), lane = tid & 63, r32 = lane & 31, hi = lane >> 5;
    char* V_lds = lds + OFF_V; char* K_lds = lds + OFF_K;
    float* ws = (float*)(lds + OFF_WS) + wid * 64; float* li_l = ws; float* al_l = ws + 32;
    float m_reg = -1e30f, l_reg = 0; f32x16 o[4] = {}; bf16x8 qr[8]; char* qpe = lds + OFF_QPE + wid * 4096 + lane * 16;
    const bf16_t* Qw = Qu + (size_t)(wid * QBLK + r32) * DK + hi * 8;
#pragma unroll
    for (int d0 = 0; d0 < 8; ++d0) qr[d0] = *reinterpret_cast<const bf16x8*>(Qw + d0 * 16);
    { const int l = l0 + wid * QBLK + r32;
#pragma unroll
      for (int part = 0; part < 2; ++part) { const int pos = part == 0 ? (l >> 6) : (l & 63);
          const u32x4 x1 = *reinterpret_cast<const u32x4*>(Qw + (8 + 2 * part) * 16), x2 = *reinterpret_cast<const u32x4*>(Qw + (9 + 2 * part) * 16);
          const f32x4* tp = (const f32x4*)(ROPEt + (size_t)pos * 32 + hi * 16); const f32x4 t0 = tp[0], t1 = tp[1], t2 = tp[2], t3 = tp[3];
          u32x4 o1, o2;
#define ROT2(X1, X2, T, O1, O2) { const float a0 = bf_lo(X1), a1 = bf_hi(X1), b0 = bf_lo(X2), b1 = bf_hi(X2); \
          O1 = cvt_pk_bf16(a0 * T[0] - b0 * T[1], a1 * T[2] - b1 * T[3]); O2 = cvt_pk_bf16(b0 * T[0] + a0 * T[1], b1 * T[2] + a1 * T[3]); }
          ROT2(x1.x, x2.x, t0, o1.x, o2.x) ROT2(x1.y, x2.y, t1, o1.y, o2.y) ROT2(x1.z, x2.z, t2, o1.z, o2.z) ROT2(x1.w, x2.w, t3, o1.w, o2.w)
#undef ROT2
          *reinterpret_cast<u32x4*>(qpe + (2 * part) * 1024) = o1; *reinterpret_cast<u32x4*>(qpe + (2 * part + 1) * 1024) = o2; } }
    const int sr = tid >> 4, sc = (tid & 15) * 8, vst0 = v_st(sr, sc), vst1 = v_st(32 + sr, sc);
    const int pr = tid >> 3, pc = (tid & 7) * 8;
    const int vb0 = (int)(uintptr_t)V_lds + v_rd_base(lane);
    bf16x8 vs0, vs1, ks0, ks1, ps0;
    const unsigned go0 = (unsigned)(sr * 128 + sc) * 2u, go1 = go0 + 8192u, go2 = (unsigned)(pr * 64 + pc) * 2u;
#define SLOAD(k0) do { const char* vt_ = (const char*)Vh + (size_t)(k0) * 256; const char* kt_ = (const char*)Kh + (size_t)(k0) * 256; const char* pt_ = (const char*)Pb + (size_t)(k0) * 128; \
    vs0 = *(const bf16x8*)(vt_ + go0); vs1 = *(const bf16x8*)(vt_ + go1); ks0 = *(const bf16x8*)(kt_ + go0); ks1 = *(const bf16x8*)(kt_ + go1); \
    ps0 = *(const bf16x8*)(pt_ + go2); } while (0)
#define SWRITE(b) do { *(bf16x8*)(V_lds + (b) * SHM_V + vst0) = vs0; *(bf16x8*)(V_lds + (b) * SHM_V + vst1) = vs1; const int kc = sc * 2;  \
    *(bf16x8*)(K_lds + (b) * SHM_K + KSWZ(sr, kc)) = ks0; *(bf16x8*)(K_lds + (b) * SHM_K + KSWZ(32 + sr, kc)) = ks1;                       \
    *(bf16x8*)(K_lds + (b) * SHM_K + KSWZ(pr, 256 + pc * 2)) = ps0; } while (0)
#define SWAIT() asm volatile("s_waitcnt vmcnt(0)" ::: "memory")
#define RESC(a) do { if (__any((a) < 1.f)) { if (hi == 0) al_l[r32] = (a); asm volatile("s_waitcnt lgkmcnt(0)" ::: "memory"); \
    _Pragma("unroll") for (int d = 0; d < 4; ++d) _Pragma("unroll") for (int r = 0; r < 16; ++r) o[d][r] *= al_l[crow(r, hi)]; } } while (0)
    f32x16 pA0, pA1, pB0, pB1; float mnA, mnB, alA, alB; bf16x8 pa0, pa1, pa2, pa3; constexpr int NT = NKEY / KVBLK;
    SLOAD(0); SWAIT(); SWRITE(0); __syncthreads();
    qkt(pA0, pA1, K_lds, qr, qpe, r32, hi); partialSM(pA0, pA1, m_reg, mnA, alA);
    SLOAD(KVBLK);
    SWAIT(); SWRITE(1); __syncthreads();
    for (int j = 1; j + 1 < NT; j += 2) {
        SBAR(); qkt(pB0, pB1, K_lds + SHM_K, qr, qpe, r32, hi);
        finishSM(pA0, pA1, alA, l_reg, pa0, pa1, pa2, pa3); SBAR();
        SLOAD((j + 1) * KVBLK); SBAR();
        pv_d0(o, vb0, pa0, pa1, pa2, pa3); partialSM(pB0, pB1, m_reg, mnB, alB);
        __syncthreads(); SWAIT(); SWRITE(0);
        RESC(alB); __syncthreads();
        SBAR(); qkt(pA0, pA1, K_lds, qr, qpe, r32, hi);
        finishSM(pB0, pB1, alB, l_reg, pa0, pa1, pa2, pa3); SBAR();
        SLOAD((j + 2) * KVBLK); SBAR();
        pv_d0(o, vb0 + SHM_V, pa0, pa1, pa2, pa3); partialSM(pA0, pA1, m_reg, mnA, alA);
        __syncthreads(); SWAIT(); SWRITE(1);
        RESC(alA); __syncthreads();
    }
    SBAR(); qkt(pB0, pB1, K_lds + SHM_K, qr, qpe, r32, hi);
    finishSM(pA0, pA1, alA, l_reg, pa0, pa1, pa2, pa3); SBAR();
    pv_d0(o, vb0, pa0, pa1, pa2, pa3); partialSM(pB0, pB1, m_reg, mnB, alB);
    __syncthreads(); RESC(alB);
    finishSM(pB0, pB1, alB, l_reg, pa0, pa1, pa2, pa3); SBAR();
    pv_d0(o, vb0 + SHM_V, pa0, pa1, pa2, pa3);
    u32x4 gv[8];
    { const bf16_t* Gw = Gm + (size_t)(wid * QBLK) * 2048;
#pragma unroll
      for (int it = 0; it < 8; ++it) { const int idx = it * 64 + lane, row = idx >> 4, ch = idx & 15; gv[it] = *(const u32x4*)(Gw + (size_t)row * 2048 + ch * 8); } }
    if (hi == 0) li_l[r32] = l_reg; asm volatile("s_waitcnt lgkmcnt(0)" ::: "memory");
    __syncthreads();
    { char* ot = lds + wid * (32 * 272);
#pragma unroll
      for (int r = 0; r < 16; ++r) { const int orow = crow(r, hi); const float rl = __builtin_amdgcn_rcpf(li_l[orow]);
#pragma unroll
          for (int d0 = 0; d0 < 4; ++d0) *(bf16_t*)(ot + orow * 272 + (d0 * 32 + r32) * 2) = (bf16_t)(cvt_pk_bf16(o[d0][r] * rl, 0.f) & 0xffffu); }
      asm volatile("s_waitcnt lgkmcnt(0)" ::: "memory");
      bf16_t* Ow = Qu + (size_t)(wid * QBLK) * 128;
#pragma unroll
      for (int it = 0; it < 8; ++it) { const int idx = it * 64 + lane, row = idx >> 4, ch = idx & 15;
          const u32x4 ov = *(const u32x4*)(ot + row * 272 + ch * 16); const u32x4 g4 = gv[it];
          u32x4 w; w.x = cvt_pk_bf16(bf_lo(ov.x) * bf_lo(g4.x), bf_hi(ov.x) * bf_hi(g4.x)); w.y = cvt_pk_bf16(bf_lo(ov.y) * bf_lo(g4.y), bf_hi(ov.y) * bf_hi(g4.y));
          w.z = cvt_pk_bf16(bf_lo(ov.z) * bf_lo(g4.z), bf_hi(ov.z) * bf_hi(g4.z)); w.w = cvt_pk_bf16(bf_lo(ov.w) * bf_lo(g4.w), bf_hi(ov.w) * bf_hi(g4.w));
          *(u32x4*)(Ow + (size_t)row * 128 + ch * 8) = w; } }
    __syncthreads();
#undef SLOAD
#undef SWRITE
#undef SWAIT
#undef RESC
}
#undef KSWZ
#undef SBAR
}


namespace peer {
__device__ __forceinline__ int f2key(float f) { const int b = __builtin_bit_cast(int, f); return b ^ ((b >> 31) & 0x7fffffff); }
__device__ __forceinline__ float key2f(int k) { return __builtin_bit_cast(float, k ^ ((k >> 31) & 0x7fffffff)); }
__device__ __forceinline__ void ce_desc(int& a, int& b) { const int hi = a > b ? a : b, lo = a > b ? b : a; a = hi; b = lo; }
__device__ __forceinline__ void sort16_desc(int (&v)[16]) {
#pragma unroll
    for (int k = 2; k <= 16; k <<= 1)
#pragma unroll
        for (int j = k >> 1; j > 0; j >>= 1)
#pragma unroll
            for (int i = 0; i < 16; ++i) { const int l = i ^ j; if (l > i) { if ((i & k) == 0) ce_desc(v[i], v[l]); else ce_desc(v[l], v[i]); } }
}
__device__ __forceinline__ void merge_top16(int (&a)[16], const int (&b)[16]) {
#pragma unroll
    for (int i = 0; i < 16; ++i) a[i] = a[i] > b[15 - i] ? a[i] : b[15 - i];
#pragma unroll
    for (int j = 8; j > 0; j >>= 1)
#pragma unroll
        for (int i = 0; i < 16; ++i) { const int l = i ^ j; if (l > i) ce_desc(a[i], a[l]); }
}
__device__ __forceinline__ int lut16(const int (&P)[4], int a) { const int s = a >> 2; const int v = (P[0] & -(int)(s == 0)) | (P[1] & -(int)(s == 1)) | (P[2] & -(int)(s == 2)) | (P[3] & -(int)(s == 3)); return (v >> (8 * (a & 3))) & 127; }
constexpr int KSW_BYTES = 2 * 128 * 256;
__device__ __forceinline__ int ksw(int z, int key, int colB) { return (z * 128 + key) * 256 + (colB ^ ((key & 7) << 4)); }

__device__ constexpr int G2A[16] = {1, 1, 1, 1, 1, 1, 1, 2, 2, 2, 2, 3, 3, 3, 4, 4}, G2B[16] = {1, 2, 3, 4, 5, 6, 7, 1, 2, 3, 4, 1, 2, 3, 1, 2};
__device__ constexpr int G3A[3] = {5, 6, 7}, G3B[3] = {1, 1, 1};

__device__ __forceinline__ void route_unit(const bf16_t* __restrict__ PQ, const char* KL, unsigned* __restrict__ RIDX, float* __restrict__ RW, int tok0, int h, int lane) {
    const int r32 = lane & 31, hi = lane >> 5;
    int X[2][16];
#pragma unroll
    for (int z = 0; z < 2; ++z) {
        bf16x8 qf[8];
        const bf16_t* qp = PQ + (size_t)(tok0 + r32) * 2048 + h * 256 + z * 128 + hi * 8;
#pragma unroll
        for (int ks = 0; ks < 8; ++ks) qf[ks] = *(const bf16x8*)(qp + ks * 16);
        f32x16 acc[4];
#pragma unroll
        for (int kt = 0; kt < 4; ++kt) { acc[kt] = f32x16{};
#pragma unroll
            for (int ks = 0; ks < 8; ++ks) { const bf16x8 kf = *(const bf16x8*)(KL + ksw(z, kt * 32 + r32, (ks * 16 + hi * 8) * 2)); acc[kt] = MFMA32(kf, qf[ks], acc[kt]); } }
        MFMA_PAD();
        int g0[16], g1[16];
#pragma unroll
        for (int half = 0; half < 2; ++half) {
#pragma unroll
            for (int i = 0; i < 16; ++i) { g0[i] = (f2key(acc[2 * half][i]) & ~127) | (64 * half + (i & 3) + 8 * (i >> 2) + 4 * hi);
                                           g1[i] = (f2key(acc[2 * half + 1][i]) & ~127) | (64 * half + 32 + (i & 3) + 8 * (i >> 2) + 4 * hi); }
            sort16_desc(g0); sort16_desc(g1); merge_top16(g0, g1);
            if (half == 0) {
#pragma unroll
                for (int i = 0; i < 16; ++i) X[z][i] = g0[i];
            } else merge_top16(X[z], g0);
        }
    }
    int T0[16], T1[16];
    { int P[16];
#pragma unroll
      for (int i = 0; i < 16; ++i) { auto rr = __builtin_amdgcn_permlane32_swap((unsigned)X[0][i], (unsigned)X[1][i], false, false); T0[i] = (int)rr[0]; P[i] = (int)rr[1]; }
      merge_top16(T0, P);
#pragma unroll
      for (int i = 0; i < 16; ++i) { auto rr = __builtin_amdgcn_permlane32_swap((unsigned)T0[i], (unsigned)T0[i], false, false); T0[i] = (int)rr[0]; T1[i] = (int)rr[1]; } }
    float f0[16], f1[16]; int I0[4] = {0, 0, 0, 0}, I1[4] = {0, 0, 0, 0};
#pragma unroll
    for (int a = 0; a < 16; ++a) { f0[a] = key2f(T0[a] & ~127); f1[a] = key2f(T1[a] & ~127); I0[a >> 2] |= (T0[a] & 127) << (8 * (a & 3)); I1[a >> 2] |= (T1[a] & 127) << (8 * (a & 3)); }
    int C0[16], C1[16], C2[16], C3[16];
#pragma unroll
    for (int b = 0; b < 16; ++b) C0[b] = (f2key(f0[0] + f1[b]) & ~255) | b;
#pragma unroll
    for (int a = 1; a < 16; ++a) C1[a - 1] = (f2key(f0[a] + f1[0]) & ~255) | (a << 4);
    C1[15] = (int)0x80000000;
#pragma unroll
    for (int c = 0; c < 16; ++c) C2[c] = (f2key(f0[G2A[c]] + f1[G2B[c]]) & ~255) | (G2A[c] << 4) | G2B[c];
#pragma unroll
    for (int c = 0; c < 16; ++c) C3[c] = (int)0x80000000;
#pragma unroll
    for (int c = 0; c < 3; ++c) C3[c] = (f2key(f0[G3A[c]] + f1[G3B[c]]) & ~255) | (G3A[c] << 4) | G3B[c];
    ce_desc(C3[0], C3[1]); ce_desc(C3[1], C3[2]); ce_desc(C3[0], C3[1]);
    sort16_desc(C2);
    merge_top16(C0, C1); merge_top16(C2, C3); merge_top16(C0, C2);
    float sc[16]; float ssum = 0.f; const float smax = key2f(C0[0] & ~255);
#pragma unroll
    for (int k = 0; k < 16; ++k) { sc[k] = __expf(key2f(C0[k] & ~255) - smax); ssum += sc[k]; }
    const float rs = __builtin_amdgcn_rcpf(ssum);
    {
        unsigned* ip = RIDX + (size_t)(tok0 + r32) * 128 + h * 16; float* wp = RW + (size_t)(tok0 + r32) * 128 + h * 16;
#pragma unroll
        for (int k4 = 0; k4 < 4; ++k4) { u32x4 iv; f32x4 wv;
#pragma unroll
            for (int e = 0; e < 4; ++e) { const int k = 4 * k4 + e, ab = C0[k] & 255; iv[e] = (unsigned)(lut16(I0, ab >> 4) * 128 + lut16(I1, ab & 15)); wv[e] = sc[k] * rs; }
            *(u32x4*)(ip + 4 * k4) = iv; *(f32x4*)(wp + 4 * k4) = wv; }
    }
}

constexpr float PU_SCALE = 256.f, PV_SCALE = 16.f;
#define DPP_ADD(s, ctrl) s += __builtin_bit_cast(float, __builtin_amdgcn_update_dpp(0, __builtin_bit_cast(int, s), ctrl, 0xF, 0xF, true))
__device__ __forceinline__ void acc16_fp8(const u32x4 w, const float a, float (&f)[16]) {
    const f32x2 a0 = __builtin_amdgcn_cvt_pk_f32_fp8((int)w.x, false), a1 = __builtin_amdgcn_cvt_pk_f32_fp8((int)w.x, true), a2 = __builtin_amdgcn_cvt_pk_f32_fp8((int)w.y, false), a3 = __builtin_amdgcn_cvt_pk_f32_fp8((int)w.y, true);
    const f32x2 a4 = __builtin_amdgcn_cvt_pk_f32_fp8((int)w.z, false), a5 = __builtin_amdgcn_cvt_pk_f32_fp8((int)w.z, true), a6 = __builtin_amdgcn_cvt_pk_f32_fp8((int)w.w, false), a7 = __builtin_amdgcn_cvt_pk_f32_fp8((int)w.w, true);
    f[0] = fmaf(a, a0[0], f[0]); f[1] = fmaf(a, a0[1], f[1]); f[2] = fmaf(a, a1[0], f[2]); f[3] = fmaf(a, a1[1], f[3]); f[4] = fmaf(a, a2[0], f[4]); f[5] = fmaf(a, a2[1], f[5]); f[6] = fmaf(a, a3[0], f[6]); f[7] = fmaf(a, a3[1], f[7]);
    f[8] = fmaf(a, a4[0], f[8]); f[9] = fmaf(a, a4[1], f[9]); f[10] = fmaf(a, a5[0], f[10]); f[11] = fmaf(a, a5[1], f[11]); f[12] = fmaf(a, a6[0], f[12]); f[13] = fmaf(a, a6[1], f[13]); f[14] = fmaf(a, a7[0], f[14]); f[15] = fmaf(a, a7[1], f[15]);
}
constexpr int TOK_PER_WAVE = 4;
constexpr int LIST_BYTES = 128 * 8, TOKLDS_BYTES = LIST_BYTES + 512;
__device__ __forceinline__ void bucket_token(const unsigned i0, const unsigned i1, const float w0, const float w1, LAS unsigned char* tl, int lane) {
    LAS unsigned* hist = (LAS unsigned*)(tl + LIST_BYTES); LAS unsigned* ent = (LAS unsigned*)tl; LAS float* wt = (LAS float*)(tl + 512);
    hist[lane] = 0u; hist[64 + lane] = 0u;
    LDS_WAIT();
    const unsigned r0 = __hip_atomic_fetch_add(hist + (i0 >> 7), 1u, __ATOMIC_RELAXED, __HIP_MEMORY_SCOPE_WORKGROUP);
    const unsigned r1 = __hip_atomic_fetch_add(hist + (i1 >> 7), 1u, __ATOMIC_RELAXED, __HIP_MEMORY_SCOPE_WORKGROUP);
    LDS_WAIT();
    const unsigned c0 = hist[2 * lane], c1 = hist[2 * lane + 1], tot = c0 + c1;
    unsigned incl = tot;
#pragma unroll
    for (int d = 1; d < 64; d <<= 1) { const unsigned o = (unsigned)__shfl_up((int)incl, d); if (lane >= d) incl += o; }
    LDS_WAIT();
    hist[2 * lane] = incl - tot; hist[2 * lane + 1] = incl - tot + c0;
    LDS_WAIT();
    { const unsigned p = hist[i0 >> 7] + r0; ent[p] = i0; wt[p] = w0; }
    { const unsigned p = hist[i1 >> 7] + r1; ent[p] = i1; wt[p] = w1; }
}
constexpr float X_SCALE = 16.f;
constexpr int XOP_BYTES = 2048, DESC_MAX = 128;
constexpr int WAVE_LDS = TOK_PER_WAVE * TOKLDS_BYTES + TOK_PER_WAVE * XOP_BYTES + DESC_MAX * 4;
__device__ __forceinline__ float sat8(float v) { return fminf(fmaxf(v, -440.f), 440.f); }
__device__ __forceinline__ void xop_store(const u32x4 x0, const u32x4 x1, LAS unsigned char* xo, int lane) {
    float x[16];
    x[0] = bf_lo(x0.x); x[1] = bf_hi(x0.x); x[2] = bf_lo(x0.y); x[3] = bf_hi(x0.y); x[4] = bf_lo(x0.z); x[5] = bf_hi(x0.z); x[6] = bf_lo(x0.w); x[7] = bf_hi(x0.w);
    x[8] = bf_lo(x1.x); x[9] = bf_hi(x1.x); x[10] = bf_lo(x1.y); x[11] = bf_hi(x1.y); x[12] = bf_lo(x1.z); x[13] = bf_hi(x1.z); x[14] = bf_lo(x1.w); x[15] = bf_hi(x1.w);
    u32x4 hi, lo;
#pragma unroll
    for (int d = 0; d < 4; ++d) {
        const float a0 = sat8(x[4 * d] * X_SCALE), a1 = sat8(x[4 * d + 1] * X_SCALE), a2 = sat8(x[4 * d + 2] * X_SCALE), a3 = sat8(x[4 * d + 3] * X_SCALE);
        int h = __builtin_amdgcn_cvt_pk_fp8_f32(a0, a1, 0, false); h = __builtin_amdgcn_cvt_pk_fp8_f32(a2, a3, h, true);
        const f32x2 b0 = __builtin_amdgcn_cvt_pk_f32_fp8(h, false), b1 = __builtin_amdgcn_cvt_pk_f32_fp8(h, true);
        int l = __builtin_amdgcn_cvt_pk_fp8_f32(a0 - b0[0], a1 - b0[1], 0, false); l = __builtin_amdgcn_cvt_pk_fp8_f32(a2 - b1[0], a3 - b1[1], l, true);
        hi[d] = (unsigned)h; lo[d] = (unsigned)l; }
    *(LAS u32x4*)(xo + 16 * lane) = hi; *(LAS u32x4*)(xo + 1024 + 16 * lane) = lo;
}
__device__ __forceinline__ void build_recs(LAS unsigned char* wl, int lane) {
    LAS unsigned* hist = (LAS unsigned*)(wl + LIST_BYTES);
    const int q0 = lane, q1 = lane + 64;
    const LAS unsigned* l0 = (const LAS unsigned*)(wl + (q0 >> 5) * TOKLDS_BYTES) + 4 * (q0 & 31); const LAS unsigned* l1 = (const LAS unsigned*)(wl + (q1 >> 5) * TOKLDS_BYTES) + 4 * (q1 & 31);
    const u32x4 ea = *(const LAS u32x4*)l0, wa = *(const LAS u32x4*)(l0 + 128), eb = *(const LAS u32x4*)l1, wb = *(const LAS u32x4*)(l1 + 128);
    const unsigned k0 = ea.x >> 7, k1 = eb.x >> 7;
    LDS_WAIT();
    hist[lane] = 0u; hist[64 + lane] = 0u;
    LDS_WAIT();
    const unsigned r0 = __hip_atomic_fetch_add(hist + k0, 1u, __ATOMIC_RELAXED, __HIP_MEMORY_SCOPE_WORKGROUP);
    const unsigned r1 = __hip_atomic_fetch_add(hist + k1, 1u, __ATOMIC_RELAXED, __HIP_MEMORY_SCOPE_WORKGROUP);
    LDS_WAIT();
    const unsigned c0 = hist[2 * lane], c1 = hist[2 * lane + 1], tot = c0 + c1;
    unsigned incl = tot;
#pragma unroll
    for (int d = 1; d < 64; d <<= 1) { const unsigned o = (unsigned)__shfl_up((int)incl, d); if (lane >= d) incl += o; }
    LDS_WAIT();
    hist[2 * lane] = incl - tot; hist[2 * lane + 1] = incl - tot + c0;
    LDS_WAIT();
    const unsigned p0 = hist[k0] + r0, p1 = hist[k1] + r1;
    LDS_WAIT();
    { LAS u32x4* rc = (LAS u32x4*)(wl + 32 * p0); rc[0] = (u32x4){ea.x | ((unsigned)(q0 >> 5) << 14) | (ea.y << 16), ea.z | (ea.w << 16), 0u, 0u}; rc[1] = wa; }
    { LAS u32x4* rc = (LAS u32x4*)(wl + 32 * p1); rc[0] = (u32x4){eb.x | ((unsigned)(q1 >> 5) << 14) | (eb.y << 16), eb.z | (eb.w << 16), 0u, 0u}; rc[1] = wb; }
}
__device__ __forceinline__ long pk64(unsigned lo, unsigned hi) { return (long)(((unsigned long long)hi << 32) | (unsigned long long)lo); }
#define MFMA_FP8(a, b, c) __builtin_amdgcn_mfma_f32_16x16x32_fp8_fp8(a, b, c, 0, 0, 0)
__device__ __forceinline__ void sweep_compute(const u32x4 u0, const u32x4 u1, const u32x4 u2, const u32x4 u3, const u32x4 v0, const u32x4 v1, const u32x4 v2, const u32x4 v3,
                                              const float g, const int tok, const u32x4 xh, const u32x4 xo, float (&f0)[16], float (&f1)[16], float (&f2)[16], float (&f3)[16], int lane, const f32x4 wsel) {
    const long xa = pk64(xh.x, xh.y), xb = pk64(xh.z, xh.w), xc = pk64(xo.x, xo.y), xd = pk64(xo.z, xo.w);
    f32x4 c0 = {0.f, 0.f, 0.f, 0.f}, c1 = c0, c2 = c0, c3 = c0;
    c0 = MFMA_FP8(pk64(u0.x, u0.y), xa, c0); c1 = MFMA_FP8(pk64(u1.x, u1.y), xa, c1); c2 = MFMA_FP8(pk64(u2.x, u2.y), xa, c2); c3 = MFMA_FP8(pk64(u3.x, u3.y), xa, c3);
    c0 = MFMA_FP8(pk64(u0.z, u0.w), xb, c0); c1 = MFMA_FP8(pk64(u1.z, u1.w), xb, c1); c2 = MFMA_FP8(pk64(u2.z, u2.w), xb, c2); c3 = MFMA_FP8(pk64(u3.z, u3.w), xb, c3);
    c0 = MFMA_FP8(pk64(u0.x, u0.y), xc, c0); c1 = MFMA_FP8(pk64(u1.x, u1.y), xc, c1); c2 = MFMA_FP8(pk64(u2.x, u2.y), xc, c2); c3 = MFMA_FP8(pk64(u3.x, u3.y), xc, c3);
    c0 = MFMA_FP8(pk64(u0.z, u0.w), xd, c0); c1 = MFMA_FP8(pk64(u1.z, u1.w), xd, c1); c2 = MFMA_FP8(pk64(u2.z, u2.w), xd, c2); c3 = MFMA_FP8(pk64(u3.z, u3.w), xd, c3);
    __builtin_amdgcn_sched_barrier(0); asm volatile("s_nop 7" ::: "memory"); __builtin_amdgcn_sched_barrier(0);
    const float p0 = fmaf(c0[3], wsel[3], fmaf(c0[2], wsel[2], fmaf(c0[1], wsel[1], c0[0] * wsel[0]))), p1 = fmaf(c1[3], wsel[3], fmaf(c1[2], wsel[2], fmaf(c1[1], wsel[1], c1[0] * wsel[0])));
    const float p2 = fmaf(c2[3], wsel[3], fmaf(c2[2], wsel[2], fmaf(c2[1], wsel[1], c2[0] * wsel[0]))), p3 = fmaf(c3[3], wsel[3], fmaf(c3[2], wsel[2], fmaf(c3[1], wsel[1], c3[0] * wsel[0])));
    const bool up32 = lane >= 32;
    float k0 = up32 ? p2 : p0, k1 = up32 ? p3 : p1, s0 = up32 ? p0 : p2, s1 = up32 ? p1 : p3;
    { auto r0 = __builtin_amdgcn_permlane32_swap(__builtin_bit_cast(unsigned, s0), __builtin_bit_cast(unsigned, s0), false, false);
      auto r1_ = __builtin_amdgcn_permlane32_swap(__builtin_bit_cast(unsigned, s1), __builtin_bit_cast(unsigned, s1), false, false);
      k0 += __builtin_bit_cast(float, up32 ? r0[0] : r0[1]); k1 += __builtin_bit_cast(float, up32 ? r1_[0] : r1_[1]); }
    const bool odd16 = (lane & 16) != 0;
    float kk = odd16 ? k1 : k0, ss = odd16 ? k0 : k1;
    { auto rr = __builtin_amdgcn_permlane16_swap(__builtin_bit_cast(unsigned, ss), __builtin_bit_cast(unsigned, ss), false, false); kk += __builtin_bit_cast(float, odd16 ? rr[0] : rr[1]); }
    DPP_ADD(kk, 0xB1); DPP_ADD(kk, 0x4E); DPP_ADD(kk, 0x141); DPP_ADD(kk, 0x140);
    const float act = gelu_tanh(kk) * g;
    const float a0 = __builtin_bit_cast(float, __builtin_amdgcn_readlane(__builtin_bit_cast(unsigned, act), 0)), a1 = __builtin_bit_cast(float, __builtin_amdgcn_readlane(__builtin_bit_cast(unsigned, act), 16));
    const float a2 = __builtin_bit_cast(float, __builtin_amdgcn_readlane(__builtin_bit_cast(unsigned, act), 32)), a3 = __builtin_bit_cast(float, __builtin_amdgcn_readlane(__builtin_bit_cast(unsigned, act), 48));
#define SW_ACC(F) { acc16_fp8(v0, a0, F); acc16_fp8(v1, a1, F); acc16_fp8(v2, a2, F); acc16_fp8(v3, a3, F); }
    if (tok == 0) { SW_ACC(f0) asm volatile("; token 0"); } else if (tok == 1) { SW_ACC(f1) asm volatile("; token 1"); } else if (tok == 2) { SW_ACC(f2) asm volatile("; token 2"); } else { SW_ACC(f3) asm volatile("; token 3"); }
#undef SW_ACC
}
#undef DPP_ADD
}


constexpr int NWAVES = 8, RING_BYTES = 131072, LDSCTL_OFF = RING_BYTES, MISC_OFF = LDSCTL_OFF + 320, LDS_BYTES = 147456;
constexpr int NPH = 11;
struct Args { const float* in[29]; float* out; unsigned char* ws; int ph_lo, ph_hi; };
static_assert(sizeof(Args) == 29 * 8 + 8 + 8 + 8, "Args has no padding");
enum { I_X = 0, I_C, I_CTX, I_CCTX, I_WMOD, I_BMOD, I_WIN, I_QNG, I_KVNG, I_WUQ, I_WUKV, I_S5ARE, I_S5AIM, I_S5LDT, I_S5BRE, I_S5BIM, I_S5CRE, I_S5CIM, I_S5D, I_WGLU, I_WOUT,
       I_LN1G, I_LN1B, I_PWQ, I_PKEYS, I_PU, I_PV, I_LN2G, I_LN2B };

__global__ void __launch_bounds__(NWAVES * 64, 2) mk_fwd(Args args) {
    extern __shared__ __attribute__((aligned(16))) unsigned char lds[];
    LAS unsigned char* ldsl = (LAS unsigned char*)lds;
    volatile LAS unsigned* MISC = (volatile LAS unsigned*)(ldsl + MISC_OFF);
    const int wave = __builtin_amdgcn_readfirstlane(threadIdx.x >> 6);
    const int G = gridDim.x; const int bx = blockIdx.x; const int vcu = (G % 8 == 0) ? (bx % 8) * (G / 8) + bx / 8 : bx;
    const int gw = vcu * NWAVES + wave, NGW = G * NWAVES;
    unsigned char* ws = args.ws;
    { const int tid = wave * 64 + lane_id_fresh(); for (int u = tid; u < (LDS_BYTES - LDSCTL_OFF) / 4; u += NWAVES * 64) ((LAS unsigned*)(ldsl + LDSCTL_OFF))[u] = 0u; }
    __syncthreads();
    XcdBarrier bar; bar.bar = (unsigned*)(ws + WS_CTL); bar.x = 0; bar.st = nullptr;
    if (MK_N_LAUNCHES == 1) bar = xcd_barrier_post((unsigned*)(ws + WS_CTL), MISC + 8, wave * 64 + lane_id_fresh());
    const int lo = args.ph_lo, hi = args.ph_hi;
    unsigned long long t_a = 0ull, t_b = 0ull; if (MK_TSEL == 0) t_a = __builtin_amdgcn_s_memrealtime();
#define TSTAMP(k) do { if (MK_TSEL >= 0) { if ((k) + 1 == MK_TSEL) t_a = __builtin_amdgcn_s_memrealtime(); if ((k) == MK_TSEL) t_b = __builtin_amdgcn_s_memrealtime(); } } while (0)
#ifndef MK_ONLY
#define MK_ONLY -1
#endif
#define IN(k) ((MK_ONLY < 0 || MK_ONLY == (k)) && lo <= (k) && (k) < hi)
#define SEAM(k) do { if (IN(k) && IN((k) + 1)) { xcd_barrier(bar, wave * 64 + lane_id_fresh()); } } while (0)
#define MOD ((float*)(ws + WS_MOD))
#define ABAR ((float*)(ws + WS_S5ABAR))
#define POW ((float*)(ws + WS_S5POW))
#define BB ((bf16_t*)(ws + WS_S5BB))
#define CM ((bf16_t*)(ws + WS_S5CM))
#define ROPE ((float*)(ws + WS_ROPE))
#define PART ((float*)(ws + WS_PART))
#define S5E ((float*)(ws + WS_S5E))
#define WIN ((bf16_t*)(ws + WS_WIN))
#define WUQ ((bf16_t*)(ws + WS_WUQ))
#define WUKV ((bf16_t*)(ws + WS_WUKV))
#define WGLU ((bf16_t*)(ws + WS_WGLU))
#define WOUT ((bf16_t*)(ws + WS_WOUT))
#define WQ ((bf16_t*)(ws + WS_WQ))
#define KEYS ((bf16_t*)(ws + WS_KEYS))
#define ZQ ((bf16_t*)(ws + WS_ZQ))
#define YB ((bf16_t*)(ws + WS_Y))
#define SU ((bf16_t*)(ws + WS_SU))
#define GATES ((bf16_t*)(ws + WS_GATES))
#define XM ((bf16_t*)(ws + WS_XM))
#define VB ((bf16_t*)(ws + WS_V))
#define MERGED ((bf16_t*)(ws + WS_MERGED))
#define QB ((bf16_t*)(ws + WS_Q))
#define KN ((bf16_t*)(ws + WS_KN))
#define KPE ((bf16_t*)(ws + WS_KPE))
#define TB ((bf16_t*)(ws + WS_T))
#define XM2 ((bf16_t*)(ws + WS_XM2))
#define PQ ((bf16_t*)(ws + WS_PQ))
#define PUB ((bf16_t*)(ws + WS_PU))
#define PVB ((bf16_t*)(ws + WS_PV))
    if (IN(0)) { const int lane = lane_id_fresh(), tid = wave * 64 + lane; (void)tid;
        if (bx < 96) {
            LAS float* sl = (LAS float*)ldsl;
            for (int idx = tid; idx < 17 * 1024; idx += 512) { const int b = idx >> 10, k = idx & 1023; const float cv = (b < 16) ? args.in[I_C][b * 1024 + k] : args.in[I_CCTX][k];
                sl[k * 20 + b] = cv * __builtin_amdgcn_rcpf(1.f + __expf(-cv)); }
            __syncthreads();
            LAS float* red = (LAS float*)(ldsl + 81920);
            for (int item = bx; item < 96; item += G) { const int n0 = item * 64;
                float acc[17];
#pragma unroll
                for (int b = 0; b < 17; ++b) acc[b] = 0.f;
                const float* wp = args.in[I_WMOD] + (size_t)(wave * 128) * 6144 + n0 + lane;
#pragma unroll 1
                for (int k0 = 0; k0 < 128; k0 += 32) { float wv[32];
#pragma unroll
                    for (int kk = 0; kk < 32; ++kk) wv[kk] = wp[(size_t)(k0 + kk) * 6144];
                    __builtin_amdgcn_sched_barrier(0);
#pragma unroll
                    for (int kk = 0; kk < 32; ++kk) { const float w = wv[kk]; const LAS float* s = sl + (wave * 128 + k0 + kk) * 20;
                        const f32x4 s0 = *(const LAS f32x4*)s, s1 = *(const LAS f32x4*)(s + 4), s2 = *(const LAS f32x4*)(s + 8), s3 = *(const LAS f32x4*)(s + 12); const float s4 = s[16];
                        acc[0] += w * s0[0]; acc[1] += w * s0[1]; acc[2] += w * s0[2]; acc[3] += w * s0[3]; acc[4] += w * s1[0]; acc[5] += w * s1[1]; acc[6] += w * s1[2]; acc[7] += w * s1[3];
                        acc[8] += w * s2[0]; acc[9] += w * s2[1]; acc[10] += w * s2[2]; acc[11] += w * s2[3]; acc[12] += w * s3[0]; acc[13] += w * s3[1]; acc[14] += w * s3[2]; acc[15] += w * s3[3]; acc[16] += w * s4; } }
#pragma unroll
                for (int b = 0; b < 17; ++b) red[(wave * 17 + b) * 64 + lane] = acc[b];
                __syncthreads();
                for (int idx = tid; idx < 17 * 64; idx += 512) { const int b = idx >> 6, ln = idx & 63; float s = args.in[I_BMOD][n0 + ln];
#pragma unroll
                    for (int w = 0; w < 8; ++w) s += red[(w * 17 + b) * 64 + ln];
                    MOD[(size_t)b * 6144 + n0 + ln] = s; }
                __syncthreads();
            }
        }
        {
            LAS float* scr = (LAS float*)(ldsl + wave * 16384);
            constexpr int I_1 = 16 * 104, I_2 = 6 * 48, I_3 = 4 * 64, I_4 = 8 * 64, I_5 = 16 * 32, I_6 = 16 * 64, NITEMS = I_1 + I_2 + I_3 + I_4 + I_5 + I_6;
            const bool split = (G == 256);
            for (int it = split ? (bx - 96) * NWAVES + wave : gw; it >= 0 && it < NITEMS; it += split ? (G - 96) * NWAVES : NGW) { int r = it;
                if (r < I_1) { const int kb = r / 104, nb = r % 104, nd = nb * 32;
                    const int ns = nd < 704 ? nd : (nd < 768 ? -1 : nd - 64);
                    transpose_item(args.in[I_WIN], INW, kb * 64, ns, WIN, 1024, nd, nullptr, scr, lane); continue; } r -= I_1;
                if (r < I_2) { const int kb = r / 48, nb = r % 48; transpose_item(args.in[I_WUQ], 1536, kb * 64, nb * 32, WUQ, 384, nb * 32, args.in[I_QNG], scr, lane); continue; } r -= I_2;
                if (r < I_3) { const int kb = r / 64, nb = r % 64; transpose_item(args.in[I_WUKV], 2048, kb * 64, nb * 32, WUKV, 256, nb * 32, args.in[I_KVNG], scr, lane); continue; } r -= I_3;
                if (r < I_4) { const int kb = r / 64, nb = r % 64, nd = nb * 32, tile = nd >> 8, wi = nd & 255;
                    const int ns = wi < 128 ? tile * 128 + wi : 1024 + tile * 128 + (wi - 128);
                    transpose_item(args.in[I_WGLU], 2048, kb * 64, ns, WGLU, 512, nd, nullptr, scr, lane); continue; } r -= I_4;
                if (r < I_5) { const int kb = r / 32, nb = r % 32; transpose_item(args.in[I_WOUT], 1024, kb * 64, nb * 32, WOUT, 1024, nb * 32, nullptr, scr, lane); continue; } r -= I_5;
                { const int kb = r / 64, nb = r % 64; transpose_item(args.in[I_PWQ], 2048, kb * 64, nb * 32, WQ, 1024, nb * 32, nullptr, scr, lane); }
            }
        }
        const int gt = (G - 1 - bx) * 512 + tid, NGT = G * 512;
        for (int i = gt; i < 16 * 128 * 128 / 8; i += NGT) {
            const f32x4 a = ((const f32x4*)args.in[I_PKEYS])[2 * i], b = ((const f32x4*)args.in[I_PKEYS])[2 * i + 1]; ((u32x4*)KEYS)[i] = pack8(a, b); }
        for (int i = gt; i < 4096; i += NGT) {
            const int p = i & 63, dg = i >> 6;
            const double dt = exp((double)args.in[I_S5LDT][dg]), ar = args.in[I_S5ARE][i], ai = args.in[I_S5AIM][i];
            const double mag = exp(ar * dt), abr = mag * cos(ai * dt), abi = mag * sin(ai * dt), den = ar * ar + ai * ai;
            const double fr = ((abr - 1.0) * ar + abi * ai) / den, fi = (abi * ar - (abr - 1.0) * ai) / den;
            ABAR[2 * i] = (float)abr; ABAR[2 * i + 1] = (float)abi;
            { const double m1 = exp(ar * dt * 256.0), m2 = exp(ar * dt * 512.0);
              POW[2 * i] = (float)(m1 * cos(ai * dt * 256.0)); POW[2 * i + 1] = (float)(m1 * sin(ai * dt * 256.0));
              POW[8192 + 2 * i] = (float)(m2 * cos(ai * dt * 512.0)); POW[8192 + 2 * i + 1] = (float)(m2 * sin(ai * dt * 512.0)); }
            for (int c = 0; c < 16; ++c) { const double br = args.in[I_S5BRE][(size_t)i * 16 + c], bi = args.in[I_S5BIM][(size_t)i * 16 + c];
                BB[((size_t)(dg * 2 + 0) * 64 + p) * 16 + c] = (bf16_t)(cvt_pk_bf16((float)(fr * br - fi * bi), 0.f) & 0xffffu);
                BB[((size_t)(dg * 2 + 1) * 64 + p) * 16 + c] = (bf16_t)(cvt_pk_bf16((float)(fr * bi + fi * br), 0.f) & 0xffffu);
                CM[((size_t)dg * 16 + c) * 128 + p] = (bf16_t)(cvt_pk_bf16(args.in[I_S5CRE][((size_t)dg * 16 + c) * 64 + p], 0.f) & 0xffffu);
                CM[((size_t)dg * 16 + c) * 128 + 64 + p] = (bf16_t)(cvt_pk_bf16(-args.in[I_S5CIM][((size_t)dg * 16 + c) * 64 + p], 0.f) & 0xffffu); }
        }
        for (int i = gt; i < 1024; i += NGT) { const int pos = i >> 4, idx = i & 15;
            const double ang = (double)pos * exp(-9.210340371976184 * (double)idx / 16.0); ROPE[2 * i] = (float)cos(ang); ROPE[2 * i + 1] = (float)sin(ang); }
    }
    SEAM(0); TSTAMP(0);
    if (IN(1)) { const int lane = lane_id_fresh(), tid = wave * 64 + lane; (void)tid;
#define P1A_ROW(m_) ((m_) < MLAT ? args.in[I_X] + (size_t)(m_) * DM : args.in[I_CTX] + (size_t)((m_) - MLAT) * DM)
#define P1A_LOAD(V, m_) do { const f32x4* p_ = (const f32x4*)P1A_ROW(m_) + lane; V[0] = p_[0]; V[1] = p_[64]; V[2] = p_[128]; V[3] = p_[192]; } while (0)
#define P1A_MOD(m_, A1, BS) do { const int b_ = ((m_) < MLAT) ? ((m_) >> 11) : 16; const f32x4* sh_ = (const f32x4*)(MOD + (size_t)b_ * 6144) + lane; const f32x4* sc_ = (const f32x4*)(MOD + (size_t)b_ * 6144 + 1024) + lane; \
    _Pragma("unroll") for (int j_ = 0; j_ < 4; ++j_) { A1[j_] = sc_[64 * j_]; BS[j_] = sh_[64 * j_]; } } while (0)
        { f32x4 va[4], vb[4], a1[4], bs[4], a1b[4], bsb[4];
          int m = gw; P1A_LOAD(va, m); P1A_MOD(m, a1, bs);
#pragma unroll 1
          for (; m < MTOT; m += 2 * NGW) {
              const int m2 = m + NGW, m3 = m + 2 * NGW;
              if (m2 < MTOT) { P1A_LOAD(vb, m2); P1A_MOD(m2, a1b, bsb); }
              modulate_row_r(va, a1, bs, XM + (size_t)m * DM, lane);
              if (m2 < MTOT) { if (m3 < MTOT) { P1A_LOAD(va, m3); P1A_MOD(m3, a1, bs); } modulate_row_r(vb, a1b, bsb, XM + (size_t)m2 * DM, lane); }
          } }
#undef P1A_ROW
#undef P1A_LOAD
#undef P1A_MOD
    }
    SEAM(1); TSTAMP(1);
    if (IN(2)) {
        pg8::Gemm g{XM, WIN, 1024, 1024, 1024}; pg8::StaticOrder S; S.init(MLAT / 256, 13, G, bx, MCTX / 256, 5);
        EpiInProj E{ZQ, SU, GATES, PART};
        pg8::gemm_phase(ldsl, g, S, E, wave * 64 + lane_id_fresh());
    }
    SEAM(2); TSTAMP(2);
    if (IN(3)) { const int lane = lane_id_fresh(), tid = wave * 64 + lane; (void)tid;
        { pg8::Gemm g{ZQ, WUQ, 768, 384, 384}; pg8::StaticOrder S; S.init(MLAT / 256, 6, G, bx); EpiUQ E{QB, PART}; pg8::gemm_phase(ldsl, g, S, E, wave * 64 + lane_id_fresh()); }
        { pg8::Gemm g{ZQ + 384, WUKV, 768, 256, 256}; pg8::StaticOrder S; S.init(MTOT / 256, 8, G, bx); EpiUKV E{KN, VB, PART}; pg8::gemm_phase(ldsl, g, S, E, wave * 64 + lane_id_fresh()); }
        const int gt = bx * 512 + tid, NGT = G * 512;
        for (int i = gt; i < MTOT * 32; i += NGT) {
            const int row = i >> 5, pp = i & 31, part = pp >> 4, idx = pp & 15;
            const bf16_t* z = ZQ + (size_t)row * 768 + 640 + part * 32 + idx; const float x1 = bf_lo((unsigned)z[0]), x2 = bf_lo((unsigned)z[16]);
            float o1 = x1, o2 = x2; int b, key;
            if (row < MLAT) { b = row >> 11; const int l = row & 2047; key = CTXL + l; const int pos = part == 0 ? (l >> 6) : (l & 63); const float cs = ROPE[(pos * 16 + idx) * 2], sn = ROPE[(pos * 16 + idx) * 2 + 1];
                o1 = x1 * cs - x2 * sn; o2 = x2 * cs + x1 * sn; }
            else { const int r2 = row - MLAT; b = r2 >> 8; key = r2 & 255; }
            bf16_t* kp = KPE + ((size_t)b * NKEY + key) * 64 + part * 32 + idx;
            kp[0] = (bf16_t)(cvt_pk_bf16(o1, 0.f) & 0xffffu); kp[16] = (bf16_t)(cvt_pk_bf16(o2, 0.f) & 0xffffu); }
        for (int u = gw; u < 2 * 32 * 8 * 8; u += NGW) s5_passA(SU, ABAR, BB, S5E, u, lane);
    }
    SEAM(3); TSTAMP(3);
    if (IN(4)) { const int lane = lane_id_fresh(), tid = wave * 64 + lane; (void)tid;
#pragma unroll 1
        for (int U = vcu; U < 1024; U += G) { const int bh = U >> 3, qb = U & 7, b = bh >> 3, h = bh & 7;
            att::attn_unit(QB + ((size_t)bh * SEQ + qb * 256) * DK, KN + (size_t)bh * NKEY * 128, KPE + (size_t)b * NKEY * 64, VB + (size_t)bh * NKEY * 128,
                           GATES + ((size_t)(b * SEQ + qb * 256)) * 2048 + h * 128, ROPE, qb * 256, (char*)lds, wave * 64 + lane_id_fresh()); }
        for (int u = gw; u < 2048; u += NGW) s5_passB(SU, ABAR, POW, BB, CM, S5E, args.in[I_S5D], YB, u, lane, ldsl + wave * S5_LDS_WAVE);
    }
    SEAM(4); TSTAMP(4);
    if (IN(5)) {
        pg8::Gemm g{YB, WGLU, 512, 512, 512}; pg8::StaticOrder S; S.init(MLAT / 256, 8, G, bx); EpiGLU E{QB, GATES, MERGED}; pg8::gemm_phase(ldsl, g, S, E, wave * 64 + lane_id_fresh());
    }
    SEAM(5); TSTAMP(5);
    if (IN(6)) {
        pg8::Gemm g{MERGED, WOUT, 1024, 1024, 1024}; pg8::StaticOrder S; S.init(MLAT / 256, 4, G, bx); EpiOut E{args.in[I_X], MOD, TB}; pg8::gemm_phase(ldsl, g, S, E, wave * 64 + lane_id_fresh());
    }
    SEAM(6); TSTAMP(6);
    if (IN(7)) { const int lane = lane_id_fresh(), tid = wave * 64 + lane; (void)tid;
#define P5B_LOAD(V, m_) do { const u32x2* p_ = (const u32x2*)(TB + (size_t)(m_) * DM) + lane; _Pragma("unroll") for (int j_ = 0; j_ < 4; ++j_) { const u32x2 q_ = p_[64 * j_]; V[j_] = (f32x4){bf_lo(q_.x), bf_hi(q_.x), bf_lo(q_.y), bf_hi(q_.y)}; } } while (0)
#define P5B_MOD(m_, A1, BS) do { const int b_ = (m_) >> 11; const f32x4* sh_ = (const f32x4*)(MOD + (size_t)b_ * 6144 + 3072) + lane; const f32x4* sc_ = (const f32x4*)(MOD + (size_t)b_ * 6144 + 4096) + lane; \
    _Pragma("unroll") for (int j_ = 0; j_ < 4; ++j_) { A1[j_] = sc_[64 * j_]; BS[j_] = sh_[64 * j_]; } } while (0)
        { f32x4 va[4], vb[4], g1v[4], b1v[4], a1[4], bs[4], a1b[4], bsb[4];
#pragma unroll
          for (int j = 0; j < 4; ++j) { g1v[j] = ((const f32x4*)args.in[I_LN1G] + lane)[64 * j]; b1v[j] = ((const f32x4*)args.in[I_LN1B] + lane)[64 * j]; }
          int m = gw; P5B_LOAD(va, m); P5B_MOD(m, a1, bs);
#pragma unroll 1
          for (; m < MLAT; m += 2 * NGW) {
              P5B_LOAD(vb, m + NGW); P5B_MOD(m + NGW, a1b, bsb);
              ln1_row(va, PART + 2 * (size_t)m, g1v, b1v, a1, bs, XM2 + (size_t)m * DM, lane);
              if (m + 2 * NGW < MLAT) { P5B_LOAD(va, m + 2 * NGW); P5B_MOD(m + 2 * NGW, a1, bs); }
              ln1_row(vb, PART + 2 * (size_t)(m + NGW), g1v, b1v, a1b, bsb, XM2 + (size_t)(m + NGW) * DM, lane);
          } }
#undef P5B_LOAD
#undef P5B_MOD
#pragma unroll 1
        for (int r0 = gw * 4; r0 < 2 * PEXP; r0 += NGW * 4) {
            f32x4 t[4][4];
#pragma unroll
            for (int q = 0; q < 4; ++q) { const int r = r0 + q; const bool isU = r < PEXP; const f32x4* src = (const f32x4*)(isU ? args.in[I_PU] : args.in[I_PV]) + (size_t)(isU ? r : r - PEXP) * (DM / 4) + lane;
#pragma unroll
                for (int d = 0; d < 4; ++d) t[q][d] = src[64 * d]; }
#pragma unroll
            for (int q = 0; q < 4; ++q) { const int r = r0 + q; const bool isU = r < PEXP; const float sc_ = isU ? peer::PU_SCALE : peer::PV_SCALE;
                unsigned* dst = (unsigned*)(ws + WS_PU + (isU ? (size_t)0 : (size_t)(16 * MiB)) + (size_t)(isU ? r : r - PEXP) * DM) + lane;
#pragma unroll
                for (int d = 0; d < 4; ++d) { const f32x4 v = t[q][d] * sc_; int p = __builtin_amdgcn_cvt_pk_fp8_f32(peer::sat8(v[0]), peer::sat8(v[1]), 0, false); p = __builtin_amdgcn_cvt_pk_fp8_f32(peer::sat8(v[2]), peer::sat8(v[3]), p, true); dst[64 * d] = (unsigned)p; } }
        }
    }
    SEAM(7); TSTAMP(7);
    if (IN(8)) {
        pg8::Gemm g{XM2, WQ, 1024, 1024, 1024}; pg8::StaticOrder S; S.init(MLAT / 256, 8, G, bx); EpiPQ E{PQ}; pg8::gemm_phase(ldsl, g, S, E, wave * 64 + lane_id_fresh());
    }
    SEAM(8); TSTAMP(8);
    if (IN(9)) { const int lane = lane_id_fresh(), tid = wave * 64 + lane; const int h = bx & 7;
        for (int c = tid; c < 4096; c += 512) { const int z = c >> 11, key = (c >> 4) & 127, c16 = c & 15;
            *(LAS u32x4*)(ldsl + peer::ksw(z, key, c16 * 16)) = *(const u32x4*)(KEYS + ((size_t)(h * 2 + z) * 128 + key) * 128 + c16 * 8); }
        __syncthreads();
#pragma unroll 1
        for (int j = wave; j < 32; j += 8) { int l2 = lane; asm volatile("" : "+v"(l2));
            peer::route_unit(PQ, (const char*)lds,
                (unsigned*)(ws + WS_ROUTE), (float*)(ws + WS_ROUTE + 16 * MiB), ((bx >> 3) * 32 + j) * 32, h, l2); }
    }
    SEAM(9); TSTAMP(9);
    if (IN(10)) { const int lane = lane_id_fresh();
        LAS unsigned char* wl = ldsl + wave * peer::WAVE_LDS;
        LAS unsigned char* xl = wl + peer::TOK_PER_WAVE * peer::TOKLDS_BYTES;
        const unsigned char* PU8 = ws + WS_PU; const unsigned char* PV8 = ws + WS_PU + 16 * MiB;
        f32x4 wsel; { const bool dsel = (lane >> 4) == ((lane & 15) >> 2); const float sc_ = 1.f / (peer::PU_SCALE * peer::X_SCALE);
#pragma unroll
          for (int r = 0; r < 4; ++r) wsel[r] = (dsel && (lane & 3) == r) ? sc_ : 0.f; }
#pragma unroll 1
        for (int m0 = gw * peer::TOK_PER_WAVE; m0 < MLAT; m0 += NGW * peer::TOK_PER_WAVE) {
            float f0[16], f1[16], f2[16], f3[16];
            { unsigned ia[4], ib[4]; float wa[4], wb[4]; u32x4 xa[4], xb[4];
#pragma unroll
              for (int i = 0; i < 4; ++i) { const size_t m = (size_t)(m0 + i); const unsigned* ridx = (const unsigned*)(ws + WS_ROUTE) + m * 128; const float* rw = (const float*)(ws + WS_ROUTE + 16 * MiB) + m * 128;
                  ia[i] = ridx[lane]; ib[i] = ridx[64 + lane]; wa[i] = rw[lane]; wb[i] = rw[64 + lane];
                  const bf16_t* xrow = XM2 + m * DM; xa[i] = *(const u32x4*)(xrow + 16 * lane); xb[i] = *(const u32x4*)(xrow + 16 * lane + 8); }
#pragma unroll
              for (int i = 0; i < 4; ++i) { peer::bucket_token(ia[i], ib[i], wa[i], wb[i], wl + i * peer::TOKLDS_BYTES, lane); peer::xop_store(xa[i], xb[i], xl + i * peer::XOP_BYTES, lane); } }
#pragma unroll
            for (int e = 0; e < 16; ++e) { f0[e] = 0.f; f1[e] = 0.f; f2[e] = 0.f; f3[e] = 0.f; }
            LDS_WAIT();
            peer::build_recs(wl, lane); constexpr int nd = 128;
            LDS_WAIT();
            u32x4 au0, au1, au2, au3, av0, av1, av2, av3, bu0, bu1, bu2, bu3, bv0, bv1, bv2, bv3, axh, axo, bxh, bxo; float ag, bg; int at, bt;
            u32x2 ra, rb;
#define SW_REC(k_, R) do { const int kk_ = (k_) < nd ? (k_) : nd - 1; R = *(const LAS u32x2*)(wl + 32 * kk_); } while (0)
#define SW_LOAD(k_, R, U0, U1, U2, U3, V0, V1, V2, V3, XH, XO, G, T) do { \
    const unsigned p0_ = (unsigned)__builtin_amdgcn_readfirstlane((int)R.x), p1_ = (unsigned)__builtin_amdgcn_readfirstlane((int)R.y); T = (int)((p0_ >> 14) & 3u); \
    const unsigned e0_ = p0_ & 0x3fffu, e1_ = p0_ >> 16, e2_ = p1_ & 0xffffu, e3_ = p1_ >> 16; \
    { const int kk_ = (k_) < nd ? (k_) : nd - 1; G = ((const LAS float*)(wl + 32 * kk_))[4 + (lane >> 4)] * (1.f / peer::PV_SCALE); } \
    XH = *(const LAS u32x4*)(xl + T * peer::XOP_BYTES + 16 * lane); XO = *(const LAS u32x4*)(xl + T * peer::XOP_BYTES + 1024 + 16 * lane); \
    U0 = *(const u32x4*)(PU8 + (size_t)e0_ * 1024 + 16 * lane); U1 = *(const u32x4*)(PU8 + (size_t)e1_ * 1024 + 16 * lane); \
    U2 = *(const u32x4*)(PU8 + (size_t)e2_ * 1024 + 16 * lane); U3 = *(const u32x4*)(PU8 + (size_t)e3_ * 1024 + 16 * lane); \
    V0 = *(const u32x4*)(PV8 + (size_t)e0_ * 1024 + 16 * lane); V1 = *(const u32x4*)(PV8 + (size_t)e1_ * 1024 + 16 * lane); \
    V2 = *(const u32x4*)(PV8 + (size_t)e2_ * 1024 + 16 * lane); V3 = *(const u32x4*)(PV8 + (size_t)e3_ * 1024 + 16 * lane); } while (0)
            SW_REC(0, ra); SW_REC(1, rb);
            SW_LOAD(0, ra, au0, au1, au2, au3, av0, av1, av2, av3, axh, axo, ag, at);
#pragma unroll 1
            for (int k = 0; k < nd; k += 2) {
                SW_LOAD(k + 1, rb, bu0, bu1, bu2, bu3, bv0, bv1, bv2, bv3, bxh, bxo, bg, bt);
                SW_REC(k + 2, ra);
                peer::sweep_compute(au0, au1, au2, au3, av0, av1, av2, av3, ag, at, axh, axo, f0, f1, f2, f3, lane, wsel);
                SW_LOAD(k + 2, ra, au0, au1, au2, au3, av0, av1, av2, av3, axh, axo, ag, at);
                SW_REC(k + 3, rb);
                peer::sweep_compute(bu0, bu1, bu2, bu3, bv0, bv1, bv2, bv3, bg, bt, bxh, bxo, f0, f1, f2, f3, lane, wsel);
            }
#undef SW_REC
#undef SW_LOAD
            { const int b = m0 >> 11;
              f32x4 gf[4], g1v[4], b1v[4], g2v[4], b2v[4]; u32x4 ta[4], tb[4]; float mean1[4], rstd1[4];
#pragma unroll
              for (int i = 0; i < 4; ++i) { const u32x4* hp = (const u32x4*)(TB + (size_t)(m0 + i) * DM + 16 * lane); ta[i] = hp[0]; tb[i] = hp[1]; mean1[i] = PART[2 * (size_t)(m0 + i)]; rstd1[i] = PART[2 * (size_t)(m0 + i) + 1]; }
#pragma unroll
              for (int d = 0; d < 4; ++d) { gf[d] = ((const f32x4*)(MOD + (size_t)b * 6144 + 5120 + 16 * lane))[d]; g1v[d] = ((const f32x4*)(args.in[I_LN1G] + 16 * lane))[d]; b1v[d] = ((const f32x4*)(args.in[I_LN1B] + 16 * lane))[d];
                  g2v[d] = ((const f32x4*)(args.in[I_LN2G] + 16 * lane))[d]; b2v[d] = ((const f32x4*)(args.in[I_LN2B] + 16 * lane))[d]; }
#pragma unroll
              for (int i = 0; i < 4; ++i) { const int m = m0 + i; float v[16];
#pragma unroll
                  for (int d = 0; d < 4; ++d) {
                      const unsigned qa = d < 2 ? (d == 0 ? ta[i].x : ta[i].z) : (d == 2 ? tb[i].x : tb[i].z), qb = d < 2 ? (d == 0 ? ta[i].y : ta[i].w) : (d == 2 ? tb[i].y : tb[i].w);
                      const f32x4 t = {bf_lo(qa), bf_hi(qa), bf_lo(qb), bf_hi(qb)};
#pragma unroll
                      for (int e = 0; e < 4; ++e) { const float fv = (i == 0 ? f0[4 * d + e] : i == 1 ? f1[4 * d + e] : i == 2 ? f2[4 * d + e] : f3[4 * d + e]);
                          v[4 * d + e] = gf[d][e] * fv + ALPHA * ((t[e] - mean1[i]) * rstd1[i] * g1v[d][e] + b1v[d][e]); } }
                  float s = 0.f;
#pragma unroll
                  for (int e = 0; e < 16; ++e) s += v[e];
                  const float mean = wave_sum(s) * (1.f / DM); float s2 = 0.f;
#pragma unroll
                  for (int e = 0; e < 16; ++e) { v[e] -= mean; s2 += v[e] * v[e]; }
                  const float rstd = rsqrtf(wave_sum(s2) * (1.f / DM) + LN_EPS);
                  f32x4* op = (f32x4*)(args.out + (size_t)m * DM + 16 * lane);
#pragma unroll
                  for (int d = 0; d < 4; ++d) { f32x4 o;
#pragma unroll
                      for (int e = 0; e < 4; ++e) o[e] = v[4 * d + e] * rstd * g2v[d][e] + b2v[d][e];
                      op[d] = o; } } }
        }
    }
    if (MK_TSEL >= 0) { if (MK_TSEL == 10) t_b = __builtin_amdgcn_s_memrealtime(); if (bx == 0) { const unsigned long long span = t_b - t_a, t0 = __builtin_amdgcn_s_memrealtime(); while (__builtin_amdgcn_s_memrealtime() - t0 < 4ull * span) __builtin_amdgcn_s_sleep(8); } }
#undef IN
#undef SEAM
}

extern "C" void kernel_launch(void* const* d_in, const int* in_sizes, int n_in, void* d_out, int out_size, void* d_ws, size_t ws_size, hipStream_t stream) {
    static int grid = 0;
    if (grid == 0) {
        if (n_in != 29 || in_sizes[0] != MLAT * DM || out_size != MLAT * DM || ws_size < WS_END) {
            fprintf(stderr, "kernel_launch: unexpected problem: n_in %d in0 %d out %d ws %zu (need %zu)\n", n_in, n_in > 0 ? in_sizes[0] : -1, out_size, ws_size, (size_t)WS_END); grid = -1; return; }
        int dev = 0, cus = 0;
        if (hipGetDevice(&dev) != hipSuccess || hipDeviceGetAttribute(&cus, hipDeviceAttributeMultiprocessorCount, dev) != hipSuccess) { grid = -1; return; }
        if (hipFuncSetAttribute((const void*)mk_fwd, hipFuncAttributeMaxDynamicSharedMemorySize, LDS_BYTES) != hipSuccess) { fprintf(stderr, "kernel_launch: hipFuncSetAttribute failed\n"); grid = -1; return; }
        int per_cu = 0;
        if (hipOccupancyMaxActiveBlocksPerMultiprocessor(&per_cu, (const void*)mk_fwd, NWAVES * 64, LDS_BYTES) != hipSuccess || per_cu < 1)
            fprintf(stderr, "kernel_launch: occupancy query reports %d blocks per CU\n", per_cu);
        (void)hipGetLastError();
        grid = cus >= 256 ? 256 : (cus >= 128 ? 128 : (cus >= 64 ? 64 : -1));
    }
    if (grid < 0) return;
    if (hipMemsetAsync((char*)d_ws + WS_CTL, 0, CTL_ZERO_BYTES, stream) != hipSuccess) return;
    Args a{};
    for (int i = 0; i < 29; ++i) a.in[i] = (const float*)d_in[i];
    a.out = (float*)d_out; a.ws = (unsigned char*)d_ws;
#if MK_N_LAUNCHES == 1
    a.ph_lo = 0; a.ph_hi = NPH;
    hipLaunchKernelGGL(mk_fwd, dim3(grid), dim3(NWAVES * 64), LDS_BYTES, stream, a);
#else
    for (int p = 0; p < NPH; ++p) { a.ph_lo = p; a.ph_hi = p + 1; hipLaunchKernelGGL(mk_fwd, dim3(grid), dim3(NWAVES * 64), LDS_BYTES, stream, a); }
#endif
    const hipError_t le = hipPeekAtLastError();
    if (le != hipSuccess) fprintf(stderr, "kernel_launch: launch failed: %s\n", hipGetErrorName(le));
}
```

```cpp
#include <hip/hip_runtime.h>
#include <cstdio>
#include <cstdint>

#define GAS __attribute__((address_space(1)))
#define LAS __attribute__((address_space(3)))
typedef unsigned short bf16_t;
typedef short bf16x8 __attribute__((ext_vector_type(8)));
typedef short s16x4 __attribute__((ext_vector_type(4)));
typedef short v4i16_t __attribute__((ext_vector_type(4)));
typedef float f32x2 __attribute__((ext_vector_type(2)));
typedef float f32x4 __attribute__((ext_vector_type(4)));
typedef float f32x16 __attribute__((ext_vector_type(16)));
typedef unsigned u32x2 __attribute__((ext_vector_type(2)));
typedef unsigned u32x4 __attribute__((ext_vector_type(4)));


#ifndef MK_TSEL
#define MK_TSEL -1
#endif
#ifndef MK_N_LAUNCHES
#define MK_N_LAUNCHES 1
#endif

constexpr int DM = 1024, NB = 16, SEQ = 2048, CTXL = 256, MLAT = NB * SEQ, MCTX = NB * CTXL, MTOT = MLAT + MCTX;
constexpr int NH = 8, DK = 192, DV = 128, QRANK = 384, KVRANK = 256, NKEY = CTXL + SEQ;
constexpr int INW = 3264;
constexpr int S5W = 512, S5G = 32, S5C = 16, S5P = 64;
constexpr int PEH = 8, PEK = 128, PEXP = 16384, PETOP = 16;
constexpr float LN_EPS = 1e-6f;
constexpr float ALPHA = 1.189207115002721f;
constexpr float QSCALE = 0.07216878364870322f * 1.4426950408889634f;

constexpr size_t MiB = 1u << 20;
constexpr size_t WS_CTL = 0, CTL_ZERO_BYTES = 64 * 1024;
constexpr size_t WS_MOD = 1 * MiB;
constexpr size_t WS_S5ABAR = 1 * MiB + 512 * 1024;
constexpr size_t WS_S5POW = WS_S5ABAR + 32768;
constexpr size_t WS_S5BB = WS_S5POW + 65536;
constexpr size_t WS_S5CM = WS_S5BB + 262144;
constexpr size_t WS_ROPE = WS_S5CM + 262144;
constexpr size_t WS_PART = 3 * MiB;
constexpr size_t WS_S5E = 6 * MiB;
constexpr size_t WS_WIN = 10 * MiB;
constexpr size_t WS_WUQ = WS_WIN + 3328 * 1024 * 2;
constexpr size_t WS_WUKV = WS_WUQ + 1536 * 384 * 2;
constexpr size_t WS_WGLU = WS_WUKV + 2048 * 256 * 2;
constexpr size_t WS_WOUT = WS_WGLU + 2048 * 512 * 2;
constexpr size_t WS_WQ = WS_WOUT + 1024 * 1024 * 2;
constexpr size_t WS_KEYS = WS_WQ + 2048 * 1024 * 2;
static_assert(WS_KEYS + 16 * 128 * 128 * 2 <= 28 * MiB, "weights region");
constexpr size_t WS_ZQ = 28 * MiB;
constexpr size_t WS_Y = 28 * MiB;
constexpr size_t WS_PU = 28 * MiB, WS_PV = 60 * MiB;
constexpr size_t WS_SU = 82 * MiB;
constexpr size_t WS_GATES = 118 * MiB;
constexpr size_t WS_XM2 = 118 * MiB;
constexpr size_t WS_PQ = 182 * MiB;
constexpr size_t WS_XM = 246 * MiB;
constexpr size_t WS_V = 246 * MiB;
constexpr size_t WS_MERGED = 246 * MiB;
constexpr size_t WS_Q = 318 * MiB;
constexpr size_t WS_T = 318 * MiB;
constexpr size_t WS_KN = 414 * MiB;
constexpr size_t WS_KPE = 486 * MiB;
constexpr size_t WS_ROUTE = 448 * MiB;
constexpr size_t WS_END = 492 * MiB;

#define RLX_AGENT __ATOMIC_RELAXED, __HIP_MEMORY_SCOPE_AGENT
#define LDS_WAIT() asm volatile("s_waitcnt lgkmcnt(0)" ::: "memory")
#define VM_WAIT() asm volatile("s_waitcnt vmcnt(0)" ::: "memory")
typedef __bf16 bf16x2_t __attribute__((ext_vector_type(2)));
__device__ __forceinline__ unsigned cvt_pk_bf16(float lo, float hi) { const f32x2 v = {lo, hi}; const bf16x2_t b = __builtin_convertvector(v, bf16x2_t); return __builtin_bit_cast(unsigned, b); }
__device__ __forceinline__ float bf_lo(unsigned u) { return __builtin_bit_cast(float, u << 16); }
__device__ __forceinline__ float bf_hi(unsigned u) { return __builtin_bit_cast(float, u & 0xffff0000u); }
__device__ __forceinline__ float wave_sum(float v) {
#pragma unroll
    for (int o = 1; o < 64; o <<= 1) v += __shfl_xor(v, o);
    return v;
}
__device__ __forceinline__ int lane_id_fresh() { unsigned z; asm volatile("s_mov_b32 %0, 0" : "=s"(z)); return (int)__builtin_amdgcn_mbcnt_hi(~0u, __builtin_amdgcn_mbcnt_lo(~0u, z)); }
__device__ __forceinline__ float sigmoidf_(float x) { return __builtin_amdgcn_rcpf(1.f + __expf(-x)); }
__device__ __forceinline__ float gelu_tanh(float x) {
    const float u = 0.7978845608028654f * (x + 0.044715f * x * x * x);
    return x * __builtin_amdgcn_rcpf(1.f + __expf(-2.f * u));
}

#define MFMA32(a, b, c) __builtin_amdgcn_mfma_f32_32x32x16_bf16(a, b, c, 0, 0, 0)
#define MFMA_PAD() do { __builtin_amdgcn_sched_barrier(0); asm volatile("s_nop 15\n\ts_nop 15\n\ts_nop 15\n\ts_nop 15\n\ts_nop 15\n\ts_nop 15" ::: "memory"); __builtin_amdgcn_sched_barrier(0); } while (0)

namespace pg8 {
constexpr int BM = 256, BK = 64, HALF = 128, HTB = HALF * BK * 2, STAGE_BYTES = 8 * HTB, NXCD = 8, WGM = 8;
__host__ __device__ __forceinline__ int lds_byte(int r, int c) { const int st = (r >> 4) * 2 + (c >> 5), rr = r & 15, cc = c & 31, ob = rr * 64 + cc * 2; return st * 1024 + (ob ^ (((ob >> 9) & 1) << 5)); }
__host__ __device__ __forceinline__ void stage_rc(int b, int& R, int& C) { const int st = b / 1024, sb = b % 1024, swz = sb ^ (((sb >> 9) & 1) << 5); R = (st >> 1) * 16 + swz / 64; C = (st & 1) * 32 + (swz % 64) / 2; }
__host__ __device__ __forceinline__ int perm32(int rho) { const int n = rho >> 4, i = rho & 15; return 8 * (i >> 2) + 4 * n + (i & 3); }
struct Unit { int pm, pn; };
struct Gemm { const bf16_t* A; const bf16_t* Bt; int lda, ldb, K; };
struct StaticOrder {
    int nM, nN, nwg, G, c, nM2, nN2, pm0;
    __device__ void init(int nM_, int nN_, int G_, int c_, int nM2_ = 0, int nN2_ = 0) { nM = nM_; nN = nN_; nwg = nM * nN; G = G_; c = c_; nM2 = nM2_; nN2 = nN2_; pm0 = nM_; }
    __device__ bool next(int i, Unit& u) const {
        const long L = (long)i * G + c;
        if (L >= nwg) { const int e = (int)(L - nwg); if (e >= nM2 * nN2) return false; u.pm = pm0 + e % nM2; u.pn = e / nM2; return true; }
        int wgid = (int)L; { const int q = nwg / NXCD, r = nwg % NXCD, xcd = wgid % NXCD, off = wgid / NXCD; wgid = (xcd < r ? xcd * (q + 1) : r * (q + 1) + (xcd - r) * q) + off; }
        const int nig = WGM * nN, gid = wgid / nig, fm = gid * WGM, gsz = (nM - fm) < WGM ? (nM - fm) : WGM;
        u.pm = fm + ((wgid % nig) % gsz); u.pn = (wgid % nig) / gsz; return true;
    }
};

template <class Epi, class Sched>
__device__ __forceinline__ void gemm_phase(LAS unsigned char* lds, const Gemm g, const Sched& S, const Epi& E, int tid_) {
    asm volatile("" : "+v"(tid_));
    const int tid = tid_, wid = __builtin_amdgcn_readfirstlane(tid >> 6), lane = tid & 63, wr = wid >> 2, wc = wid & 3, fr = lane & 15, fq = lane >> 4;
    const int K = g.K, nt = K / BK;
    unsigned voffA[2], voffB[2];
#pragma unroll
    for (int i = 0; i < 2; ++i) { int R, C; stage_rc(tid * 16 + i * 8192, R, C); const int Rb = Epi::PERM ? ((R & ~31) + perm32(R & 31)) : R;
        voffA[i] = (unsigned)(R * g.lda + C) * 2u; voffB[i] = (unsigned)(Rb * g.ldb + C) * 2u; }
    const size_t kstep = (size_t)(BK * 2);
    const size_t hstepA = (size_t)HALF * g.lda * 2, hstepB = (size_t)HALF * g.ldb * 2;
    const size_t tstepA = 2 * hstepA, tstepB = 2 * hstepB;
    const unsigned ldsw = (unsigned)wid * 1024u;
    const int aoff = lds_byte(wr * 64 + fr, fq * 8), boff = lds_byte(wc * 32 + fr, fq * 8);
#define PG8_SA(b, h) (((b) * 2 + (h)) * HTB)
#define PG8_SB(b, h) ((4 + (b) * 2 + (h)) * HTB)
#define PG8_STAGE(bufoff, gbase, voff) do { _Pragma("unroll") for (int _i = 0; _i < 2; ++_i) \
        __builtin_amdgcn_global_load_lds((const unsigned*)((const char*)(gbase) + (voff)[_i]), (LAS unsigned*)(lds + (bufoff) + ldsw + _i * 8192), 16, 0, 0); } while (0)
#define PG8_LDA(dst, b, h) do { _Pragma("unroll") for (int m = 0; m < 4; ++m) _Pragma("unroll") for (int k = 0; k < 2; ++k) dst[m][k] = *(const LAS bf16x8*)(lds + PG8_SA(b, h) + aoff + m * 2048 + k * 1024); } while (0)
#define PG8_LDB(dst, b, h) do { _Pragma("unroll") for (int n = 0; n < 2; ++n) _Pragma("unroll") for (int k = 0; k < 2; ++k) dst[n][k] = *(const LAS bf16x8*)(lds + PG8_SB(b, h) + boff + n * 2048 + k * 1024); } while (0)
#define PG8_MMA(ai, bj, At, Bt) do { __builtin_amdgcn_s_setprio(1); _Pragma("unroll") for (int m = 0; m < 4; ++m) _Pragma("unroll") for (int n = 0; n < 2; ++n) _Pragma("unroll") for (int k = 0; k < 2; ++k) \
        acc[ai][bj][m][n] = __builtin_amdgcn_mfma_f32_16x16x32_bf16(Bt[n][k], At[m][k], acc[ai][bj][m][n], 0, 0, 0); __builtin_amdgcn_s_setprio(0); } while (0)
#define PG8_WAIT_V(n) asm volatile("s_waitcnt vmcnt(" #n ")" ::: "memory")
#define PG8_WAIT_L(n) asm volatile("s_waitcnt lgkmcnt(" #n ")" ::: "memory")
#define PG8_BAR __builtin_amdgcn_s_barrier()
#define PG8_SCHED __builtin_amdgcn_sched_barrier(0)
    Unit cur, nxt; int ui = 0;
    if (!S.next(0, cur)) return;
    f32x4 acc[2][2][4][2];
#pragma unroll
    for (int a = 0; a < 2; ++a)
#pragma unroll
        for (int b = 0; b < 2; ++b)
#pragma unroll
            for (int m = 0; m < 4; ++m)
#pragma unroll
                for (int n = 0; n < 2; ++n) acc[a][b][m][n] = (f32x4){0.f, 0.f, 0.f, 0.f};
    bf16x8 At[4][2], B0[2][2], B1[2][2];
    const char* cA = (const char*)g.A + (size_t)cur.pm * tstepA; const char* cB = (const char*)g.Bt + (size_t)cur.pn * tstepB;
    PG8_STAGE(PG8_SB(0, 0), cB, voffB); PG8_STAGE(PG8_SB(0, 1), cB + hstepB, voffB); PG8_STAGE(PG8_SA(0, 0), cA, voffA); PG8_STAGE(PG8_SA(0, 1), cA + hstepA, voffA);
    if (wr == 1) PG8_BAR;
    PG8_WAIT_V(2); PG8_BAR;
    PG8_STAGE(PG8_SB(1, 0), cB + kstep, voffB); PG8_STAGE(PG8_SA(1, 0), cA + kstep, voffA); PG8_STAGE(PG8_SB(1, 1), cB + hstepB + kstep, voffB);
    PG8_WAIT_V(6); PG8_BAR;
    for (;;) {
        const bool has_next = S.next(ui + 1, nxt);
        const char* nA = has_next ? (const char*)g.A + (size_t)nxt.pm * tstepA : cA; const char* nB = has_next ? (const char*)g.Bt + (size_t)nxt.pn * tstepB : cB;
        for (int t = 0; t < nt; t += 2) {
            const bool last = (t == nt - 2);
            const char* a1 = cA + (size_t)(t + 1) * kstep;
            const char* a2 = last ? nA : cA + (size_t)(t + 2) * kstep; const char* b2 = last ? nB : cB + (size_t)(t + 2) * kstep;
            const char* a3 = a2 + kstep; const char* b3 = b2 + kstep;
            PG8_LDB(B0, 0, 0); PG8_LDB(B1, 0, 1); PG8_SCHED; PG8_LDA(At, 0, 0); PG8_STAGE(PG8_SA(1, 1), a1 + hstepA, voffA);
            PG8_WAIT_V(8); PG8_WAIT_L(0); PG8_BAR; PG8_MMA(0, 0, At, B0); PG8_MMA(0, 1, At, B1); PG8_BAR; PG8_SCHED;
            PG8_LDA(At, 0, 1); PG8_STAGE(PG8_SB(0, 0), b2, voffB); PG8_STAGE(PG8_SB(0, 1), b2 + hstepB, voffB); PG8_STAGE(PG8_SA(0, 0), a2, voffA);
            PG8_WAIT_V(8); PG8_WAIT_L(0); PG8_BAR; PG8_MMA(1, 0, At, B0); PG8_MMA(1, 1, At, B1); PG8_BAR; PG8_SCHED;
            PG8_LDB(B0, 1, 0); PG8_LDB(B1, 1, 1); PG8_SCHED; PG8_LDA(At, 1, 0); PG8_STAGE(PG8_SA(0, 1), a2 + hstepA, voffA);
            PG8_WAIT_V(8); PG8_WAIT_L(0); PG8_BAR; PG8_MMA(0, 0, At, B0); PG8_MMA(0, 1, At, B1); PG8_BAR; PG8_SCHED;
            PG8_LDA(At, 1, 1); PG8_STAGE(PG8_SB(1, 0), b3, voffB); PG8_STAGE(PG8_SB(1, 1), b3 + hstepB, voffB); PG8_STAGE(PG8_SA(1, 0), a3, voffA);
            PG8_WAIT_V(8); PG8_WAIT_L(0); PG8_BAR; PG8_MMA(1, 0, At, B0); PG8_MMA(1, 1, At, B1); PG8_BAR; PG8_SCHED;
        }
        if (wr == 0) PG8_BAR;
        MFMA_PAD();
        { const int l2 = lane_id_fresh(); E(acc, cur, wr, wc, l2 & 15, l2 >> 4); }
        if (!has_next) break;
#pragma unroll
        for (int a = 0; a < 2; ++a)
#pragma unroll
            for (int b = 0; b < 2; ++b)
#pragma unroll
                for (int m = 0; m < 4; ++m)
#pragma unroll
                    for (int n = 0; n < 2; ++n) acc[a][b][m][n] = (f32x4){0.f, 0.f, 0.f, 0.f};
        cur = nxt; cA = nA; cB = nB; ++ui;
        if (wr == 1) PG8_BAR;
    }
    PG8_WAIT_V(0);
    PG8_BAR;
#undef PG8_SA
#undef PG8_SB
#undef PG8_STAGE
#undef PG8_LDA
#undef PG8_LDB
#undef PG8_MMA
#undef PG8_WAIT_V
#undef PG8_WAIT_L
#undef PG8_BAR
#undef PG8_SCHED
}
}

typedef f32x4 acc_t[2][2][4][2];
__device__ __forceinline__ u32x4 pack8(const f32x4 a, const f32x4 b) { u32x4 w; w.x = cvt_pk_bf16(a[0], a[1]); w.y = cvt_pk_bf16(a[2], a[3]); w.z = cvt_pk_bf16(b[0], b[1]); w.w = cvt_pk_bf16(b[2], b[3]); return w; }

struct EpiInProj { static constexpr bool PERM = true;
    bf16_t* ZQ; bf16_t* SU; bf16_t* GATES; float* PART;
    __device__ __forceinline__ void operator()(const acc_t& acc, const pg8::Unit& u, int wr, int wc, int fr, int fq) const {
        const int row0 = u.pm * 256 + wr * 64 + fr, pn = u.pn;
#pragma unroll
        for (int ai = 0; ai < 2; ++ai)
#pragma unroll
            for (int m = 0; m < 4; ++m) { const int row = row0 + ai * 128 + m * 16;
#pragma unroll
                for (int bj = 0; bj < 2; ++bj) { f32x4 v0 = acc[ai][bj][m][0], v1 = acc[ai][bj][m][1]; const int c0 = bj * 128 + wc * 32 + 8 * fq;
                    if (pn < 3) {
                        *(u32x4*)(ZQ + (size_t)row * 768 + pn * 256 + c0) = pack8(v0, v1);
                        float ss = (v0[0] * v0[0] + v0[1] * v0[1]) + (v0[2] * v0[2] + v0[3] * v0[3]) + (v1[0] * v1[0] + v1[1] * v1[1]) + (v1[2] * v1[2] + v1[3] * v1[3]);
                        ss += __shfl_xor(ss, 16); ss += __shfl_xor(ss, 32);
                        const int slot = pn * 2 + bj;
                        if (fq == 0 && slot < 5) PART[(size_t)row * 20 + slot * 4 + wc] = ss;
                    } else if (pn < 5) {
                        *(u32x4*)(SU + (size_t)row * 512 + (pn - 3) * 256 + c0) = pack8(v0, v1);
                    } else {
#pragma unroll
                        for (int e = 0; e < 4; ++e) { v0[e] = sigmoidf_(v0[e]); v1[e] = sigmoidf_(v1[e]); }
                        *(u32x4*)(GATES + (size_t)row * 2048 + (pn - 5) * 256 + c0) = pack8(v0, v1);
                    } } }
    }
};
struct EpiUQ { static constexpr bool PERM = true;
    bf16_t* Q; const float* PART;
    __device__ __forceinline__ void operator()(const acc_t& acc, const pg8::Unit& u, int wr, int wc, int fr, int fq) const {
        asm volatile("" : "+v"(fr), "+v"(fq));
        const int row0 = u.pm * 256 + wr * 64 + fr;
#pragma unroll
        for (int ai = 0; ai < 2; ++ai)
#pragma unroll
            for (int m = 0; m < 4; ++m) { asm volatile("" ::: "memory"); const int row = row0 + ai * 128 + m * 16; const int b = row >> 11, l = row & 2047;
                const f32x4* pp = (const f32x4*)(PART + (size_t)row * 20); const f32x4 p0 = pp[0], p1 = pp[1], p2 = pp[2];
                const float ssq = ((p0[0] + p0[1]) + (p0[2] + p0[3])) + ((p1[0] + p1[1]) + (p1[2] + p1[3])) + ((p2[0] + p2[1]) + (p2[2] + p2[3]));
                const float sc = rsqrtf(ssq * (1.f / 384.f) + LN_EPS) * QSCALE;
#pragma unroll
                for (int bj = 0; bj < 2; ++bj) { const f32x4 v0 = acc[ai][bj][m][0] * sc, v1 = acc[ai][bj][m][1] * sc;
                    const int g0 = u.pn * 256 + bj * 128 + wc * 32;
                    const int head = g0 / 192, w0 = g0 - head * 192;
                    *(u32x4*)(Q + ((size_t)(b * NH + head) * SEQ + l) * DK + w0 + 8 * fq) = pack8(v0, v1);
                } }
    }
};
struct EpiUKV { static constexpr bool PERM = true;
    bf16_t* KN; bf16_t* V; const float* PART;
    __device__ __forceinline__ void operator()(const acc_t& acc, const pg8::Unit& u, int wr, int wc, int fr, int fq) const {
        asm volatile("" : "+v"(fr), "+v"(fq));
        const int row0 = u.pm * 256 + wr * 64 + fr;
#pragma unroll
        for (int ai = 0; ai < 2; ++ai)
#pragma unroll
            for (int m = 0; m < 4; ++m) { asm volatile("" ::: "memory"); const int row = row0 + ai * 128 + m * 16;
                int b, key; if (row < MLAT) { b = row >> 11; key = CTXL + (row & 2047); } else { const int r2 = row - MLAT; b = r2 >> 8; key = r2 & 255; }
                const f32x4* pp = (const f32x4*)(PART + (size_t)row * 20 + 12); const f32x4 p0 = pp[0], p1 = pp[1];
                const float ssq = ((p0[0] + p0[1]) + (p0[2] + p0[3])) + ((p1[0] + p1[1]) + (p1[2] + p1[3]));
                const float sc = rsqrtf(ssq * (1.f / 256.f) + LN_EPS);
#pragma unroll
                for (int bj = 0; bj < 2; ++bj) { const f32x4 v0 = acc[ai][bj][m][0] * sc, v1 = acc[ai][bj][m][1] * sc;
                    const int head = u.pn; bf16_t* dst = (bj == 0) ? KN : V;
                    *(u32x4*)(dst + ((size_t)(b * NH + head) * NKEY + key) * 128 + wc * 32 + 8 * fq) = pack8(v0, v1);
                } }
    }
};
struct EpiGLU { static constexpr bool PERM = true;
    const bf16_t* ATT; const bf16_t* GATES; bf16_t* MERGED;
    __device__ __forceinline__ void operator()(const acc_t& acc, const pg8::Unit& u, int wr, int wc, int fr, int fq) const {
        asm volatile("" : "+v"(fr), "+v"(fq));
        const int row0 = u.pm * 256 + wr * 64 + fr; const int head = u.pn, d0 = wc * 32 + 8 * fq, j0 = head * 128 + d0;
#define GLU_LD(it_, AT, GS) do { const int row_ = row0 + ((it_) >> 2) * 128 + ((it_) & 3) * 16; const int b_ = row_ >> 11, l_ = row_ & 2047; \
        AT = *(const u32x4*)(ATT + ((size_t)(b_ * NH + head) * SEQ + (l_ & ~255)) * DK + (l_ & 255) * 128 + d0); GS = *(const u32x4*)(GATES + (size_t)row_ * 2048 + 1024 + j0); } while (0)
        u32x4 atn, gsn; GLU_LD(0, atn, gsn);
#pragma unroll
        for (int it = 0; it < 8; ++it) { const int ai = it >> 2, m = it & 3, row = row0 + ai * 128 + m * 16;
            const u32x4 at = atn, gs = gsn;
            if (it + 1 < 8) GLU_LD(it + 1, atn, gsn);
            asm volatile("" ::: "memory");
            const f32x4 a0 = acc[ai][0][m][0], a1 = acc[ai][0][m][1], b0 = acc[ai][1][m][0], b1 = acc[ai][1][m][1];
            f32x4 o0, o1;
#define GLU1(o, a, bb, atw, gsw, e0) o[e0] = bf_lo(atw) + bf_lo(gsw) * a[e0] * sigmoidf_(bb[e0]); o[e0 + 1] = bf_hi(atw) + bf_hi(gsw) * a[e0 + 1] * sigmoidf_(bb[e0 + 1]);
            GLU1(o0, a0, b0, at.x, gs.x, 0) GLU1(o0, a0, b0, at.y, gs.y, 2) GLU1(o1, a1, b1, at.z, gs.z, 0) GLU1(o1, a1, b1, at.w, gs.w, 2)
#undef GLU1
            *(u32x4*)(MERGED + (size_t)row * 1024 + j0) = pack8(o0, o1);
        }
#undef GLU_LD
    }
};
struct EpiOut { static constexpr bool PERM = true;
    const float* X; const float* MOD; bf16_t* T;
    __device__ __forceinline__ void operator()(const acc_t& acc, const pg8::Unit& u, int wr, int wc, int fr, int fq) const {
        asm volatile("" : "+v"(fr), "+v"(fq));
        const int row0 = u.pm * 256 + wr * 64 + fr, c0 = u.pn * 256 + wc * 32 + 8 * fq;
        const float* gpb = MOD + (size_t)(row0 >> 11) * 6144 + 2048 + c0;
        const f32x4 g00 = *(const f32x4*)gpb, g01 = *(const f32x4*)(gpb + 4), g10 = *(const f32x4*)(gpb + 128), g11 = *(const f32x4*)(gpb + 132);
#define OUT_LD(it_, X00, X01, X10, X11) do { const float* xp_ = X + (size_t)(row0 + ((it_) >> 2) * 128 + ((it_) & 3) * 16) * DM + c0; \
        X00 = *(const f32x4*)xp_; X01 = *(const f32x4*)(xp_ + 4); X10 = *(const f32x4*)(xp_ + 128); X11 = *(const f32x4*)(xp_ + 132); } while (0)
        f32x4 n00, n01, n10, n11; OUT_LD(0, n00, n01, n10, n11);
#pragma unroll
        for (int it = 0; it < 8; ++it) { const int ai = it >> 2, m = it & 3, row = row0 + ai * 128 + m * 16;
            const f32x4 x00 = n00, x01 = n01, x10 = n10, x11 = n11;
            if (it + 1 < 8) OUT_LD(it + 1, n00, n01, n10, n11);
            asm volatile("" ::: "memory");
            { const f32x4 t0 = x00 * ALPHA + g00 * acc[ai][0][m][0], t1 = x01 * ALPHA + g01 * acc[ai][0][m][1];
              u32x4 w; w.x = cvt_pk_bf16(t0[0], t0[1]); w.y = cvt_pk_bf16(t0[2], t0[3]); w.z = cvt_pk_bf16(t1[0], t1[1]); w.w = cvt_pk_bf16(t1[2], t1[3]);
              *(u32x4*)(T + (size_t)row * DM + c0) = w; }
            { const f32x4 t0 = x10 * ALPHA + g10 * acc[ai][1][m][0], t1 = x11 * ALPHA + g11 * acc[ai][1][m][1];
              u32x4 w; w.x = cvt_pk_bf16(t0[0], t0[1]); w.y = cvt_pk_bf16(t0[2], t0[3]); w.z = cvt_pk_bf16(t1[0], t1[1]); w.w = cvt_pk_bf16(t1[2], t1[3]);
              *(u32x4*)(T + (size_t)row * DM + c0 + 128) = w; }
        }
#undef OUT_LD
    }
};
struct EpiPQ { static constexpr bool PERM = true;
    bf16_t* PQ;
    __device__ __forceinline__ void operator()(const acc_t& acc, const pg8::Unit& u, int wr, int wc, int fr, int fq) const {
        asm volatile("" : "+v"(fr), "+v"(fq));
        const int row0 = u.pm * 256 + wr * 64 + fr;
#pragma unroll
        for (int ai = 0; ai < 2; ++ai)
#pragma unroll
            for (int m = 0; m < 4; ++m) { const int row = row0 + ai * 128 + m * 16;
#pragma unroll
                for (int bj = 0; bj < 2; ++bj) *(u32x4*)(PQ + (size_t)row * 2048 + u.pn * 256 + bj * 128 + wc * 32 + 8 * fq) = pack8(acc[ai][bj][m][0], acc[ai][bj][m][1]); }
    }
};

#define XB_TMO      128
#define XB_XCNT(j)  (256  + 64 * (j))
#define XB_XSUB(j)  (1280 + 64 * (j))
#define XB_XGEN(j)  (2304 + 64 * (j))
#define XB_TOP      3328
#define XB_TOPGEN   3392
#define XCD_BAR_WORDS 3456
#define XB_SPIN_CAP (1u << 22)
__device__ __forceinline__ unsigned xb_ld(unsigned* p)              { return __hip_atomic_load(p, __ATOMIC_RELAXED, __HIP_MEMORY_SCOPE_AGENT); }
__device__ __forceinline__ unsigned xb_add(unsigned* p, unsigned v) { return __hip_atomic_fetch_add(p, v, __ATOMIC_RELAXED, __HIP_MEMORY_SCOPE_AGENT); }
__device__ __forceinline__ unsigned xb_xcc_id() { return (unsigned)__builtin_amdgcn_s_getreg((3 << 11) | 20) & 0xFu; }
#define XB_SPIN(cond, bar) do { unsigned _sp = 0; while (cond) { __builtin_amdgcn_s_sleep(1); \
    if ((++_sp & 255u) == 0u) { if (xb_ld(&(bar)[XB_TMO])) break; if (_sp > XB_SPIN_CAP) { atomicAdd(&(bar)[XB_TMO], 1u); break; } } } } while (0)
struct XcdBarrier { unsigned* bar; unsigned x; volatile LAS unsigned* st; };
__device__ __forceinline__ XcdBarrier xcd_barrier_post(unsigned* bar, volatile LAS unsigned* st, int tid) {
    XcdBarrier b; b.bar = bar; b.x = xb_xcc_id(); b.st = st;
    if (tid == 0) (void)xb_add(&bar[XB_XCNT(b.x)], 1u);
    return b;
}
__device__ __forceinline__ void xcd_barrier_complete(unsigned* bar, unsigned x, unsigned& nloc, unsigned& nx) {
    const unsigned G = gridDim.x * gridDim.y * gridDim.z;
    unsigned sum, cnt, mine, sp = 0u;
    for (;;) {
        sum = 0u; cnt = 0u; mine = 0u;
#pragma unroll
        for (unsigned j = 0; j < 16; ++j) { const unsigned c = xb_ld(&bar[XB_XCNT(j)]); sum += c; cnt += (c > 0u) ? 1u : 0u; mine = (j == x) ? c : mine; }
        if (sum == G) break;
        __builtin_amdgcn_s_sleep(1);
        if ((++sp & 255u) == 0u) { if (xb_ld(&bar[XB_TMO])) break; if (sp > XB_SPIN_CAP) { atomicAdd(&bar[XB_TMO], 1u); break; } }
    }
    nloc = mine > 0u ? mine : 1u; nx = cnt > 0u ? cnt : 1u;
}
__device__ __forceinline__ void xcd_barrier(const XcdBarrier& b, int tid) {
    asm volatile("s_waitcnt vmcnt(0)" ::: "memory");
    __syncthreads();
    if (tid == 0) {
        unsigned* bar = b.bar;
        __builtin_amdgcn_s_waitcnt(0);
        unsigned nloc = b.st[0], nx = b.st[1];
        if (nloc == 0u) { xcd_barrier_complete(bar, b.x, nloc, nx); b.st[0] = nloc; b.st[1] = nx; }
        const unsigned old = xb_add(&bar[XB_XSUB(b.x)], 1u);
        const unsigned gen = old / nloc;
        if (old + 1u == (gen + 1u) * nloc) {
            __builtin_amdgcn_fence(__ATOMIC_RELEASE, "agent");
            asm volatile("s_waitcnt vmcnt(0)" ::: "memory");
            const unsigned og = xb_add(&bar[XB_TOP], 1u);
            const unsigned tg = og / nx;
            if (og + 1u == (tg + 1u) * nx) xb_add(&bar[XB_TOPGEN], 1u);
            else XB_SPIN(xb_ld(&bar[XB_TOPGEN]) == tg, bar);
            __builtin_amdgcn_fence(__ATOMIC_ACQUIRE, "agent");
            xb_add(&bar[XB_XGEN(b.x)], 1u);
            asm volatile("s_waitcnt vmcnt(0)" ::: "memory");
        } else {
            XB_SPIN(xb_ld(&bar[XB_XGEN(b.x)]) == gen, bar);
            __builtin_amdgcn_fence(__ATOMIC_ACQUIRE, "agent");
            asm volatile("s_waitcnt vmcnt(0)" ::: "memory");
        }
    }
    __syncthreads();
}

__device__ __forceinline__ void transpose_item(const float* W, int ldw, int k0, int nsrc0, bf16_t* WT, int ldt, int ndst0, const float* gk, LAS float* scr, int lane) {
    if (nsrc0 >= 0) {
#pragma unroll 8
        for (int i = 0; i < 32; ++i) { const int kk = 2 * i + (lane >> 5); float v = W[(size_t)(k0 + kk) * ldw + nsrc0 + (lane & 31)]; if (gk) v *= gk[k0 + kk]; scr[kk * 33 + (lane & 31)] = v; }
    } else {
#pragma unroll 8
        for (int i = 0; i < 32; ++i) { const int kk = 2 * i + (lane >> 5); scr[kk * 33 + (lane & 31)] = 0.f; }
    }
    LDS_WAIT(); asm volatile("" ::: "memory");
    const int c = lane & 7;
#pragma unroll
    for (int j = 0; j < 4; ++j) { const int n = (lane >> 3) + 8 * j; const LAS float* s = scr + (8 * c) * 33 + n;
        u32x4 o; o.x = cvt_pk_bf16(s[0 * 33], s[1 * 33]); o.y = cvt_pk_bf16(s[2 * 33], s[3 * 33]); o.z = cvt_pk_bf16(s[4 * 33], s[5 * 33]); o.w = cvt_pk_bf16(s[6 * 33], s[7 * 33]);
        *(u32x4*)(WT + (size_t)(ndst0 + n) * ldt + k0 + 8 * c) = o; }
    LDS_WAIT(); asm volatile("" ::: "memory");
}
__device__ __forceinline__ void modulate_row(const float* xrow, const float* sh, const float* sc, bf16_t* orow, int lane) {
    const f32x4* xr = (const f32x4*)xrow + lane; f32x4 v[4]; float s = 0.f;
#pragma unroll
    for (int j = 0; j < 4; ++j) { v[j] = xr[64 * j]; s += (v[j][0] + v[j][1]) + (v[j][2] + v[j][3]); }
    const float mean = wave_sum(s) * (1.f / DM); float s2 = 0.f;
#pragma unroll
    for (int j = 0; j < 4; ++j) { v[j] = v[j] - mean; s2 += (v[j][0] * v[j][0] + v[j][1] * v[j][1]) + (v[j][2] * v[j][2] + v[j][3] * v[j][3]); }
    const float rstd = rsqrtf(wave_sum(s2) * (1.f / DM) + LN_EPS);
    u32x2* o8 = (u32x2*)orow + lane;
#pragma unroll
    for (int j = 0; j < 4; ++j) { const f32x4 a = ((const f32x4*)sc)[64 * j + lane], b = ((const f32x4*)sh)[64 * j + lane]; const f32x4 y = v[j] * rstd * (a + 1.f) + b;
        u32x2 w; w.x = cvt_pk_bf16(y[0], y[1]); w.y = cvt_pk_bf16(y[2], y[3]); o8[64 * j] = w; }
}
__device__ __forceinline__ void modulate_row_r(f32x4 (&v)[4], const f32x4 (&a1)[4], const f32x4 (&bs)[4], bf16_t* orow, int lane) {
    float s = 0.f;
#pragma unroll
    for (int j = 0; j < 4; ++j) s += (v[j][0] + v[j][1]) + (v[j][2] + v[j][3]);
    const float mean = wave_sum(s) * (1.f / DM); float s2 = 0.f;
#pragma unroll
    for (int j = 0; j < 4; ++j) { v[j] = v[j] - mean; s2 += (v[j][0] * v[j][0] + v[j][1] * v[j][1]) + (v[j][2] * v[j][2] + v[j][3] * v[j][3]); }
    const float rstd = rsqrtf(wave_sum(s2) * (1.f / DM) + LN_EPS);
    u32x2* o8 = (u32x2*)orow + lane;
#pragma unroll
    for (int j = 0; j < 4; ++j) { const f32x4 y = v[j] * rstd * (a1[j] + 1.f) + bs[j]; u32x2 w; w.x = cvt_pk_bf16(y[0], y[1]); w.y = cvt_pk_bf16(y[2], y[3]); o8[64 * j] = w; }
}
__device__ __forceinline__ void modulate_row_v(f32x4 (&v)[4], const float* sh, const float* sc, bf16_t* orow, int lane) {
    float s = 0.f;
#pragma unroll
    for (int j = 0; j < 4; ++j) s += (v[j][0] + v[j][1]) + (v[j][2] + v[j][3]);
    const float mean = wave_sum(s) * (1.f / DM); float s2 = 0.f;
#pragma unroll
    for (int j = 0; j < 4; ++j) { v[j] = v[j] - mean; s2 += (v[j][0] * v[j][0] + v[j][1] * v[j][1]) + (v[j][2] * v[j][2] + v[j][3] * v[j][3]); }
    const float rstd = rsqrtf(wave_sum(s2) * (1.f / DM) + LN_EPS);
    u32x2* o8 = (u32x2*)orow + lane;
#pragma unroll
    for (int j = 0; j < 4; ++j) { const f32x4 a = ((const f32x4*)sc)[64 * j + lane], b = ((const f32x4*)sh)[64 * j + lane]; const f32x4 y = v[j] * rstd * (a + 1.f) + b;
        u32x2 w; w.x = cvt_pk_bf16(y[0], y[1]); w.y = cvt_pk_bf16(y[2], y[3]); o8[64 * j] = w; }
}
__device__ __forceinline__ void ln1_row(f32x4 (&v)[4], float* stat, const f32x4 (&g1v)[4], const f32x4 (&b1v)[4], const f32x4 (&a1)[4], const f32x4 (&bs)[4], bf16_t* orow, int lane) {
    float s = 0.f;
#pragma unroll
    for (int j = 0; j < 4; ++j) s += (v[j][0] + v[j][1]) + (v[j][2] + v[j][3]);
    float mean = wave_sum(s) * (1.f / DM); float s2 = 0.f;
#pragma unroll
    for (int j = 0; j < 4; ++j) { v[j] = v[j] - mean; s2 += (v[j][0] * v[j][0] + v[j][1] * v[j][1]) + (v[j][2] * v[j][2] + v[j][3] * v[j][3]); }
    float rstd = rsqrtf(wave_sum(s2) * (1.f / DM) + LN_EPS);
    s = 0.f;
    if (lane == 0) { stat[0] = mean; stat[1] = rstd; }
#pragma unroll
    for (int j = 0; j < 4; ++j) { v[j] = v[j] * rstd * g1v[j] + b1v[j]; s += (v[j][0] + v[j][1]) + (v[j][2] + v[j][3]); }
    mean = wave_sum(s) * (1.f / DM); s2 = 0.f;
#pragma unroll
    for (int j = 0; j < 4; ++j) { v[j] = v[j] - mean; s2 += (v[j][0] * v[j][0] + v[j][1] * v[j][1]) + (v[j][2] * v[j][2] + v[j][3] * v[j][3]); }
    rstd = rsqrtf(wave_sum(s2) * (1.f / DM) + LN_EPS);
    u32x2* o8 = (u32x2*)orow + lane;
#pragma unroll
    for (int j = 0; j < 4; ++j) { const f32x4 y = v[j] * rstd * (a1[j] + 1.f) + bs[j]; u32x2 w; w.x = cvt_pk_bf16(y[0], y[1]); w.y = cvt_pk_bf16(y[2], y[3]); o8[64 * j] = w; }
}

__device__ __forceinline__ int s5_row(int d, int b, int s) {
    if (d == 0) return (s < CTXL) ? (MLAT + b * CTXL + s) : (b * SEQ + (s - CTXL));
    return (s < CTXL) ? (MLAT + b * CTXL + (CTXL - 1 - s)) : (b * SEQ + (SEQ - 1 - (s - CTXL)));
}
typedef const LAS unsigned char* lds_cptr;
__device__ __forceinline__ s16x4 vtr(lds_cptr p) { return __builtin_bit_cast(s16x4, __builtin_amdgcn_ds_read_tr16_b64_v4i16((LAS v4i16_t*)p)); }
__device__ __forceinline__ void s5_passA(const bf16_t* __restrict__ SU, const float* __restrict__ ABAR, const bf16_t* __restrict__ BB, float* __restrict__ E, int unit, int lane) {
    asm volatile("" : "+v"(lane));
    const int rest = unit >> 2, j = rest & 7, bp = (rest >> 3) & 7, g = ((rest >> 6) & 7) * 4 + (unit & 3), d = rest >> 9;
    const int r = lane & 31, hA = lane >> 5;
    const int bA = 2 * bp + ((r >> 2) & 1), ti = (r & 3) + 4 * (r >> 3);
    const int s_begin = 256 * j, s_end = s_begin + 256;
    const bf16_t* bbp = BB + (size_t)((d * 32 + g) * 2) * 64 * 16;
    const bf16x8 bre0 = *(const bf16x8*)(bbp + (r * 16 + 8 * hA)), bre1 = *(const bf16x8*)(bbp + ((32 + r) * 16 + 8 * hA));
    const bf16x8 bim0 = *(const bf16x8*)(bbp + ((64 + r) * 16 + 8 * hA)), bim1 = *(const bf16x8*)(bbp + ((96 + r) * 16 + 8 * hA));
    const float* ab = ABAR + (size_t)(d * 32 + g) * 128;
    const float ar0 = ab[2 * r], ai0 = ab[2 * r + 1], ar1 = ab[2 * (32 + r)], ai1 = ab[2 * (32 + r) + 1];
    float hr0 = 0.f, hi0 = 0.f, hr1 = 0.f, hi1 = 0.f;
    bf16x8 ua = *(const bf16x8*)(SU + (size_t)s5_row(d, bA, s_begin + ti) * 512 + g * 16 + 8 * hA);
    for (int s0 = s_begin; s0 < s_end; s0 += 16) {
        const int sn = (s0 + 16 < s_end) ? s0 + 16 : s0;
        const bf16x8 un = *(const bf16x8*)(SU + (size_t)s5_row(d, bA, sn + ti) * 512 + g * 16 + 8 * hA);
        const f32x16 z = {};
        __builtin_amdgcn_sched_barrier(0);
        const f32x16 ur0 = MFMA32(ua, bre0, z), ur1 = MFMA32(ua, bre1, z), ui0 = MFMA32(ua, bim0, z), ui1 = MFMA32(ua, bim1, z);
        MFMA_PAD();
#pragma unroll
        for (int i = 0; i < 16; ++i) {
            const float nr0 = fmaf(ar0, hr0, fmaf(-ai0, hi0, ur0[i])), ni0 = fmaf(ar0, hi0, fmaf(ai0, hr0, ui0[i])); hr0 = nr0; hi0 = ni0;
            const float nr1 = fmaf(ar1, hr1, fmaf(-ai1, hi1, ur1[i])), ni1 = fmaf(ar1, hi1, fmaf(ai1, hr1, ui1[i])); hr1 = nr1; hi1 = ni1;
        }
        ua = un;
    }
    const int b = 2 * bp + (lane >> 5);
    float* e = E + (size_t)(((d * 32 + g) * 16 + b) * 8 + j) * 128;
    e[r] = hr0; e[32 + r] = hr1; e[64 + r] = hi0; e[96 + r] = hi1;
}
constexpr int S5_HT_PITCH = 80;
constexpr int S5_LDS_WAVE = 128 * S5_HT_PITCH;
__device__ __forceinline__ void s5_passB(const bf16_t* __restrict__ SU, const float* __restrict__ ABAR, const float* __restrict__ POW, const bf16_t* __restrict__ BB, const bf16_t* __restrict__ CM,
                                         const float* __restrict__ E, const float* __restrict__ DSK, bf16_t* Y, int unit, int lane, LAS unsigned char* ht) {
    asm volatile("" : "+v"(lane));
    const int k = (unit >> 2) & 7, bp = (unit >> 5) & 7, g = (unit >> 8) * 4 + (unit & 3);
    const int r = lane & 31, hA = lane >> 5;
    const int bA = 2 * bp + ((r >> 2) & 1), ti = (r & 3) + 4 * (r >> 3);
    const int bS = 2 * bp + hA;
    const int G4 = lane >> 4, q4 = (lane & 15) >> 2, p4 = lane & 3;
    const lds_cptr trb = (lds_cptr)ht + (8 * hA + q4) * S5_HT_PITCH + (16 * (G4 & 1) + 4 * p4) * 2;
    const int bO = 2 * bp + (r >> 4), tO = r & 15;
    const f32x4 d0 = *(const f32x4*)(DSK + g * 16 + 4 * hA), d1 = *(const f32x4*)(DSK + g * 16 + 8 + 4 * hA);
#pragma unroll 1
    for (int d = 0; d < 2; ++d) {
        const int j = d == 0 ? k : 7 - k;
        const int s_begin = CTXL + 256 * j, s_end = s_begin + 256;
        const bf16_t* bbp = BB + (size_t)((d * 32 + g) * 2) * 64 * 16;
        const bf16x8 bre0 = *(const bf16x8*)(bbp + (r * 16 + 8 * hA)), bre1 = *(const bf16x8*)(bbp + ((32 + r) * 16 + 8 * hA));
        const bf16x8 bim0 = *(const bf16x8*)(bbp + ((64 + r) * 16 + 8 * hA)), bim1 = *(const bf16x8*)(bbp + ((96 + r) * 16 + 8 * hA));
        const float* ab = ABAR + (size_t)(d * 32 + g) * 128;
        const float ar0 = ab[2 * r], ai0 = ab[2 * r + 1], ar1 = ab[2 * (32 + r)], ai1 = ab[2 * (32 + r) + 1];
        bf16x8 cm[8];
#pragma unroll
        for (int ks = 0; ks < 8; ++ks) { cm[ks] = (bf16x8){0, 0, 0, 0, 0, 0, 0, 0}; if (r < 16) cm[ks] = *(const bf16x8*)(CM + ((size_t)((d * 32 + g) * 16 + r) * 128 + 16 * ks + 8 * hA)); }
        float hr0 = 0.f, hi0 = 0.f, hr1 = 0.f, hi1 = 0.f;
        { const float* e = E + (size_t)(((d * 32 + g) * 16 + bS) * 8) * 128;
          const float* pw = POW + ((size_t)(d * 32 + g) * 64) * 2;
          const float pr0 = pw[2 * r], pi0 = pw[2 * r + 1], pr1 = pw[2 * (32 + r)], pi1 = pw[2 * (32 + r) + 1];
          float er0[8], er1[8], ei0[8], ei1[8];
#pragma unroll
          for (int jj = 0; jj < 8; ++jj) { er0[jj] = e[jj * 128 + r]; er1[jj] = e[jj * 128 + 32 + r]; ei0[jj] = e[jj * 128 + 64 + r]; ei1[jj] = e[jj * 128 + 96 + r]; }
#pragma unroll
          for (int jj = 0; jj < 8; ++jj) if (jj <= j) {
              const float nr0 = pr0 * hr0 - pi0 * hi0 + er0[jj], ni0 = pr0 * hi0 + pi0 * hr0 + ei0[jj]; hr0 = nr0; hi0 = ni0;
              const float nr1 = pr1 * hr1 - pi1 * hi1 + er1[jj], ni1 = pr1 * hi1 + pi1 * hr1 + ei1[jj]; hr1 = nr1; hi1 = ni1; } }
        bf16x8 ua = *(const bf16x8*)(SU + (size_t)s5_row(d, bA, s_begin + ti) * 512 + g * 16 + 8 * hA);
        for (int s0 = s_begin; s0 < s_end; s0 += 16) {
            const int sn = (s0 + 16 < s_end) ? s0 + 16 : s0;
            const bf16x8 un = *(const bf16x8*)(SU + (size_t)s5_row(d, bA, sn + ti) * 512 + g * 16 + 8 * hA);
            const f32x16 z = {};
            const int row = s5_row(d, bO, (s0 >= CTXL ? s0 : CTXL) + tO);
            const bf16_t* pre = (d == 0 ? SU : (const bf16_t*)Y) + (size_t)row * 512 + g * 16 + 4 * hA;
            const u32x2 pre0 = *(const u32x2*)pre, pre1 = *(const u32x2*)(pre + 8);
            __builtin_amdgcn_sched_barrier(0);
            f32x16 ur0 = MFMA32(ua, bre0, z), ur1 = MFMA32(ua, bre1, z), ui0 = MFMA32(ua, bim0, z), ui1 = MFMA32(ua, bim1, z);
            MFMA_PAD();
#pragma unroll
            for (int i = 0; i < 16; ++i) {
                const float nr0 = fmaf(ar0, hr0, fmaf(-ai0, hi0, ur0[i])), ni0 = fmaf(ar0, hi0, fmaf(ai0, hr0, ui0[i])); hr0 = nr0; hi0 = ni0; ur0[i] = nr0; ui0[i] = ni0;
                const float nr1 = fmaf(ar1, hr1, fmaf(-ai1, hi1, ur1[i])), ni1 = fmaf(ar1, hi1, fmaf(ai1, hr1, ui1[i])); hr1 = nr1; hi1 = ni1; ur1[i] = nr1; ui1[i] = ni1;
            }
            if (s0 >= CTXL) {
#define S5_WR(V, R) do { LAS unsigned char* wp = ht + (R) * S5_HT_PITCH + hA * 32; \
                    u32x4 w0, w1; w0.x = cvt_pk_bf16(V[0], V[1]); w0.y = cvt_pk_bf16(V[2], V[3]); w0.z = cvt_pk_bf16(V[4], V[5]); w0.w = cvt_pk_bf16(V[6], V[7]); \
                    w1.x = cvt_pk_bf16(V[8], V[9]); w1.y = cvt_pk_bf16(V[10], V[11]); w1.z = cvt_pk_bf16(V[12], V[13]); w1.w = cvt_pk_bf16(V[14], V[15]); \
                    *(LAS u32x4*)wp = w0; *(LAS u32x4*)(wp + 16) = w1; } while (0)
                S5_WR(ur0, r); S5_WR(ur1, 32 + r); S5_WR(ui0, 64 + r); S5_WR(ui1, 96 + r);
#undef S5_WR
                LDS_WAIT();
                f32x16 ya = {}, yb = {};
#pragma unroll
                for (int ks = 0; ks < 8; ++ks) {
                    const s16x4 lo = vtr(trb + (16 * ks) * S5_HT_PITCH), hi = vtr(trb + (16 * ks + 4) * S5_HT_PITCH);
                    const bf16x8 bfrag = (bf16x8){lo[0], lo[1], lo[2], lo[3], hi[0], hi[1], hi[2], hi[3]};
                    if (ks & 1) yb = MFMA32(cm[ks], bfrag, yb); else ya = MFMA32(cm[ks], bfrag, ya);
                }
                MFMA_PAD();
#pragma unroll
                for (int i = 0; i < 8; ++i) ya[i] += yb[i];
                bf16_t* yp = Y + (size_t)row * 512 + g * 16 + 4 * hA;
                if (d == 0) {
                    const u32x2 u0 = pre0, u1 = pre1;
                    u32x2 o0, o1;
                    o0.x = cvt_pk_bf16(ya[0] + d0[0] * bf_lo(u0.x), ya[1] + d0[1] * bf_hi(u0.x)); o0.y = cvt_pk_bf16(ya[2] + d0[2] * bf_lo(u0.y), ya[3] + d0[3] * bf_hi(u0.y));
                    o1.x = cvt_pk_bf16(ya[4] + d1[0] * bf_lo(u1.x), ya[5] + d1[1] * bf_hi(u1.x)); o1.y = cvt_pk_bf16(ya[6] + d1[2] * bf_lo(u1.y), ya[7] + d1[3] * bf_hi(u1.y));
                    *(u32x2*)yp = o0; *(u32x2*)(yp + 8) = o1;
                } else {
                    const u32x2 f0 = pre0, f1 = pre1;
                    u32x2 o0, o1;
                    o0.x = cvt_pk_bf16(gelu_tanh(ya[0] + bf_lo(f0.x)), gelu_tanh(ya[1] + bf_hi(f0.x))); o0.y = cvt_pk_bf16(gelu_tanh(ya[2] + bf_lo(f0.y)), gelu_tanh(ya[3] + bf_hi(f0.y)));
                    o1.x = cvt_pk_bf16(gelu_tanh(ya[4] + bf_lo(f1.x)), gelu_tanh(ya[5] + bf_hi(f1.x))); o1.y = cvt_pk_bf16(gelu_tanh(ya[6] + bf_lo(f1.y)), gelu_tanh(ya[7] + bf_hi(f1.y)));
                    *(u32x2*)yp = o0; *(u32x2*)(yp + 8) = o1;
                }
                LDS_WAIT();
            }
            ua = un;
        }
        VM_WAIT();
    }
}

namespace att {
constexpr int NW = 8, QBLK = 32, KVBLK = 64;
constexpr int SHM_V = KVBLK * 128 * 2, SHM_K = KVBLK * DK * 2;
constexpr int OFF_V = 0, OFF_K = 2 * SHM_V, OFF_WS = OFF_K + 2 * SHM_K, OFF_QPE = OFF_WS + NW * 64 * 4, LDS_BYTES = OFF_QPE + NW * 4096;
constexpr float THRL = 8.f * 1.4426950408889634f;
#define KSWZ(row, colB) ((row) * 384 + ((colB) ^ (((row) & 7) << 4)))
#define SBAR() __builtin_amdgcn_sched_barrier(0)
__device__ __forceinline__ int crow(int r, int hi) { return (r & 3) + 8 * (r >> 2) + 4 * hi; }
__device__ __forceinline__ void partialSM(f32x16& p0, f32x16& p1, float& m_reg, float& mn, float& alpha) {
    float pmax = p0[0];
#pragma unroll
    for (int r = 1; r < 16; ++r) pmax = fmaxf(pmax, p0[r]);
#pragma unroll
    for (int r = 0; r < 16; ++r) pmax = fmaxf(pmax, p1[r]);
    { auto rr = __builtin_amdgcn_permlane32_swap(__float_as_uint(pmax), __float_as_uint(pmax), false, false);
      pmax = fmaxf(__uint_as_float(rr[0]), __uint_as_float(rr[1])); }
    if (__builtin_expect(__all(pmax - m_reg <= THRL), 1)) { mn = m_reg; alpha = 1.f; }
    else { mn = fmaxf(m_reg, pmax); alpha = __builtin_amdgcn_exp2f(m_reg - mn); m_reg = mn; }
#pragma unroll
    for (int r = 0; r < 16; ++r) p0[r] = p0[r] - mn;
#pragma unroll
    for (int r = 0; r < 16; ++r) p1[r] = p1[r] - mn;
#pragma unroll
    for (int r = 0; r < 16; ++r) p0[r] = __builtin_amdgcn_exp2f(p0[r]);
}
__device__ __forceinline__ void finishSM(f32x16& p0, f32x16& p1, float alpha, float& l_reg, bf16x8& pa0, bf16x8& pa1, bf16x8& pa2, bf16x8& pa3) {
#pragma unroll
    for (int r = 0; r < 16; ++r) p1[r] = __builtin_amdgcn_exp2f(p1[r]);
    float ps = 0;
#pragma unroll
    for (int r = 0; r < 16; ++r) ps += p0[r];
#pragma unroll
    for (int r = 0; r < 16; ++r) ps += p1[r];
    { auto rr = __builtin_amdgcn_permlane32_swap(__float_as_uint(ps), __float_as_uint(ps), false, false);
      ps = __uint_as_float(rr[0]) + __uint_as_float(rr[1]); }
    l_reg = l_reg * alpha + ps;
#define PK4(P, BASE, OUT) do { unsigned a0 = cvt_pk_bf16(P[BASE + 0], P[BASE + 1]), a1 = cvt_pk_bf16(P[BASE + 2], P[BASE + 3]);   \
    unsigned b0 = cvt_pk_bf16(P[BASE + 4], P[BASE + 5]), b1 = cvt_pk_bf16(P[BASE + 6], P[BASE + 7]);                              \
    auto r0 = __builtin_amdgcn_permlane32_swap(a0, b0, false, false); auto r1 = __builtin_amdgcn_permlane32_swap(a1, b1, false, false); \
    u32x4 w = {r0[0], r1[0], r0[1], r1[1]}; OUT = *reinterpret_cast<bf16x8*>(&w); } while (0)
    PK4(p0, 0, pa0); PK4(p0, 8, pa1); PK4(p1, 0, pa2); PK4(p1, 8, pa3);
#undef PK4
}
__device__ __forceinline__ void qkt(f32x16& p0, f32x16& p1, const char* Ks, const bf16x8* qr, const char* qpe, int r32, int hi) {
    p0 = f32x16{}; p1 = f32x16{};
#pragma unroll
    for (int d0 = 0; d0 < 12; ++d0) { const int cb = (d0 * 16 + hi * 8) * 2;
        const bf16x8 b0 = *reinterpret_cast<const bf16x8*>(Ks + KSWZ(r32, cb));
        const bf16x8 b1 = *reinterpret_cast<const bf16x8*>(Ks + KSWZ(32 + r32, cb));
        const bf16x8 q = d0 < 8 ? qr[d0 < 8 ? d0 : 0] : *reinterpret_cast<const bf16x8*>(qpe + (d0 - 8) * 1024);
        p0 = MFMA32(b0, q, p0);
        p1 = MFMA32(b1, q, p1); }
}
__device__ __forceinline__ int v_st(int k, int c) { const int kk = (k & ~0xC) | ((k & 4) << 1) | ((k & 8) >> 1); return ((kk >> 3) * 4 + (c >> 5)) * 512 + ((kk & 7) * 32 + (c & 31)) * 2; }
__device__ __forceinline__ int v_rd_base(int lane) { return ((lane & 3) << 3) | (((lane >> 2) & 3) << 6) | (((lane >> 4) & 1) << 5) | (((lane >> 5) & 1) << 8); }
constexpr int v_rd_off(int d0, int ks, int half) { return d0 * 512 + ks * 4096 + half * 2048; }
template <int OFF> __device__ __forceinline__ s16x4 tr_read(int vb) {
    s16x4 r; asm volatile("ds_read_b64_tr_b16 %0, %1 offset:%2" : "=&v"(r) : "v"(vb), "i"(OFF) : "memory"); return r;
}
template <int D0> __device__ __forceinline__ void pv_one(f32x16& od, int vb, bf16x8 pa0, bf16x8 pa1, bf16x8 pa2, bf16x8 pa3) {
    const s16x4 l0 = tr_read<v_rd_off(D0, 0, 0)>(vb), h0 = tr_read<v_rd_off(D0, 0, 1)>(vb), l1 = tr_read<v_rd_off(D0, 1, 0)>(vb), h1 = tr_read<v_rd_off(D0, 1, 1)>(vb);
    const s16x4 l2 = tr_read<v_rd_off(D0, 2, 0)>(vb), h2 = tr_read<v_rd_off(D0, 2, 1)>(vb), l3 = tr_read<v_rd_off(D0, 3, 0)>(vb), h3 = tr_read<v_rd_off(D0, 3, 1)>(vb);
    asm volatile("s_waitcnt lgkmcnt(0)" ::: "memory"); SBAR();
#define PK(L, H) (bf16x8){L[0], L[1], L[2], L[3], H[0], H[1], H[2], H[3]}
    od = MFMA32(pa0, PK(l0, h0), od);
    od = MFMA32(pa1, PK(l1, h1), od);
    od = MFMA32(pa2, PK(l2, h2), od);
    od = MFMA32(pa3, PK(l3, h3), od);
#undef PK
}
__device__ __forceinline__ void pv_d0(f32x16* o, int vb, bf16x8 pa0, bf16x8 pa1, bf16x8 pa2, bf16x8 pa3) {
    pv_one<0>(o[0], vb, pa0, pa1, pa2, pa3); pv_one<1>(o[1], vb, pa0, pa1, pa2, pa3); pv_one<2>(o[2], vb, pa0, pa1, pa2, pa3); pv_one<3>(o[3], vb, pa0, pa1, pa2, pa3);
}
__device__ __forceinline__ void attn_unit(bf16_t* Qu, const bf16_t* __restrict__ Kh, const bf16_t* __restrict__ Pb, const bf16_t* __restrict__ Vh, const bf16_t* __restrict__ Gm, const float* __restrict__ ROPEt, int l0, char* lds, int tid_) {
    asm volatile("" : "+v"(tid_));
    const int tid = tid_, wid = __builtin_amdgcn_readfirstlane(tid >> 6), lane = tid & 63, r32 = lane & 31, hi = lane >> 5;
    char* V_lds = lds + OFF_V; char* K_lds = lds + OFF_K;
    float* ws = (float*)(lds + OFF_WS) + wid * 64; float* li_l = ws; float* al_l = ws + 32;
    float m_reg = -1e30f, l_reg = 0; f32x16 o[4] = {}; bf16x8 qr[8]; char* qpe = lds + OFF_QPE + wid * 4096 + lane * 16;
    const int sr = tid >> 4, sc = (tid & 15) * 8, vst0 = v_st(sr, sc), vst1 = v_st(32 + sr, sc);
    const int pr = tid >> 3, pc = (tid & 7) * 8;
    const int vb0 = (int)(uintptr_t)V_lds + v_rd_base(lane);
    bf16x8 vs0, vs1, ks0, ks1, ps0;
    const unsigned go0 = (unsigned)(sr * 128 + sc) * 2u, go1 = go0 + 8192u, go2 = (unsigned)(pr * 64 + pc) * 2u;
#define SLOAD(k0) do { const char* vt_ = (const char*)Vh + (size_t)(k0) * 256; const char* kt_ = (const char*)Kh + (size_t)(k0) * 256; const char* pt_ = (const char*)Pb + (size_t)(k0) * 128; \
    vs0 = *(const bf16x8*)(vt_ + go0); vs1 = *(const bf16x8*)(vt_ + go1); ks0 = *(const bf16x8*)(kt_ + go0); ks1 = *(const bf16x8*)(kt_ + go1); \
    ps0 = *(const bf16x8*)(pt_ + go2); } while (0)
#define SWRITE(b) do { *(bf16x8*)(V_lds + (b) * SHM_V + vst0) = vs0; *(bf16x8*)(V_lds + (b) * SHM_V + vst1) = vs1; const int kc = sc * 2;  \
    *(bf16x8*)(K_lds + (b) * SHM_K + KSWZ(sr, kc)) = ks0; *(bf16x8*)(K_lds + (b) * SHM_K + KSWZ(32 + sr, kc)) = ks1;                       \
    *(bf16x8*)(K_lds + (b) * SHM_K + KSWZ(pr, 256 + pc * 2)) = ps0; } while (0)
#define SWAIT() asm volatile("s_waitcnt vmcnt(0)" ::: "memory")
#define RESC(a) do { if (__any((a) < 1.f)) { if (hi == 0) al_l[r32] = (a); asm volatile("s_waitcnt lgkmcnt(0)" ::: "memory"); \
    _Pragma("unroll") for (int d = 0; d < 4; ++d) _Pragma("unroll") for (int r = 0; r < 16; ++r) o[d][r] *= al_l[crow(r, hi)]; } } while (0)
    SLOAD(0); SBAR();
    const bf16_t* Qw = Qu + (size_t)(wid * QBLK + r32) * DK + hi * 8;
#pragma unroll
    for (int d0 = 0; d0 < 8; ++d0) qr[d0] = *reinterpret_cast<const bf16x8*>(Qw + d0 * 16);
    { const int l = l0 + wid * QBLK + r32;
#pragma unroll
      for (int part = 0; part < 2; ++part) { const int pos = part == 0 ? (l >> 6) : (l & 63);
          const u32x4 x1 = *reinterpret_cast<const u32x4*>(Qw + (8 + 2 * part) * 16), x2 = *reinterpret_cast<const u32x4*>(Qw + (9 + 2 * part) * 16);
          const f32x4* tp = (const f32x4*)(ROPEt + (size_t)pos * 32 + hi * 16); const f32x4 t0 = tp[0], t1 = tp[1], t2 = tp[2], t3 = tp[3];
          u32x4 o1, o2;
#define ROT2(X1, X2, T, O1, O2) { const float a0 = bf_lo(X1), a1 = bf_hi(X1), b0 = bf_lo(X2), b1 = bf_hi(X2); \
          O1 = cvt_pk_bf16(a0 * T[0] - b0 * T[1], a1 * T[2] - b1 * T[3]); O2 = cvt_pk_bf16(b0 * T[0] + a0 * T[1], b1 * T[2] + a1 * T[3]); }
          ROT2(x1.x, x2.x, t0, o1.x, o2.x) ROT2(x1.y, x2.y, t1, o1.y, o2.y) ROT2(x1.z, x2.z, t2, o1.z, o2.z) ROT2(x1.w, x2.w, t3, o1.w, o2.w)
#undef ROT2
          *reinterpret_cast<u32x4*>(qpe + (2 * part) * 1024) = o1; *reinterpret_cast<u32x4*>(qpe + (2 * part + 1) * 1024) = o2; } }
    f32x16 pA0, pA1, pB0, pB1; float mnA, mnB, alA, alB; bf16x8 pa0, pa1, pa2, pa3; constexpr int NT = NKEY / KVBLK;
    SWAIT(); SWRITE(0); __syncthreads();
    SLOAD(KVBLK); SBAR();
    qkt(pA0, pA1, K_lds, qr, qpe, r32, hi); partialSM(pA0, pA1, m_reg, mnA, alA);
    SWAIT(); SWRITE(1); __syncthreads();
    for (int j = 1; j + 1 < NT; j += 2) {
        SBAR(); qkt(pB0, pB1, K_lds + SHM_K, qr, qpe, r32, hi);
        finishSM(pA0, pA1, alA, l_reg, pa0, pa1, pa2, pa3); SBAR();
        SLOAD((j + 1) * KVBLK); SBAR();
        pv_d0(o, vb0, pa0, pa1, pa2, pa3); partialSM(pB0, pB1, m_reg, mnB, alB);
        __syncthreads(); SWAIT(); SWRITE(0);
        RESC(alB); __syncthreads();
        SBAR(); qkt(pA0, pA1, K_lds, qr, qpe, r32, hi);
        finishSM(pB0, pB1, alB, l_reg, pa0, pa1, pa2, pa3); SBAR();
        SLOAD((j + 2) * KVBLK); SBAR();
        pv_d0(o, vb0 + SHM_V, pa0, pa1, pa2, pa3); partialSM(pA0, pA1, m_reg, mnA, alA);
        __syncthreads(); SWAIT(); SWRITE(1);
        RESC(alA); __syncthreads();
    }
    SBAR(); qkt(pB0, pB1, K_lds + SHM_K, qr, qpe, r32, hi);
    finishSM(pA0, pA1, alA, l_reg, pa0, pa1, pa2, pa3); SBAR();
    pv_d0(o, vb0, pa0, pa1, pa2, pa3); partialSM(pB0, pB1, m_reg, mnB, alB);
    __syncthreads(); RESC(alB);
    finishSM(pB0, pB1, alB, l_reg, pa0, pa1, pa2, pa3); SBAR();
    pv_d0(o, vb0 + SHM_V, pa0, pa1, pa2, pa3);
    u32x4 gv[8];
    { const bf16_t* Gw = Gm + (size_t)(wid * QBLK) * 2048;
#pragma unroll
      for (int it = 0; it < 8; ++it) { const int idx = it * 64 + lane, row = idx >> 4, ch = idx & 15; gv[it] = *(const u32x4*)(Gw + (size_t)row * 2048 + ch * 8); } }
    if (hi == 0) li_l[r32] = l_reg; asm volatile("s_waitcnt lgkmcnt(0)" ::: "memory");
    __syncthreads();
    { char* ot = lds + wid * (32 * 272);
#pragma unroll
      for (int r = 0; r < 16; ++r) { const int orow = crow(r, hi); const float rl = __builtin_amdgcn_rcpf(li_l[orow]);
#pragma unroll
          for (int d0 = 0; d0 < 4; ++d0) *(bf16_t*)(ot + orow * 272 + (d0 * 32 + r32) * 2) = (bf16_t)(cvt_pk_bf16(o[d0][r] * rl, 0.f) & 0xffffu); }
      asm volatile("s_waitcnt lgkmcnt(0)" ::: "memory");
      bf16_t* Ow = Qu + (size_t)(wid * QBLK) * 128;
#pragma unroll
      for (int it = 0; it < 8; ++it) { const int idx = it * 64 + lane, row = idx >> 4, ch = idx & 15;
          const u32x4 ov = *(const u32x4*)(ot + row * 272 + ch * 16); const u32x4 g4 = gv[it];
          u32x4 w; w.x = cvt_pk_bf16(bf_lo(ov.x) * bf_lo(g4.x), bf_hi(ov.x) * bf_hi(g4.x)); w.y = cvt_pk_bf16(bf_lo(ov.y) * bf_lo(g4.y), bf_hi(ov.y) * bf_hi(g4.y));
          w.z = cvt_pk_bf16(bf_lo(ov.z) * bf_lo(g4.z), bf_hi(ov.z) * bf_hi(g4.z)); w.w = cvt_pk_bf16(bf_lo(ov.w) * bf_lo(g4.w), bf_hi(ov.w) * bf_hi(g4.w));
          *(u32x4*)(Ow + (size_t)row * 128 + ch * 8) = w; } }
    __syncthreads();
#undef SLOAD
#undef SWRITE
#undef SWAIT
#undef RESC
}
#undef KSWZ
#undef SBAR
}


namespace peer {
__device__ __forceinline__ int f2key(float f) { const int b = __builtin_bit_cast(int, f); return b ^ ((b >> 31) & 0x7fffffff); }
__device__ __forceinline__ float key2f(int k) { return __builtin_bit_cast(float, k ^ ((k >> 31) & 0x7fffffff)); }
__device__ __forceinline__ void ce_desc(int& a, int& b) { const int hi = a > b ? a : b, lo = a > b ? b : a; a = hi; b = lo; }
__device__ __forceinline__ void sort16_desc(int (&v)[16]) {
#pragma unroll
    for (int k = 2; k <= 16; k <<= 1)
#pragma unroll
        for (int j = k >> 1; j > 0; j >>= 1)
#pragma unroll
            for (int i = 0; i < 16; ++i) { const int l = i ^ j; if (l > i) { if ((i & k) == 0) ce_desc(v[i], v[l]); else ce_desc(v[l], v[i]); } }
}
__device__ __forceinline__ void merge_top16(int (&a)[16], const int (&b)[16]) {
#pragma unroll
    for (int i = 0; i < 16; ++i) a[i] = a[i] > b[15 - i] ? a[i] : b[15 - i];
#pragma unroll
    for (int j = 8; j > 0; j >>= 1)
#pragma unroll
        for (int i = 0; i < 16; ++i) { const int l = i ^ j; if (l > i) ce_desc(a[i], a[l]); }
}
__device__ __forceinline__ int lut16(const int (&P)[4], int a) { const int s = a >> 2; const int v = (P[0] & -(int)(s == 0)) | (P[1] & -(int)(s == 1)) | (P[2] & -(int)(s == 2)) | (P[3] & -(int)(s == 3)); return (v >> (8 * (a & 3))) & 127; }
constexpr int KSW_BYTES = 2 * 128 * 256;
__device__ __forceinline__ int ksw(int z, int key, int colB) { return (z * 128 + key) * 256 + (colB ^ ((key & 7) << 4)); }

__device__ constexpr int G2A[16] = {1, 1, 1, 1, 1, 1, 1, 2, 2, 2, 2, 3, 3, 3, 4, 4}, G2B[16] = {1, 2, 3, 4, 5, 6, 7, 1, 2, 3, 4, 1, 2, 3, 1, 2};
__device__ constexpr int G3A[3] = {5, 6, 7}, G3B[3] = {1, 1, 1};

__device__ __forceinline__ void route_unit(const bf16_t* __restrict__ PQ, const char* KL, unsigned* __restrict__ RIDX, float* __restrict__ RW, int tok0, int h, int lane) {
    const int r32 = lane & 31, hi = lane >> 5;
    int X[2][16];
#pragma unroll
    for (int z = 0; z < 2; ++z) {
        bf16x8 qf[8];
        const bf16_t* qp = PQ + (size_t)(tok0 + r32) * 2048 + h * 256 + z * 128 + hi * 8;
#pragma unroll
        for (int ks = 0; ks < 8; ++ks) qf[ks] = *(const bf16x8*)(qp + ks * 16);
        f32x16 acc[4];
#pragma unroll
        for (int kt = 0; kt < 4; ++kt) { acc[kt] = f32x16{};
#pragma unroll
            for (int ks = 0; ks < 8; ++ks) { const bf16x8 kf = *(const bf16x8*)(KL + ksw(z, kt * 32 + r32, (ks * 16 + hi * 8) * 2)); acc[kt] = MFMA32(kf, qf[ks], acc[kt]); } }
        MFMA_PAD();
        int g0[16], g1[16];
#pragma unroll
        for (int half = 0; half < 2; ++half) {
#pragma unroll
            for (int i = 0; i < 16; ++i) { g0[i] = (f2key(acc[2 * half][i]) & ~127) | (64 * half + (i & 3) + 8 * (i >> 2) + 4 * hi);
                                           g1[i] = (f2key(acc[2 * half + 1][i]) & ~127) | (64 * half + 32 + (i & 3) + 8 * (i >> 2) + 4 * hi); }
            sort16_desc(g0); sort16_desc(g1); merge_top16(g0, g1);
            if (half == 0) {
#pragma unroll
                for (int i = 0; i < 16; ++i) X[z][i] = g0[i];
            } else merge_top16(X[z], g0);
        }
    }
    int T0[16], T1[16];
    { int P[16];
#pragma unroll
      for (int i = 0; i < 16; ++i) { auto rr = __builtin_amdgcn_permlane32_swap((unsigned)X[0][i], (unsigned)X[1][i], false, false); T0[i] = (int)rr[0]; P[i] = (int)rr[1]; }
      merge_top16(T0, P);
#pragma unroll
      for (int i = 0; i < 16; ++i) { auto rr = __builtin_amdgcn_permlane32_swap((unsigned)T0[i], (unsigned)T0[i], false, false); T0[i] = (int)rr[0]; T1[i] = (int)rr[1]; } }
    float f0[16], f1[16]; int I0[4] = {0, 0, 0, 0}, I1[4] = {0, 0, 0, 0};
#pragma unroll
    for (int a = 0; a < 16; ++a) { f0[a] = key2f(T0[a] & ~127); f1[a] = key2f(T1[a] & ~127); I0[a >> 2] |= (T0[a] & 127) << (8 * (a & 3)); I1[a >> 2] |= (T1[a] & 127) << (8 * (a & 3)); }
    int C0[16], C1[16], C2[16], C3[16];
#pragma unroll
    for (int b = 0; b < 16; ++b) C0[b] = (f2key(f0[0] + f1[b]) & ~255) | b;
#pragma unroll
    for (int a = 1; a < 16; ++a) C1[a - 1] = (f2key(f0[a] + f1[0]) & ~255) | (a << 4);
    C1[15] = (int)0x80000000;
#pragma unroll
    for (int c = 0; c < 16; ++c) C2[c] = (f2key(f0[G2A[c]] + f1[G2B[c]]) & ~255) | (G2A[c] << 4) | G2B[c];
#pragma unroll
    for (int c = 0; c < 16; ++c) C3[c] = (int)0x80000000;
#pragma unroll
    for (int c = 0; c < 3; ++c) C3[c] = (f2key(f0[G3A[c]] + f1[G3B[c]]) & ~255) | (G3A[c] << 4) | G3B[c];
    ce_desc(C3[0], C3[1]); ce_desc(C3[1], C3[2]); ce_desc(C3[0], C3[1]);
    sort16_desc(C2);
    merge_top16(C0, C1); merge_top16(C2, C3); merge_top16(C0, C2);
    float sc[16]; float ssum = 0.f; const float smax = key2f(C0[0] & ~255);
#pragma unroll
    for (int k = 0; k < 16; ++k) { sc[k] = __expf(key2f(C0[k] & ~255) - smax); ssum += sc[k]; }
    const float rs = __builtin_amdgcn_rcpf(ssum);
    {
        unsigned* ip = RIDX + (size_t)(tok0 + r32) * 128 + h * 16; float* wp = RW + (size_t)(tok0 + r32) * 128 + h * 16;
#pragma unroll
        for (int k4 = 0; k4 < 4; ++k4) { u32x4 iv; f32x4 wv;
#pragma unroll
            for (int e = 0; e < 4; ++e) { const int k = 4 * k4 + e, ab = C0[k] & 255; iv[e] = (unsigned)(lut16(I0, ab >> 4) * 128 + lut16(I1, ab & 15)); wv[e] = sc[k] * rs; }
            *(u32x4*)(ip + 4 * k4) = iv; *(f32x4*)(wp + 4 * k4) = wv; }
    }
}

constexpr float PU_SCALE = 256.f, PV_SCALE = 16.f;
#define DPP_ADD(s, ctrl) s += __builtin_bit_cast(float, __builtin_amdgcn_update_dpp(0, __builtin_bit_cast(int, s), ctrl, 0xF, 0xF, true))
__device__ __forceinline__ void acc16_fp8(const u32x4 w, const float a, float (&f)[16]) {
    const f32x2 a0 = __builtin_amdgcn_cvt_pk_f32_fp8((int)w.x, false), a1 = __builtin_amdgcn_cvt_pk_f32_fp8((int)w.x, true), a2 = __builtin_amdgcn_cvt_pk_f32_fp8((int)w.y, false), a3 = __builtin_amdgcn_cvt_pk_f32_fp8((int)w.y, true);
    const f32x2 a4 = __builtin_amdgcn_cvt_pk_f32_fp8((int)w.z, false), a5 = __builtin_amdgcn_cvt_pk_f32_fp8((int)w.z, true), a6 = __builtin_amdgcn_cvt_pk_f32_fp8((int)w.w, false), a7 = __builtin_amdgcn_cvt_pk_f32_fp8((int)w.w, true);
    f[0] = fmaf(a, a0[0], f[0]); f[1] = fmaf(a, a0[1], f[1]); f[2] = fmaf(a, a1[0], f[2]); f[3] = fmaf(a, a1[1], f[3]); f[4] = fmaf(a, a2[0], f[4]); f[5] = fmaf(a, a2[1], f[5]); f[6] = fmaf(a, a3[0], f[6]); f[7] = fmaf(a, a3[1], f[7]);
    f[8] = fmaf(a, a4[0], f[8]); f[9] = fmaf(a, a4[1], f[9]); f[10] = fmaf(a, a5[0], f[10]); f[11] = fmaf(a, a5[1], f[11]); f[12] = fmaf(a, a6[0], f[12]); f[13] = fmaf(a, a6[1], f[13]); f[14] = fmaf(a, a7[0], f[14]); f[15] = fmaf(a, a7[1], f[15]);
}
constexpr int TOK_PER_WAVE = 4;
constexpr int LIST_BYTES = 128 * 8, TOKLDS_BYTES = LIST_BYTES + 512;
__device__ __forceinline__ unsigned wave_scan_incl(unsigned x) {
    x += (unsigned)__builtin_amdgcn_update_dpp(0, (int)x, 0x111, 0xF, 0xF, true);
    x += (unsigned)__builtin_amdgcn_update_dpp(0, (int)x, 0x112, 0xF, 0xF, true);
    x += (unsigned)__builtin_amdgcn_update_dpp(0, (int)x, 0x114, 0xF, 0xF, true);
    x += (unsigned)__builtin_amdgcn_update_dpp(0, (int)x, 0x118, 0xF, 0xF, true);
    x += (unsigned)__builtin_amdgcn_update_dpp(0, (int)x, 0x142, 0xA, 0xF, false);
    x += (unsigned)__builtin_amdgcn_update_dpp(0, (int)x, 0x143, 0xC, 0xF, false);
    return x;
}
__device__ __forceinline__ void bucket_token(const unsigned i0, const unsigned i1, const float w0, const float w1, LAS unsigned char* tl, int lane) {
    LAS unsigned* hist = (LAS unsigned*)(tl + LIST_BYTES); LAS unsigned* ent = (LAS unsigned*)tl; LAS float* wt = (LAS float*)(tl + 512);
    hist[lane] = 0u; hist[64 + lane] = 0u;
    LDS_WAIT();
    const unsigned r0 = __hip_atomic_fetch_add(hist + (i0 >> 7), 1u, __ATOMIC_RELAXED, __HIP_MEMORY_SCOPE_WORKGROUP);
    const unsigned r1 = __hip_atomic_fetch_add(hist + (i1 >> 7), 1u, __ATOMIC_RELAXED, __HIP_MEMORY_SCOPE_WORKGROUP);
    LDS_WAIT();
    const unsigned c0 = hist[2 * lane], c1 = hist[2 * lane + 1], tot = c0 + c1;
    unsigned incl = tot;
    incl = wave_scan_incl(incl);
    LDS_WAIT();
    hist[2 * lane] = incl - tot; hist[2 * lane + 1] = incl - tot + c0;
    LDS_WAIT();
    { const unsigned p = hist[i0 >> 7] + r0; ent[p] = i0; wt[p] = w0; }
    { const unsigned p = hist[i1 >> 7] + r1; ent[p] = i1; wt[p] = w1; }
}
constexpr float X_SCALE = 16.f;
constexpr int XOP_BYTES = 2048, DESC_MAX = 128;
constexpr int WAVE_LDS = TOK_PER_WAVE * TOKLDS_BYTES + TOK_PER_WAVE * XOP_BYTES + DESC_MAX * 4;
__device__ __forceinline__ float sat8(float v) { return fminf(fmaxf(v, -440.f), 440.f); }
__device__ __forceinline__ void xop_store(const u32x4 x0, const u32x4 x1, LAS unsigned char* xo, int lane) {
    float x[16];
    x[0] = bf_lo(x0.x); x[1] = bf_hi(x0.x); x[2] = bf_lo(x0.y); x[3] = bf_hi(x0.y); x[4] = bf_lo(x0.z); x[5] = bf_hi(x0.z); x[6] = bf_lo(x0.w); x[7] = bf_hi(x0.w);
    x[8] = bf_lo(x1.x); x[9] = bf_hi(x1.x); x[10] = bf_lo(x1.y); x[11] = bf_hi(x1.y); x[12] = bf_lo(x1.z); x[13] = bf_hi(x1.z); x[14] = bf_lo(x1.w); x[15] = bf_hi(x1.w);
    u32x4 hi, lo;
#pragma unroll
    for (int d = 0; d < 4; ++d) {
        const float a0 = sat8(x[4 * d] * X_SCALE), a1 = sat8(x[4 * d + 1] * X_SCALE), a2 = sat8(x[4 * d + 2] * X_SCALE), a3 = sat8(x[4 * d + 3] * X_SCALE);
        int h = __builtin_amdgcn_cvt_pk_fp8_f32(a0, a1, 0, false); h = __builtin_amdgcn_cvt_pk_fp8_f32(a2, a3, h, true);
        const f32x2 b0 = __builtin_amdgcn_cvt_pk_f32_fp8(h, false), b1 = __builtin_amdgcn_cvt_pk_f32_fp8(h, true);
        int l = __builtin_amdgcn_cvt_pk_fp8_f32(a0 - b0[0], a1 - b0[1], 0, false); l = __builtin_amdgcn_cvt_pk_fp8_f32(a2 - b1[0], a3 - b1[1], l, true);
        hi[d] = (unsigned)h; lo[d] = (unsigned)l; }
    *(LAS u32x4*)(xo + 16 * lane) = hi; *(LAS u32x4*)(xo + 1024 + 16 * lane) = lo;
}
__device__ __forceinline__ void build_recs(LAS unsigned char* wl, int lane) {
    LAS unsigned* hist = (LAS unsigned*)(wl + LIST_BYTES);
    const int q0 = lane, q1 = lane + 64;
    const LAS unsigned* l0 = (const LAS unsigned*)(wl + (q0 >> 5) * TOKLDS_BYTES) + 4 * (q0 & 31); const LAS unsigned* l1 = (const LAS unsigned*)(wl + (q1 >> 5) * TOKLDS_BYTES) + 4 * (q1 & 31);
    const u32x4 ea = *(const LAS u32x4*)l0, wa = *(const LAS u32x4*)(l0 + 128), eb = *(const LAS u32x4*)l1, wb = *(const LAS u32x4*)(l1 + 128);
    const unsigned k0 = ea.x >> 7, k1 = eb.x >> 7;
    LDS_WAIT();
    hist[lane] = 0u; hist[64 + lane] = 0u;
    LDS_WAIT();
    const unsigned r0 = __hip_atomic_fetch_add(hist + k0, 1u, __ATOMIC_RELAXED, __HIP_MEMORY_SCOPE_WORKGROUP);
    const unsigned r1 = __hip_atomic_fetch_add(hist + k1, 1u, __ATOMIC_RELAXED, __HIP_MEMORY_SCOPE_WORKGROUP);
    LDS_WAIT();
    const unsigned c0 = hist[2 * lane], c1 = hist[2 * lane + 1], tot = c0 + c1;
    unsigned incl = tot;
    incl = wave_scan_incl(incl);
    LDS_WAIT();
    hist[2 * lane] = incl - tot; hist[2 * lane + 1] = incl - tot + c0;
    LDS_WAIT();
    const unsigned p0 = hist[k0] + r0, p1 = hist[k1] + r1;
    LDS_WAIT();
    { LAS u32x4* rc = (LAS u32x4*)(wl + 32 * p0); rc[0] = (u32x4){ea.x | ((unsigned)(q0 >> 5) << 14) | (ea.y << 16), ea.z | (ea.w << 16), 0u, 0u}; rc[1] = wa; }
    { LAS u32x4* rc = (LAS u32x4*)(wl + 32 * p1); rc[0] = (u32x4){eb.x | ((unsigned)(q1 >> 5) << 14) | (eb.y << 16), eb.z | (eb.w << 16), 0u, 0u}; rc[1] = wb; }
}
__device__ __forceinline__ long pk64(unsigned lo, unsigned hi) { return (long)(((unsigned long long)hi << 32) | (unsigned long long)lo); }
#define MFMA_FP8(a, b, c) __builtin_amdgcn_mfma_f32_16x16x32_fp8_fp8(a, b, c, 0, 0, 0)
__device__ __forceinline__ void sweep_compute(const u32x4 u0, const u32x4 u1, const u32x4 u2, const u32x4 u3, const u32x4 v0, const u32x4 v1, const u32x4 v2, const u32x4 v3,
                                              const float g, const int tok, const u32x4 xh, const u32x4 xo, float (&f0)[16], float (&f1)[16], float (&f2)[16], float (&f3)[16], int lane, const f32x4 wsel) {
    const long xa = pk64(xh.x, xh.y), xb = pk64(xh.z, xh.w), xc = pk64(xo.x, xo.y), xd = pk64(xo.z, xo.w);
    f32x4 c0 = {0.f, 0.f, 0.f, 0.f}, c1 = c0, c2 = c0, c3 = c0;
    c0 = MFMA_FP8(pk64(u0.x, u0.y), xa, c0); c1 = MFMA_FP8(pk64(u1.x, u1.y), xa, c1); c2 = MFMA_FP8(pk64(u2.x, u2.y), xa, c2); c3 = MFMA_FP8(pk64(u3.x, u3.y), xa, c3);
    c0 = MFMA_FP8(pk64(u0.z, u0.w), xb, c0); c1 = MFMA_FP8(pk64(u1.z, u1.w), xb, c1); c2 = MFMA_FP8(pk64(u2.z, u2.w), xb, c2); c3 = MFMA_FP8(pk64(u3.z, u3.w), xb, c3);
    c0 = MFMA_FP8(pk64(u0.x, u0.y), xc, c0); c1 = MFMA_FP8(pk64(u1.x, u1.y), xc, c1); c2 = MFMA_FP8(pk64(u2.x, u2.y), xc, c2); c3 = MFMA_FP8(pk64(u3.x, u3.y), xc, c3);
    c0 = MFMA_FP8(pk64(u0.z, u0.w), xd, c0); c1 = MFMA_FP8(pk64(u1.z, u1.w), xd, c1); c2 = MFMA_FP8(pk64(u2.z, u2.w), xd, c2); c3 = MFMA_FP8(pk64(u3.z, u3.w), xd, c3);
    __builtin_amdgcn_sched_barrier(0); asm volatile("s_nop 7" ::: "memory"); __builtin_amdgcn_sched_barrier(0);
    const float p0 = fmaf(c0[3], wsel[3], fmaf(c0[2], wsel[2], fmaf(c0[1], wsel[1], c0[0] * wsel[0]))), p1 = fmaf(c1[3], wsel[3], fmaf(c1[2], wsel[2], fmaf(c1[1], wsel[1], c1[0] * wsel[0])));
    const float p2 = fmaf(c2[3], wsel[3], fmaf(c2[2], wsel[2], fmaf(c2[1], wsel[1], c2[0] * wsel[0]))), p3 = fmaf(c3[3], wsel[3], fmaf(c3[2], wsel[2], fmaf(c3[1], wsel[1], c3[0] * wsel[0])));
    const bool up32 = lane >= 32;
    float k0 = up32 ? p2 : p0, k1 = up32 ? p3 : p1, s0 = up32 ? p0 : p2, s1 = up32 ? p1 : p3;
    { auto r0 = __builtin_amdgcn_permlane32_swap(__builtin_bit_cast(unsigned, s0), __builtin_bit_cast(unsigned, s0), false, false);
      auto r1_ = __builtin_amdgcn_permlane32_swap(__builtin_bit_cast(unsigned, s1), __builtin_bit_cast(unsigned, s1), false, false);
      k0 += __builtin_bit_cast(float, up32 ? r0[0] : r0[1]); k1 += __builtin_bit_cast(float, up32 ? r1_[0] : r1_[1]); }
    const bool odd16 = (lane & 16) != 0;
    float kk = odd16 ? k1 : k0, ss = odd16 ? k0 : k1;
    { auto rr = __builtin_amdgcn_permlane16_swap(__builtin_bit_cast(unsigned, ss), __builtin_bit_cast(unsigned, ss), false, false); kk += __builtin_bit_cast(float, odd16 ? rr[0] : rr[1]); }
    DPP_ADD(kk, 0xB1); DPP_ADD(kk, 0x4E); DPP_ADD(kk, 0x141); DPP_ADD(kk, 0x140);
    const float act = gelu_tanh(kk) * g;
    const float a0 = __builtin_bit_cast(float, __builtin_amdgcn_readlane(__builtin_bit_cast(unsigned, act), 0)), a1 = __builtin_bit_cast(float, __builtin_amdgcn_readlane(__builtin_bit_cast(unsigned, act), 16));
    const float a2 = __builtin_bit_cast(float, __builtin_amdgcn_readlane(__builtin_bit_cast(unsigned, act), 32)), a3 = __builtin_bit_cast(float, __builtin_amdgcn_readlane(__builtin_bit_cast(unsigned, act), 48));
#define SW_ACC(F) { acc16_fp8(v0, a0, F); acc16_fp8(v1, a1, F); acc16_fp8(v2, a2, F); acc16_fp8(v3, a3, F); }
    if (tok == 0) { SW_ACC(f0) asm volatile("; token 0"); } else if (tok == 1) { SW_ACC(f1) asm volatile("; token 1"); } else if (tok == 2) { SW_ACC(f2) asm volatile("; token 2"); } else { SW_ACC(f3) asm volatile("; token 3"); }
#undef SW_ACC
}
#undef DPP_ADD
}


constexpr int NWAVES = 8, RING_BYTES = 131072, LDSCTL_OFF = RING_BYTES, MISC_OFF = LDSCTL_OFF + 320, LDS_BYTES = 147456;
constexpr int NPH = 11;
struct Args { const float* in[29]; float* out; unsigned char* ws; int ph_lo, ph_hi; };
static_assert(sizeof(Args) == 29 * 8 + 8 + 8 + 8, "Args has no padding");
enum { I_X = 0, I_C, I_CTX, I_CCTX, I_WMOD, I_BMOD, I_WIN, I_QNG, I_KVNG, I_WUQ, I_WUKV, I_S5ARE, I_S5AIM, I_S5LDT, I_S5BRE, I_S5BIM, I_S5CRE, I_S5CIM, I_S5D, I_WGLU, I_WOUT,
       I_LN1G, I_LN1B, I_PWQ, I_PKEYS, I_PU, I_PV, I_LN2G, I_LN2B };

__global__ void __launch_bounds__(NWAVES * 64, 2) mk_fwd(Args args) {
    extern __shared__ __attribute__((aligned(16))) unsigned char lds[];
    LAS unsigned char* ldsl = (LAS unsigned char*)lds;
    volatile LAS unsigned* MISC = (volatile LAS unsigned*)(ldsl + MISC_OFF);
    const int wave = __builtin_amdgcn_readfirstlane(threadIdx.x >> 6);
    const int G = gridDim.x; const int bx = blockIdx.x; const int vcu = (G % 8 == 0) ? (bx % 8) * (G / 8) + bx / 8 : bx;
    const int gw = vcu * NWAVES + wave, NGW = G * NWAVES;
    unsigned char* ws = args.ws;
    { const int tid = wave * 64 + lane_id_fresh(); for (int u = tid; u < (LDS_BYTES - LDSCTL_OFF) / 4; u += NWAVES * 64) ((LAS unsigned*)(ldsl + LDSCTL_OFF))[u] = 0u; }
    __syncthreads();
    XcdBarrier bar; bar.bar = (unsigned*)(ws + WS_CTL); bar.x = 0; bar.st = nullptr;
    if (MK_N_LAUNCHES == 1) bar = xcd_barrier_post((unsigned*)(ws + WS_CTL), MISC + 8, wave * 64 + lane_id_fresh());
    const int lo = args.ph_lo, hi = args.ph_hi;
    unsigned long long t_a = 0ull, t_b = 0ull; if (MK_TSEL == 0) t_a = __builtin_amdgcn_s_memrealtime();
#define TSTAMP(k) do { if (MK_TSEL >= 0) { if ((k) + 1 == MK_TSEL) t_a = __builtin_amdgcn_s_memrealtime(); if ((k) == MK_TSEL) t_b = __builtin_amdgcn_s_memrealtime(); } } while (0)
#ifndef MK_ONLY
#define MK_ONLY -1
#endif
#define IN(k) ((MK_ONLY < 0 || MK_ONLY == (k)) && lo <= (k) && (k) < hi)
#define SEAM(k) do { if (IN(k) && IN((k) + 1)) { xcd_barrier(bar, wave * 64 + lane_id_fresh()); } } while (0)
#define MOD ((float*)(ws + WS_MOD))
#define ABAR ((float*)(ws + WS_S5ABAR))
#define POW ((float*)(ws + WS_S5POW))
#define BB ((bf16_t*)(ws + WS_S5BB))
#define CM ((bf16_t*)(ws + WS_S5CM))
#define ROPE ((float*)(ws + WS_ROPE))
#define PART ((float*)(ws + WS_PART))
#define S5E ((float*)(ws + WS_S5E))
#define WIN ((bf16_t*)(ws + WS_WIN))
#define WUQ ((bf16_t*)(ws + WS_WUQ))
#define WUKV ((bf16_t*)(ws + WS_WUKV))
#define WGLU ((bf16_t*)(ws + WS_WGLU))
#define WOUT ((bf16_t*)(ws + WS_WOUT))
#define WQ ((bf16_t*)(ws + WS_WQ))
#define KEYS ((bf16_t*)(ws + WS_KEYS))
#define ZQ ((bf16_t*)(ws + WS_ZQ))
#define YB ((bf16_t*)(ws + WS_Y))
#define SU ((bf16_t*)(ws + WS_SU))
#define GATES ((bf16_t*)(ws + WS_GATES))
#define XM ((bf16_t*)(ws + WS_XM))
#define VB ((bf16_t*)(ws + WS_V))
#define MERGED ((bf16_t*)(ws + WS_MERGED))
#define QB ((bf16_t*)(ws + WS_Q))
#define KN ((bf16_t*)(ws + WS_KN))
#define KPE ((bf16_t*)(ws + WS_KPE))
#define TB ((bf16_t*)(ws + WS_T))
#define XM2 ((bf16_t*)(ws + WS_XM2))
#define PQ ((bf16_t*)(ws + WS_PQ))
#define PUB ((bf16_t*)(ws + WS_PU))
#define PVB ((bf16_t*)(ws + WS_PV))
    if (IN(0)) { const int lane = lane_id_fresh(), tid = wave * 64 + lane; (void)tid;
        if (bx < 96) {
            LAS float* sl = (LAS float*)ldsl;
            for (int idx = tid; idx < 17 * 1024; idx += 512) { const int b = idx >> 10, k = idx & 1023; const float cv = (b < 16) ? args.in[I_C][b * 1024 + k] : args.in[I_CCTX][k];
                sl[k * 20 + b] = cv * __builtin_amdgcn_rcpf(1.f + __expf(-cv)); }
            __syncthreads();
            LAS float* red = (LAS float*)(ldsl + 81920);
            for (int item = bx; item < 96; item += G) { const int n0 = item * 64;
                float acc[17];
#pragma unroll
                for (int b = 0; b < 17; ++b) acc[b] = 0.f;
                const float* wp = args.in[I_WMOD] + (size_t)(wave * 128) * 6144 + n0 + lane;
#pragma unroll 1
                for (int k0 = 0; k0 < 128; k0 += 32) { float wv[32];
#pragma unroll
                    for (int kk = 0; kk < 32; ++kk) wv[kk] = wp[(size_t)(k0 + kk) * 6144];
                    __builtin_amdgcn_sched_barrier(0);
#pragma unroll
                    for (int kk = 0; kk < 32; ++kk) { const float w = wv[kk]; const LAS float* s = sl + (wave * 128 + k0 + kk) * 20;
                        const f32x4 s0 = *(const LAS f32x4*)s, s1 = *(const LAS f32x4*)(s + 4), s2 = *(const LAS f32x4*)(s + 8), s3 = *(const LAS f32x4*)(s + 12); const float s4 = s[16];
                        acc[0] += w * s0[0]; acc[1] += w * s0[1]; acc[2] += w * s0[2]; acc[3] += w * s0[3]; acc[4] += w * s1[0]; acc[5] += w * s1[1]; acc[6] += w * s1[2]; acc[7] += w * s1[3];
                        acc[8] += w * s2[0]; acc[9] += w * s2[1]; acc[10] += w * s2[2]; acc[11] += w * s2[3]; acc[12] += w * s3[0]; acc[13] += w * s3[1]; acc[14] += w * s3[2]; acc[15] += w * s3[3]; acc[16] += w * s4; } }
#pragma unroll
                for (int b = 0; b < 17; ++b) red[(wave * 17 + b) * 64 + lane] = acc[b];
                __syncthreads();
                for (int idx = tid; idx < 17 * 64; idx += 512) { const int b = idx >> 6, ln = idx & 63; float s = args.in[I_BMOD][n0 + ln];
#pragma unroll
                    for (int w = 0; w < 8; ++w) s += red[(w * 17 + b) * 64 + ln];
                    MOD[(size_t)b * 6144 + n0 + ln] = s; }
                __syncthreads();
            }
        }
        {
            LAS float* scr = (LAS float*)(ldsl + wave * 16384);
            constexpr int I_1 = 16 * 104, I_2 = 6 * 48, I_3 = 4 * 64, I_4 = 8 * 64, I_5 = 16 * 32, I_6 = 16 * 64, NITEMS = I_1 + I_2 + I_3 + I_4 + I_5 + I_6;
            const bool split = (G == 256);
            for (int it = split ? (bx - 96) * NWAVES + wave : gw; it >= 0 && it < NITEMS; it += split ? (G - 96) * NWAVES : NGW) { int r = it;
                if (r < I_1) { const int kb = r / 104, nb = r % 104, nd = nb * 32;
                    const int ns = nd < 704 ? nd : (nd < 768 ? -1 : nd - 64);
                    transpose_item(args.in[I_WIN], INW, kb * 64, ns, WIN, 1024, nd, nullptr, scr, lane); continue; } r -= I_1;
                if (r < I_2) { const int kb = r / 48, nb = r % 48; transpose_item(args.in[I_WUQ], 1536, kb * 64, nb * 32, WUQ, 384, nb * 32, args.in[I_QNG], scr, lane); continue; } r -= I_2;
                if (r < I_3) { const int kb = r / 64, nb = r % 64; transpose_item(args.in[I_WUKV], 2048, kb * 64, nb * 32, WUKV, 256, nb * 32, args.in[I_KVNG], scr, lane); continue; } r -= I_3;
                if (r < I_4) { const int kb = r / 64, nb = r % 64, nd = nb * 32, tile = nd >> 8, wi = nd & 255;
                    const int ns = wi < 128 ? tile * 128 + wi : 1024 + tile * 128 + (wi - 128);
                    transpose_item(args.in[I_WGLU], 2048, kb * 64, ns, WGLU, 512, nd, nullptr, scr, lane); continue; } r -= I_4;
                if (r < I_5) { const int kb = r / 32, nb = r % 32; transpose_item(args.in[I_WOUT], 1024, kb * 64, nb * 32, WOUT, 1024, nb * 32, nullptr, scr, lane); continue; } r -= I_5;
                { const int kb = r / 64, nb = r % 64; transpose_item(args.in[I_PWQ], 2048, kb * 64, nb * 32, WQ, 1024, nb * 32, nullptr, scr, lane); }
            }
        }
        const int gt = (G - 1 - bx) * 512 + tid, NGT = G * 512;
        for (int i = gt; i < 16 * 128 * 128 / 8; i += NGT) {
            const f32x4 a = ((const f32x4*)args.in[I_PKEYS])[2 * i], b = ((const f32x4*)args.in[I_PKEYS])[2 * i + 1]; ((u32x4*)KEYS)[i] = pack8(a, b); }
        for (int i = gt; i < 4096; i += NGT) {
            const int p = i & 63, dg = i >> 6;
            const double dt = exp((double)args.in[I_S5LDT][dg]), ar = args.in[I_S5ARE][i], ai = args.in[I_S5AIM][i];
            const double mag = exp(ar * dt), abr = mag * cos(ai * dt), abi = mag * sin(ai * dt), den = ar * ar + ai * ai;
            const double fr = ((abr - 1.0) * ar + abi * ai) / den, fi = (abi * ar - (abr - 1.0) * ai) / den;
            ABAR[2 * i] = (float)abr; ABAR[2 * i + 1] = (float)abi;
            { const double m1 = exp(ar * dt * 256.0), m2 = exp(ar * dt * 512.0);
              POW[2 * i] = (float)(m1 * cos(ai * dt * 256.0)); POW[2 * i + 1] = (float)(m1 * sin(ai * dt * 256.0));
              POW[8192 + 2 * i] = (float)(m2 * cos(ai * dt * 512.0)); POW[8192 + 2 * i + 1] = (float)(m2 * sin(ai * dt * 512.0)); }
            for (int c = 0; c < 16; ++c) { const double br = args.in[I_S5BRE][(size_t)i * 16 + c], bi = args.in[I_S5BIM][(size_t)i * 16 + c];
                BB[((size_t)(dg * 2 + 0) * 64 + p) * 16 + c] = (bf16_t)(cvt_pk_bf16((float)(fr * br - fi * bi), 0.f) & 0xffffu);
                BB[((size_t)(dg * 2 + 1) * 64 + p) * 16 + c] = (bf16_t)(cvt_pk_bf16((float)(fr * bi + fi * br), 0.f) & 0xffffu);
                CM[((size_t)dg * 16 + c) * 128 + p] = (bf16_t)(cvt_pk_bf16(args.in[I_S5CRE][((size_t)dg * 16 + c) * 64 + p], 0.f) & 0xffffu);
                CM[((size_t)dg * 16 + c) * 128 + 64 + p] = (bf16_t)(cvt_pk_bf16(-args.in[I_S5CIM][((size_t)dg * 16 + c) * 64 + p], 0.f) & 0xffffu); }
        }
        for (int i = gt; i < 1024; i += NGT) { const int pos = i >> 4, idx = i & 15;
            const double ang = (double)pos * exp(-9.210340371976184 * (double)idx / 16.0); ROPE[2 * i] = (float)cos(ang); ROPE[2 * i + 1] = (float)sin(ang); }
    }
    SEAM(0); TSTAMP(0);
    if (IN(1)) { const int lane = lane_id_fresh(), tid = wave * 64 + lane; (void)tid;
#define P1A_ROW(m_) ((m_) < MLAT ? args.in[I_X] + (size_t)(m_) * DM : args.in[I_CTX] + (size_t)((m_) - MLAT) * DM)
#define P1A_LOAD(V, m_) do { const f32x4* p_ = (const f32x4*)P1A_ROW(m_) + lane; V[0] = p_[0]; V[1] = p_[64]; V[2] = p_[128]; V[3] = p_[192]; } while (0)
#define P1A_MOD(m_, A1, BS) do { const int b_ = ((m_) < MLAT) ? ((m_) >> 11) : 16; const f32x4* sh_ = (const f32x4*)(MOD + (size_t)b_ * 6144) + lane; const f32x4* sc_ = (const f32x4*)(MOD + (size_t)b_ * 6144 + 1024) + lane; \
    _Pragma("unroll") for (int j_ = 0; j_ < 4; ++j_) { A1[j_] = sc_[64 * j_]; BS[j_] = sh_[64 * j_]; } } while (0)
        { f32x4 va[4], vb[4], a1[4], bs[4], a1b[4], bsb[4];
          int m = gw; P1A_LOAD(va, m); P1A_MOD(m, a1, bs);
#pragma unroll 1
          for (; m < MTOT; m += 2 * NGW) {
              const int m2 = m + NGW, m3 = m + 2 * NGW;
              if (m2 < MTOT) { P1A_LOAD(vb, m2); P1A_MOD(m2, a1b, bsb); }
              modulate_row_r(va, a1, bs, XM + (size_t)m * DM, lane);
              if (m2 < MTOT) { if (m3 < MTOT) { P1A_LOAD(va, m3); P1A_MOD(m3, a1, bs); } modulate_row_r(vb, a1b, bsb, XM + (size_t)m2 * DM, lane); }
          } }
#undef P1A_ROW
#undef P1A_LOAD
#undef P1A_MOD
    }
    SEAM(1); TSTAMP(1);
    if (IN(2)) {
        pg8::Gemm g{XM, WIN, 1024, 1024, 1024}; pg8::StaticOrder S; S.init(MLAT / 256, 13, G, bx, MCTX / 256, 5);
        EpiInProj E{ZQ, SU, GATES, PART};
        pg8::gemm_phase(ldsl, g, S, E, wave * 64 + lane_id_fresh());
    }
    SEAM(2); TSTAMP(2);
    if (IN(3)) { const int lane = lane_id_fresh(), tid = wave * 64 + lane; (void)tid;
        { pg8::Gemm g{ZQ, WUQ, 768, 384, 384}; pg8::StaticOrder S; S.init(MLAT / 256, 6, G, bx); EpiUQ E{QB, PART}; pg8::gemm_phase(ldsl, g, S, E, wave * 64 + lane_id_fresh()); }
        { pg8::Gemm g{ZQ + 384, WUKV, 768, 256, 256}; pg8::StaticOrder S; S.init(MTOT / 256, 8, G, bx); EpiUKV E{KN, VB, PART}; pg8::gemm_phase(ldsl, g, S, E, wave * 64 + lane_id_fresh()); }
        const int gt = bx * 512 + tid, NGT = G * 512;
        for (int i = gt; i < MTOT * 32; i += NGT) {
            const int row = i >> 5, pp = i & 31, part = pp >> 4, idx = pp & 15;
            const bf16_t* z = ZQ + (size_t)row * 768 + 640 + part * 32 + idx; const float x1 = bf_lo((unsigned)z[0]), x2 = bf_lo((unsigned)z[16]);
            float o1 = x1, o2 = x2; int b, key;
            if (row < MLAT) { b = row >> 11; const int l = row & 2047; key = CTXL + l; const int pos = part == 0 ? (l >> 6) : (l & 63); const float cs = ROPE[(pos * 16 + idx) * 2], sn = ROPE[(pos * 16 + idx) * 2 + 1];
                o1 = x1 * cs - x2 * sn; o2 = x2 * cs + x1 * sn; }
            else { const int r2 = row - MLAT; b = r2 >> 8; key = r2 & 255; }
            bf16_t* kp = KPE + ((size_t)b * NKEY + key) * 64 + part * 32 + idx;
            kp[0] = (bf16_t)(cvt_pk_bf16(o1, 0.f) & 0xffffu); kp[16] = (bf16_t)(cvt_pk_bf16(o2, 0.f) & 0xffffu); }
        for (int u = gw; u < 2 * 32 * 8 * 8; u += NGW) s5_passA(SU, ABAR, BB, S5E, u, lane);
    }
    SEAM(3); TSTAMP(3);
    if (IN(4)) { const int lane = lane_id_fresh(), tid = wave * 64 + lane; (void)tid;
#pragma unroll 1
        for (int U = vcu; U < 1024; U += G) { const int bh = U >> 3, qb = U & 7, b = bh >> 3, h = bh & 7;
            att::attn_unit(QB + ((size_t)bh * SEQ + qb * 256) * DK, KN + (size_t)bh * NKEY * 128, KPE + (size_t)b * NKEY * 64, VB + (size_t)bh * NKEY * 128,
                           GATES + ((size_t)(b * SEQ + qb * 256)) * 2048 + h * 128, ROPE, qb * 256, (char*)lds, wave * 64 + lane_id_fresh()); }
        for (int u = gw; u < 2048; u += NGW) s5_passB(SU, ABAR, POW, BB, CM, S5E, args.in[I_S5D], YB, u, lane, ldsl + wave * S5_LDS_WAVE);
    }
    SEAM(4); TSTAMP(4);
    if (IN(5)) {
        pg8::Gemm g{YB, WGLU, 512, 512, 512}; pg8::StaticOrder S; S.init(MLAT / 256, 8, G, bx); EpiGLU E{QB, GATES, MERGED}; pg8::gemm_phase(ldsl, g, S, E, wave * 64 + lane_id_fresh());
    }
    SEAM(5); TSTAMP(5);
    if (IN(6)) {
        pg8::Gemm g{MERGED, WOUT, 1024, 1024, 1024}; pg8::StaticOrder S; S.init(MLAT / 256, 4, G, bx); EpiOut E{args.in[I_X], MOD, TB}; pg8::gemm_phase(ldsl, g, S, E, wave * 64 + lane_id_fresh());
    }
    SEAM(6); TSTAMP(6);
    if (IN(7)) { const int lane = lane_id_fresh(), tid = wave * 64 + lane; (void)tid;
#define P5B_LOAD(V, m_) do { const u32x2* p_ = (const u32x2*)(TB + (size_t)(m_) * DM) + lane; _Pragma("unroll") for (int j_ = 0; j_ < 4; ++j_) { const u32x2 q_ = p_[64 * j_]; V[j_] = (f32x4){bf_lo(q_.x), bf_hi(q_.x), bf_lo(q_.y), bf_hi(q_.y)}; } } while (0)
#define P5B_MOD(m_, A1, BS) do { const int b_ = (m_) >> 11; const f32x4* sh_ = (const f32x4*)(MOD + (size_t)b_ * 6144 + 3072) + lane; const f32x4* sc_ = (const f32x4*)(MOD + (size_t)b_ * 6144 + 4096) + lane; \
    _Pragma("unroll") for (int j_ = 0; j_ < 4; ++j_) { A1[j_] = sc_[64 * j_]; BS[j_] = sh_[64 * j_]; } } while (0)
        { f32x4 va[4], vb[4], g1v[4], b1v[4], a1[4], bs[4], a1b[4], bsb[4];
#pragma unroll
          for (int j = 0; j < 4; ++j) { g1v[j] = ((const f32x4*)args.in[I_LN1G] + lane)[64 * j]; b1v[j] = ((const f32x4*)args.in[I_LN1B] + lane)[64 * j]; }
          int m = gw; P5B_LOAD(va, m); P5B_MOD(m, a1, bs);
#pragma unroll 1
          for (; m < MLAT; m += 2 * NGW) {
              P5B_LOAD(vb, m + NGW); P5B_MOD(m + NGW, a1b, bsb);
              ln1_row(va, PART + 2 * (size_t)m, g1v, b1v, a1, bs, XM2 + (size_t)m * DM, lane);
              if (m + 2 * NGW < MLAT) { P5B_LOAD(va, m + 2 * NGW); P5B_MOD(m + 2 * NGW, a1, bs); }
              ln1_row(vb, PART + 2 * (size_t)(m + NGW), g1v, b1v, a1b, bsb, XM2 + (size_t)(m + NGW) * DM, lane);
          } }
#undef P5B_LOAD
#undef P5B_MOD
#pragma unroll 1
        for (int r0 = gw * 4; r0 < 2 * PEXP; r0 += NGW * 4) {
            f32x4 t[4][4];
#pragma unroll
            for (int q = 0; q < 4; ++q) { const int r = r0 + q; const bool isU = r < PEXP; const f32x4* src = (const f32x4*)(isU ? args.in[I_PU] : args.in[I_PV]) + (size_t)(isU ? r : r - PEXP) * (DM / 4) + lane;
#pragma unroll
                for (int d = 0; d < 4; ++d) t[q][d] = src[64 * d]; }
#pragma unroll
            for (int q = 0; q < 4; ++q) { const int r = r0 + q; const bool isU = r < PEXP; const float sc_ = isU ? peer::PU_SCALE : peer::PV_SCALE;
                unsigned* dst = (unsigned*)(ws + WS_PU + (isU ? (size_t)0 : (size_t)(16 * MiB)) + (size_t)(isU ? r : r - PEXP) * DM) + lane;
#pragma unroll
                for (int d = 0; d < 4; ++d) { const f32x4 v = t[q][d] * sc_; int p = __builtin_amdgcn_cvt_pk_fp8_f32(peer::sat8(v[0]), peer::sat8(v[1]), 0, false); p = __builtin_amdgcn_cvt_pk_fp8_f32(peer::sat8(v[2]), peer::sat8(v[3]), p, true); dst[64 * d] = (unsigned)p; } }
        }
    }
    SEAM(7); TSTAMP(7);
    if (IN(8)) {
        pg8::Gemm g{XM2, WQ, 1024, 1024, 1024}; pg8::StaticOrder S; S.init(MLAT / 256, 8, G, bx); EpiPQ E{PQ}; pg8::gemm_phase(ldsl, g, S, E, wave * 64 + lane_id_fresh());
    }
    SEAM(8); TSTAMP(8);
    if (IN(9)) { const int lane = lane_id_fresh(), tid = wave * 64 + lane; const int h = bx & 7;
        for (int c = tid; c < 4096; c += 512) { const int z = c >> 11, key = (c >> 4) & 127, c16 = c & 15;
            *(LAS u32x4*)(ldsl + peer::ksw(z, key, c16 * 16)) = *(const u32x4*)(KEYS + ((size_t)(h * 2 + z) * 128 + key) * 128 + c16 * 8); }
        __syncthreads();
#pragma unroll 1
        for (int j = wave; j < 32; j += 8) { int l2 = lane; asm volatile("" : "+v"(l2));
            peer::route_unit(PQ, (const char*)lds,
                (unsigned*)(ws + WS_ROUTE), (float*)(ws + WS_ROUTE + 16 * MiB), ((bx >> 3) * 32 + j) * 32, h, l2); }
    }
    SEAM(9); TSTAMP(9);
    if (IN(10)) { const int lane = lane_id_fresh();
        LAS unsigned char* wl = ldsl + wave * peer::WAVE_LDS;
        LAS unsigned char* xl = wl + peer::TOK_PER_WAVE * peer::TOKLDS_BYTES;
        const unsigned char* PU8 = ws + WS_PU; const unsigned char* PV8 = ws + WS_PU + 16 * MiB;
        f32x4 wsel; { const bool dsel = (lane >> 4) == ((lane & 15) >> 2); const float sc_ = 1.f / (peer::PU_SCALE * peer::X_SCALE);
#pragma unroll
          for (int r = 0; r < 4; ++r) wsel[r] = (dsel && (lane & 3) == r) ? sc_ : 0.f; }
#pragma unroll 1
        for (int m0 = gw * peer::TOK_PER_WAVE; m0 < MLAT; m0 += NGW * peer::TOK_PER_WAVE) {
            float f0[16], f1[16], f2[16], f3[16];
            { unsigned ia[4], ib[4]; float wa[4], wb[4]; u32x4 xa[4], xb[4];
#pragma unroll
              for (int i = 0; i < 4; ++i) { const size_t m = (size_t)(m0 + i); const unsigned* ridx = (const unsigned*)(ws + WS_ROUTE) + m * 128; const float* rw = (const float*)(ws + WS_ROUTE + 16 * MiB) + m * 128;
                  ia[i] = ridx[lane]; ib[i] = ridx[64 + lane]; wa[i] = rw[lane]; wb[i] = rw[64 + lane];
                  const bf16_t* xrow = XM2 + m * DM; xa[i] = *(const u32x4*)(xrow + 16 * lane); xb[i] = *(const u32x4*)(xrow + 16 * lane + 8); }
#pragma unroll
              for (int i = 0; i < 4; ++i) { peer::bucket_token(ia[i], ib[i], wa[i], wb[i], wl + i * peer::TOKLDS_BYTES, lane); peer::xop_store(xa[i], xb[i], xl + i * peer::XOP_BYTES, lane); } }
#pragma unroll
            for (int e = 0; e < 16; ++e) { f0[e] = 0.f; f1[e] = 0.f; f2[e] = 0.f; f3[e] = 0.f; }
            LDS_WAIT();
            peer::build_recs(wl, lane); constexpr int nd = 128;
            LDS_WAIT();
            u32x4 au0, au1, au2, au3, av0, av1, av2, av3, bu0, bu1, bu2, bu3, bv0, bv1, bv2, bv3, axh, axo, bxh, bxo; float ag, bg; int at, bt;
            u32x2 ra, rb;
#define SW_REC(k_, R) do { const int kk_ = (k_) < nd ? (k_) : nd - 1; R = *(const LAS u32x2*)(wl + 32 * kk_); } while (0)
#define SW_LOAD(k_, R, U0, U1, U2, U3, V0, V1, V2, V3, XH, XO, G, T) do { \
    const unsigned p0_ = (unsigned)__builtin_amdgcn_readfirstlane((int)R.x), p1_ = (unsigned)__builtin_amdgcn_readfirstlane((int)R.y); T = (int)((p0_ >> 14) & 3u); \
    const unsigned e0_ = p0_ & 0x3fffu, e1_ = p0_ >> 16, e2_ = p1_ & 0xffffu, e3_ = p1_ >> 16; \
    { const int kk_ = (k_) < nd ? (k_) : nd - 1; G = ((const LAS float*)(wl + 32 * kk_))[4 + (lane >> 4)] * (1.f / peer::PV_SCALE); } \
    XH = *(const LAS u32x4*)(xl + T * peer::XOP_BYTES + 16 * lane); XO = *(const LAS u32x4*)(xl + T * peer::XOP_BYTES + 1024 + 16 * lane); \
    U0 = *(const u32x4*)(PU8 + (size_t)e0_ * 1024 + 16 * lane); U1 = *(const u32x4*)(PU8 + (size_t)e1_ * 1024 + 16 * lane); \
    U2 = *(const u32x4*)(PU8 + (size_t)e2_ * 1024 + 16 * lane); U3 = *(const u32x4*)(PU8 + (size_t)e3_ * 1024 + 16 * lane); \
    V0 = *(const u32x4*)(PV8 + (size_t)e0_ * 1024 + 16 * lane); V1 = *(const u32x4*)(PV8 + (size_t)e1_ * 1024 + 16 * lane); \
    V2 = *(const u32x4*)(PV8 + (size_t)e2_ * 1024 + 16 * lane); V3 = *(const u32x4*)(PV8 + (size_t)e3_ * 1024 + 16 * lane); } while (0)
            SW_REC(0, ra); SW_REC(1, rb);
            SW_LOAD(0, ra, au0, au1, au2, au3, av0, av1, av2, av3, axh, axo, ag, at);
#pragma unroll 1
            for (int k = 0; k < nd; k += 2) {
                SW_LOAD(k + 1, rb, bu0, bu1, bu2, bu3, bv0, bv1, bv2, bv3, bxh, bxo, bg, bt);
                SW_REC(k + 2, ra);
                peer::sweep_compute(au0, au1, au2, au3, av0, av1, av2, av3, ag, at, axh, axo, f0, f1, f2, f3, lane, wsel);
                SW_LOAD(k + 2, ra, au0, au1, au2, au3, av0, av1, av2, av3, axh, axo, ag, at);
                SW_REC(k + 3, rb);
                peer::sweep_compute(bu0, bu1, bu2, bu3, bv0, bv1, bv2, bv3, bg, bt, bxh, bxo, f0, f1, f2, f3, lane, wsel);
            }
#undef SW_REC
#undef SW_LOAD
            { const int b = m0 >> 11;
              f32x4 gf[4], g1v[4], b1v[4], g2v[4], b2v[4]; u32x4 ta[4], tb[4]; float mean1[4], rstd1[4];
#pragma unroll
              for (int i = 0; i < 4; ++i) { const u32x4* hp = (const u32x4*)(TB + (size_t)(m0 + i) * DM + 16 * lane); ta[i] = hp[0]; tb[i] = hp[1]; mean1[i] = PART[2 * (size_t)(m0 + i)]; rstd1[i] = PART[2 * (size_t)(m0 + i) + 1]; }
#pragma unroll
              for (int d = 0; d < 4; ++d) { gf[d] = ((const f32x4*)(MOD + (size_t)b * 6144 + 5120 + 16 * lane))[d]; g1v[d] = ((const f32x4*)(args.in[I_LN1G] + 16 * lane))[d]; b1v[d] = ((const f32x4*)(args.in[I_LN1B] + 16 * lane))[d];
                  g2v[d] = ((const f32x4*)(args.in[I_LN2G] + 16 * lane))[d]; b2v[d] = ((const f32x4*)(args.in[I_LN2B] + 16 * lane))[d]; }
#pragma unroll
              for (int i = 0; i < 4; ++i) { const int m = m0 + i; float v[16];
#pragma unroll
                  for (int d = 0; d < 4; ++d) {
                      const unsigned qa = d < 2 ? (d == 0 ? ta[i].x : ta[i].z) : (d == 2 ? tb[i].x : tb[i].z), qb = d < 2 ? (d == 0 ? ta[i].y : ta[i].w) : (d == 2 ? tb[i].y : tb[i].w);
                      const f32x4 t = {bf_lo(qa), bf_hi(qa), bf_lo(qb), bf_hi(qb)};
#pragma unroll
                      for (int e = 0; e < 4; ++e) { const float fv = (i == 0 ? f0[4 * d + e] : i == 1 ? f1[4 * d + e] : i == 2 ? f2[4 * d + e] : f3[4 * d + e]);
                          v[4 * d + e] = gf[d][e] * fv + ALPHA * ((t[e] - mean1[i]) * rstd1[i] * g1v[d][e] + b1v[d][e]); } }
                  float s = 0.f;
#pragma unroll
                  for (int e = 0; e < 16; ++e) s += v[e];
                  const float mean = wave_sum(s) * (1.f / DM); float s2 = 0.f;
#pragma unroll
                  for (int e = 0; e < 16; ++e) { v[e] -= mean; s2 += v[e] * v[e]; }
                  const float rstd = rsqrtf(wave_sum(s2) * (1.f / DM) + LN_EPS);
                  f32x4* op = (f32x4*)(args.out + (size_t)m * DM + 16 * lane);
#pragma unroll
                  for (int d = 0; d < 4; ++d) { f32x4 o;
#pragma unroll
                      for (int e = 0; e < 4; ++e) o[e] = v[4 * d + e] * rstd * g2v[d][e] + b2v[d][e];
                      op[d] = o; } } }
        }
    }
    if (MK_TSEL >= 0) { if (MK_TSEL == 10) t_b = __builtin_amdgcn_s_memrealtime(); if (bx == 0) { const unsigned long long span = t_b - t_a, t0 = __builtin_amdgcn_s_memrealtime(); while (__builtin_amdgcn_s_memrealtime() - t0 < 4ull * span) __builtin_amdgcn_s_sleep(8); } }
#undef IN
#undef SEAM
}

extern "C" void kernel_launch(void* const* d_in, const int* in_sizes, int n_in, void* d_out, int out_size, void* d_ws, size_t ws_size, hipStream_t stream) {
    static int grid = 0;
    if (grid == 0) {
        if (n_in != 29 || in_sizes[0] != MLAT * DM || out_size != MLAT * DM || ws_size < WS_END) {
            fprintf(stderr, "kernel_launch: unexpected problem: n_in %d in0 %d out %d ws %zu (need %zu)\n", n_in, n_in > 0 ? in_sizes[0] : -1, out_size, ws_size, (size_t)WS_END); grid = -1; return; }
        int dev = 0, cus = 0;
        if (hipGetDevice(&dev) != hipSuccess || hipDeviceGetAttribute(&cus, hipDeviceAttributeMultiprocessorCount, dev) != hipSuccess) { grid = -1; return; }
        if (hipFuncSetAttribute((const void*)mk_fwd, hipFuncAttributeMaxDynamicSharedMemorySize, LDS_BYTES) != hipSuccess) { fprintf(stderr, "kernel_launch: hipFuncSetAttribute failed\n"); grid = -1; return; }
        int per_cu = 0;
        if (hipOccupancyMaxActiveBlocksPerMultiprocessor(&per_cu, (const void*)mk_fwd, NWAVES * 64, LDS_BYTES) != hipSuccess || per_cu < 1)
            fprintf(stderr, "kernel_launch: occupancy query reports %d blocks per CU\n", per_cu);
        (void)hipGetLastError();
        grid = cus >= 256 ? 256 : (cus >= 128 ? 128 : (cus >= 64 ? 64 : -1));
    }
    if (grid < 0) return;
    if (hipMemsetAsync((char*)d_ws + WS_CTL, 0, CTL_ZERO_BYTES, stream) != hipSuccess) return;
    Args a{};
    for (int i = 0; i < 29; ++i) a.in[i] = (const float*)d_in[i];
    a.out = (float*)d_out; a.ws = (unsigned char*)d_ws;
#if MK_N_LAUNCHES == 1
    a.ph_lo = 0; a.ph_hi = NPH;
    hipLaunchKernelGGL(mk_fwd, dim3(grid), dim3(NWAVES * 64), LDS_BYTES, stream, a);
#else
    for (int p = 0; p < NPH; ++p) { a.ph_lo = p; a.ph_hi = p + 1; hipLaunchKernelGGL(mk_fwd, dim3(grid), dim3(NWAVES * 64), LDS_BYTES, stream, a); }
#endif
    const hipError_t le = hipPeekAtLastError();
    if (le != hipSuccess) fprintf(stderr, "kernel_launch: launch failed: %s\n", hipGetErrorName(le));
}
```
